# Optimizing an MI355X kernel written in HIP

```python
import jax
import jax.numpy as jnp
from jax import lax
import numpy as np

D_MODEL = 1024
BATCH = 4
SEQ = 8192
DEPTH = 4

GRID_W = 64
CTX_LEN = 256
N_MIXERS = 3
NORM_EPS = 1e-6
N_MOD = 6

NA_HEADS = 16
NA_HEAD_DIM = D_MODEL // NA_HEADS
NA_WIN_ROWS = 8
NA_WIN_COLS = 16

POOL_WINDOWS = (2, 4, 8, 16)
POOL_GROUPS = len(POOL_WINDOWS)
POOL_GROUP_DIM = D_MODEL // POOL_GROUPS

MLSTM_INNER = 2 * D_MODEL
MLSTM_HEADS = 4
MLSTM_HEAD_DIM = MLSTM_INNER // MLSTM_HEADS
MLSTM_CONV = 4
MLSTM_QKV_BLOCK = 4
MLSTM_QKV_NBLK = MLSTM_INNER // MLSTM_QKV_BLOCK
MLSTM_CHUNK = 64

FFN_DENSE = 2816
N_EXPERTS = 8
TOP_K = 2
FFN_EXPERT = 3584
MOE_BLOCK = 128

N_NA = (DEPTH + 2) // 3
N_POOL = (DEPTH + 1) // 3
N_MLSTM = DEPTH // 3
N_DENSE = (DEPTH + 1) // 2
N_MOE = DEPTH // 2

kernel_name = 'hybrid_natten_pool_mlstm_moe_flow_trunk'


def rmsnorm(x, g):
    xf = x.astype(jnp.float32)
    y = xf * lax.rsqrt(jnp.mean(xf * xf, axis=-1, keepdims=True) + NORM_EPS)
    return (y * g.astype(jnp.float32)).astype(x.dtype)


def adaln(cond, w, b):
    m = jax.nn.silu(cond) @ w + b
    m = m.reshape(m.shape[:-1] + (N_MOD, D_MODEL))
    return [m[..., j, :][..., None, :] for j in range(N_MOD)]


def modulate(h, shift, scale):
    return h * (1.0 + scale) + shift


def swiglu(h, w1, w3, w2):
    return (jax.nn.silu(h @ w1) * (h @ w3)) @ w2


def context_attention(q, k, v):
    s = jnp.einsum('bqhd,bkhd->bhqk', q, k).astype(jnp.float32) * (NA_HEAD_DIM ** -0.5)
    p = jax.nn.softmax(s, axis=-1).astype(v.dtype)
    return jnp.einsum('bhqk,bkhd->bqhd', p, v)


def neighbourhood_attention(q, k, v, k_ctx, v_ctx, rpb):
    B, L, H, dh = q.shape
    rows = L // GRID_W
    kh = min(NA_WIN_ROWS, rows)
    kw = NA_WIN_COLS
    grid = lambda t: t.reshape(B, rows, GRID_W, H, dh)
    qg, kg, vg = grid(q), grid(k), grid(v)
    col = jnp.arange(GRID_W)
    c0 = jnp.clip(col - kw // 2, 0, GRID_W - kw)
    col_ok = (col[None, :] >= c0[:, None]) & (col[None, :] < c0[:, None] + kw)
    dcol = jnp.clip(col[None, :] - col[:, None], 1 - kw, kw - 1) + (NA_WIN_COLS - 1)
    scale = NA_HEAD_DIM ** -0.5

    def row_block(r):
        r0 = jnp.clip(r - kh // 2, 0, rows - kh)
        q_r = lax.dynamic_index_in_dim(qg, r, axis=1, keepdims=False)
        k_r = lax.dynamic_slice_in_dim(kg, r0, kh, axis=1)
        v_r = lax.dynamic_slice_in_dim(vg, r0, kh, axis=1)
        drow = r0 + jnp.arange(kh) - r + (NA_WIN_ROWS - 1)
        bias = rpb[:, drow[None, :, None], dcol[:, None, :]]
        s_loc = jnp.einsum('bqhd,bikhd->bhqik', q_r, k_r).astype(jnp.float32) * scale + bias.astype(jnp.float32)
        s_loc = jnp.where(col_ok[:, None, :], s_loc, -jnp.inf).reshape(B, H, GRID_W, kh * GRID_W)
        s_ctx = jnp.einsum('bqhd,bchd->bhqc', q_r, k_ctx).astype(jnp.float32) * scale
        p = jax.nn.softmax(jnp.concatenate([s_loc, s_ctx], axis=-1), axis=-1).astype(v.dtype)
        p_loc = p[..., :kh * GRID_W].reshape(B, H, GRID_W, kh, GRID_W)
        return (jnp.einsum('bhqik,bikhd->bqhd', p_loc, v_r)
                + jnp.einsum('bhqc,bchd->bqhd', p[..., kh * GRID_W:], v_ctx))

    out = lax.map(row_block, jnp.arange(rows))
    return jnp.moveaxis(out, 0, 1).reshape(B, L, H, dh)


def na_mixer(a_lat, a_ctx, w_qkv, b_qkv, rpb, w_out, b_out, with_ctx_out):
    B, L, D = a_lat.shape
    C = a_ctx.shape[1]
    qkv = (a_lat @ w_qkv + b_qkv).reshape(B, L, 3, NA_HEADS, NA_HEAD_DIM)
    kv_c = (a_ctx @ w_qkv[:, D:] + b_qkv[D:]).reshape(B, C, 2, NA_HEADS, NA_HEAD_DIM)
    k_c, v_c = kv_c[:, :, 0], kv_c[:, :, 1]
    o_lat = neighbourhood_attention(qkv[:, :, 0], qkv[:, :, 1], qkv[:, :, 2], k_c, v_c, rpb)
    y_lat = o_lat.reshape(B, L, D) @ w_out + b_out
    if not with_ctx_out:
        return y_lat, None
    q_c = (a_ctx @ w_qkv[:, :D] + b_qkv[:D]).reshape(B, C, NA_HEADS, NA_HEAD_DIM)
    o_ctx = context_attention(q_c, k_c, v_c)
    return y_lat, o_ctx.reshape(B, C, D) @ w_out + b_out


def multiscale_pool(h, w_pool, pool_scale):
    B, L, D = h.shape
    hf = h.astype(jnp.float32)
    csum = jnp.concatenate([jnp.zeros((B, 1, D), jnp.float32), jnp.cumsum(hf, axis=1)], axis=1)
    t = jnp.arange(L)
    parts = []
    for g, w in enumerate(POOL_WINDOWS):
        lo = jnp.maximum(t - w // 2, 0)
        hi = jnp.minimum(t + w // 2, L)
        sl = slice(g * POOL_GROUP_DIM, (g + 1) * POOL_GROUP_DIM)
        cg = csum[..., sl]
        mean = (jnp.take(cg, hi, axis=1) - jnp.take(cg, lo, axis=1)) / (hi - lo).astype(jnp.float32)[None, :, None]
        parts.append(mean - hf[..., sl])
    pooled = jnp.stack(parts, axis=2).astype(h.dtype)
    y = jnp.einsum('blgc,gcd->blgd', pooled, w_pool).reshape(B, L, D)
    return y * pool_scale


def mlstm_features(h, w_up, conv_w, conv_b, w_q, w_k, w_v, w_gates, b_gates):
    B, L, _ = h.shape
    xm, z = jnp.split(h @ w_up, 2, axis=-1)
    left = MLSTM_CONV // 2
    xp = jnp.pad(xm, ((0, 0), (left, MLSTM_CONV - 1 - left), (0, 0)))
    xc = conv_b
    for j in range(MLSTM_CONV):
        xc = xc + xp[:, j:j + L] * conv_w[j]
    xc = jax.nn.silu(xc)

    def headwise(t, w):
        tb = t.reshape(B, L, MLSTM_QKV_NBLK, MLSTM_QKV_BLOCK)
        return jnp.einsum('blnc,ncd->blnd', tb, w).reshape(B, L, MLSTM_INNER)

    q = headwise(xc, w_q)
    k = headwise(xc, w_k)
    v = headwise(xm, w_v)
    gates = (jnp.concatenate([q, k, v], axis=-1) @ w_gates + b_gates).reshape(B, L, 4, MLSTM_HEADS)
    heads = lambda t: t.reshape(B, L, MLSTM_HEADS, MLSTM_HEAD_DIM)
    return heads(q), heads(k), heads(v), gates, xc, z


def mlstm_zero_state(B):
    return (jnp.zeros((B, MLSTM_HEADS, MLSTM_HEAD_DIM, MLSTM_HEAD_DIM), jnp.float32),
            jnp.zeros((B, MLSTM_HEADS, MLSTM_HEAD_DIM), jnp.float32),
            jnp.zeros((B, MLSTM_HEADS), jnp.float32))


def mlstm_scan(q, k, v, i_pre, f_pre, state):
    B, L, NH, dh = q.shape
    T = MLSTM_CHUNK
    nc = L // T
    f32 = jnp.float32

    def chunks(t):
        return jnp.moveaxis(t.astype(f32).reshape((B, nc, T) + t.shape[2:]), 1, 0)

    xs = (chunks(q), chunks(k) * (dh ** -0.5), chunks(v), chunks(i_pre),
          chunks(jax.nn.log_sigmoid(f_pre.astype(f32))))
    causal = jnp.tril(jnp.ones((T, T), dtype=bool))

    def step(carry, inp):
        C, n, m = carry
        qc, kc, vc, ic, lfc = inp
        b = jnp.moveaxis(jnp.cumsum(lfc, axis=1), 1, 2)
        ig = jnp.moveaxis(ic, 1, 2)
        dmat = jnp.where(causal, b[..., :, None] - b[..., None, :] + ig[..., None, :], -jnp.inf)
        inter = b + m[..., None]
        m_t = jnp.maximum(inter, jnp.max(dmat, axis=-1))
        a = jnp.einsum('bthd,bshd->bhts', qc, kc) * jnp.exp(dmat - m_t[..., None])
        w_int = jnp.exp(inter - m_t)
        num = (jnp.einsum('bhts,bshd->bthd', a, vc)
               + jnp.einsum('bhde,bthe->bthd', C, qc) * jnp.moveaxis(w_int, 1, 2)[..., None])
        den = jnp.moveaxis(jnp.sum(a, axis=-1) + w_int * jnp.einsum('bhe,bthe->bht', n, qc), 1, 2)
        floor = jnp.exp(-jnp.moveaxis(m_t, 1, 2))
        hc = num / jnp.maximum(jnp.abs(den), floor)[..., None]
        b_end = b[..., -1]
        g = b_end[..., None] - b + ig
        m_new = jnp.maximum(b_end + m, jnp.max(g, axis=-1))
        decay = jnp.exp(b_end + m - m_new)
        wg = jnp.moveaxis(jnp.exp(g - m_new[..., None]), 1, 2)[..., None]
        C_new = decay[..., None, None] * C + jnp.einsum('bshd,bshe->bhde', vc * wg, kc)
        n_new = decay[..., None] * n + jnp.sum(kc * wg, axis=1)
        return (C_new, n_new, m_new), hc

    state, hs = lax.scan(step, state, xs)
    h = jnp.moveaxis(hs, 0, 1).reshape(B, L, NH, dh).astype(q.dtype)
    return h, state


def mlstm_bidir(feats, st_fwd, st_bwd):
    q, k, v, gates = feats[0], feats[1], feats[2], feats[3]
    flip = lambda t: jnp.flip(t, axis=1)
    h_f, st_f = mlstm_scan(q, k, v, gates[:, :, 0], gates[:, :, 1], st_fwd)
    h_b, st_b = mlstm_scan(flip(q), flip(k), flip(v), flip(gates[:, :, 2]), flip(gates[:, :, 3]), st_bwd)
    return h_f + flip(h_b), st_f, st_b


def mlstm_output(h, xc, z, gn_w, skip, w_down):
    B, L = h.shape[0], h.shape[1]
    hf = h.astype(jnp.float32)
    mu = jnp.mean(hf, axis=-1, keepdims=True)
    var = jnp.mean(jnp.square(hf - mu), axis=-1, keepdims=True)
    hn = ((hf - mu) * lax.rsqrt(var + NORM_EPS)).reshape(B, L, MLSTM_INNER).astype(xc.dtype) * gn_w
    return ((hn + skip * xc) * jax.nn.silu(z)) @ w_down


def mlstm_mixer(a_lat, a_ctx, w_up, conv_w, conv_b, w_q, w_k, w_v, w_gates, b_gates,
                gn_w, skip, w_down, with_ctx_out):
    f_ctx = mlstm_features(a_ctx, w_up, conv_w, conv_b, w_q, w_k, w_v, w_gates, b_gates)
    f_lat = mlstm_features(a_lat, w_up, conv_w, conv_b, w_q, w_k, w_v, w_gates, b_gates)
    z0 = mlstm_zero_state(a_lat.shape[0])
    h_ctx, st_f, st_b = mlstm_bidir(f_ctx, z0, z0)
    h_lat, _, _ = mlstm_bidir(f_lat, st_f, st_b)
    y_lat = mlstm_output(h_lat, f_lat[4], f_lat[5], gn_w, skip, w_down)
    if not with_ctx_out:
        return y_lat, None
    return y_lat, mlstm_output(h_ctx, f_ctx[4], f_ctx[5], gn_w, skip, w_down)


def moe_swiglu(h, w_router, w1, w3, w2):
    N, D = h.shape
    logits = (h @ w_router).astype(jnp.float32)
    top_v, top_e = lax.top_k(logits, TOP_K)
    gates = jax.nn.softmax(top_v, axis=-1)
    A = N * TOP_K
    e_flat = top_e.reshape(A)
    tok = jnp.repeat(jnp.arange(N), TOP_K)
    g_flat = gates.reshape(A)
    order = jnp.argsort(e_flat)
    e_s, tok_s, g_s = e_flat[order], tok[order], g_flat[order]
    counts = jnp.bincount(e_flat, length=N_EXPERTS)
    starts = jnp.cumsum(counts) - counts
    padded = (counts + MOE_BLOCK - 1) // MOE_BLOCK * MOE_BLOCK
    pend = jnp.cumsum(padded)
    pstarts = pend - padded
    dest = pstarts[e_s] + jnp.arange(A) - starts[e_s]
    n_blocks = -(-(A + N_EXPERTS * (MOE_BLOCK - 1)) // MOE_BLOCK)
    P = n_blocks * MOE_BLOCK
    buf = jnp.zeros((P, D), h.dtype).at[dest].set(h[tok_s])
    block_e = jnp.minimum(jnp.searchsorted(pend, jnp.arange(n_blocks) * MOE_BLOCK, side='right'), N_EXPERTS - 1)

    def expert_block(args):
        xb, e = args
        return swiglu(xb, w1[e], w3[e], w2[e])

    yb = lax.map(expert_block, (buf.reshape(n_blocks, MOE_BLOCK, D), block_e)).reshape(P, D)
    return jnp.zeros((N, D), h.dtype).at[tok_s].add(yb[dest] * g_s[:, None].astype(h.dtype))


def setup_inputs(seed: int = 0) -> dict:
    key = jax.random.key(seed)
    ks = iter(jax.random.split(key, 64))
    nrm = lambda shape, s: s * jax.random.normal(next(ks), shape, jnp.float32)
    D = D_MODEL
    fbias = jnp.linspace(3.0, 6.0, MLSTM_HEADS, dtype=jnp.float32)
    zh = jnp.zeros((MLSTM_HEADS,), jnp.float32)
    gate_offset = jnp.concatenate([zh, fbias, zh, fbias])
    return {
        'x': nrm((BATCH, SEQ, D), 1.0),
        'c': nrm((BATCH, D), 1.0),
        'ctx': nrm((BATCH, CTX_LEN, D), 1.0),
        'c_ctx': nrm((D,), 1.0),
        'w_mod': nrm((DEPTH, D, N_MOD * D), 0.5 * D ** -0.5),
        'b_mod': nrm((DEPTH, N_MOD * D), 0.02),
        'norm_g': 1.0 + nrm((DEPTH, 2, D), 0.05),
        'final_g': 1.0 + nrm((D,), 0.05),
        'na_w_qkv': nrm((N_NA, D, 3 * D), D ** -0.5),
        'na_b_qkv': nrm((N_NA, 3 * D), 0.02),
        'na_rpb': nrm((N_NA, NA_HEADS, 2 * NA_WIN_ROWS - 1, 2 * NA_WIN_COLS - 1), 0.2),
        'na_w_out': nrm((N_NA, D, D), D ** -0.5),
        'na_b_out': nrm((N_NA, D), 0.02),
        'pool_w': nrm((N_POOL, POOL_GROUPS, POOL_GROUP_DIM, POOL_GROUP_DIM), POOL_GROUP_DIM ** -0.5),
        'pool_scale': 1.0 + nrm((N_POOL, D), 0.1),
        'ml_w_up': nrm((N_MLSTM, D, 2 * MLSTM_INNER), D ** -0.5),
        'ml_conv_w': nrm((N_MLSTM, MLSTM_CONV, MLSTM_INNER), MLSTM_CONV ** -0.5),
        'ml_conv_b': nrm((N_MLSTM, MLSTM_INNER), 0.02),
        'ml_w_q': nrm((N_MLSTM, MLSTM_QKV_NBLK, MLSTM_QKV_BLOCK, MLSTM_QKV_BLOCK), MLSTM_QKV_BLOCK ** -0.5),
        'ml_w_k': nrm((N_MLSTM, MLSTM_QKV_NBLK, MLSTM_QKV_BLOCK, MLSTM_QKV_BLOCK), MLSTM_QKV_BLOCK ** -0.5),
        'ml_w_v': nrm((N_MLSTM, MLSTM_QKV_NBLK, MLSTM_QKV_BLOCK, MLSTM_QKV_BLOCK), MLSTM_QKV_BLOCK ** -0.5),
        'ml_w_gates': nrm((N_MLSTM, 3 * MLSTM_INNER, 4 * MLSTM_HEADS), (3 * MLSTM_INNER) ** -0.5),
        'ml_b_gates': gate_offset + nrm((N_MLSTM, 4 * MLSTM_HEADS), 0.1),
        'ml_gn_w': 1.0 + nrm((N_MLSTM, MLSTM_INNER), 0.05),
        'ml_skip': 1.0 + nrm((N_MLSTM, MLSTM_INNER), 0.05),
        'ml_w_down': nrm((N_MLSTM, MLSTM_INNER, D), MLSTM_INNER ** -0.5),
        'ffn_w1': nrm((N_DENSE, D, FFN_DENSE), D ** -0.5),
        'ffn_w3': nrm((N_DENSE, D, FFN_DENSE), D ** -0.5),
        'ffn_w2': nrm((N_DENSE, FFN_DENSE, D), FFN_DENSE ** -0.5),
        'moe_w_router': nrm((N_MOE, D, N_EXPERTS), D ** -0.5),
        'moe_w1': nrm((N_MOE, N_EXPERTS, D, FFN_EXPERT), D ** -0.5),
        'moe_w3': nrm((N_MOE, N_EXPERTS, D, FFN_EXPERT), D ** -0.5),
        'moe_w2': nrm((N_MOE, N_EXPERTS, FFN_EXPERT, D), FFN_EXPERT ** -0.5),
    }


def reference(x, c, ctx, c_ctx, w_mod, b_mod, norm_g, final_g,
              na_w_qkv, na_b_qkv, na_rpb, na_w_out, na_b_out,
              pool_w, pool_scale,
              ml_w_up, ml_conv_w, ml_conv_b, ml_w_q, ml_w_k, ml_w_v, ml_w_gates, ml_b_gates,
              ml_gn_w, ml_skip, ml_w_down,
              ffn_w1, ffn_w3, ffn_w2,
              moe_w_router, moe_w1, moe_w3, moe_w2):
    B, L, D = x.shape
    h_lat, h_ctx = x, ctx
    for i in range(DEPTH):
        last = i == DEPTH - 1
        kind = i % N_MIXERS
        j = i // N_MIXERS
        sh1, sc1, g1, sh2, sc2, g2 = adaln(c, w_mod[i], b_mod[i])
        csh1, csc1, cg1, csh2, csc2, cg2 = adaln(c_ctx, w_mod[i], b_mod[i])

        a_lat = modulate(rmsnorm(h_lat, norm_g[i, 0]), sh1, sc1)
        if kind == 1:
            y_lat = multiscale_pool(a_lat, pool_w[j], pool_scale[j])
            if not last:
                a_ctx = modulate(rmsnorm(h_ctx, norm_g[i, 0]), csh1, csc1)
                y_ctx = multiscale_pool(a_ctx, pool_w[j], pool_scale[j])
        else:
            a_ctx = modulate(rmsnorm(h_ctx, norm_g[i, 0]), csh1, csc1)
            if kind == 0:
                y_lat, y_ctx = na_mixer(a_lat, a_ctx, na_w_qkv[j], na_b_qkv[j], na_rpb[j],
                                        na_w_out[j], na_b_out[j], not last)
            else:
                y_lat, y_ctx = mlstm_mixer(a_lat, a_ctx, ml_w_up[j], ml_conv_w[j], ml_conv_b[j],
                                           ml_w_q[j], ml_w_k[j], ml_w_v[j], ml_w_gates[j], ml_b_gates[j],
                                           ml_gn_w[j], ml_skip[j], ml_w_down[j], not last)
        h_lat = h_lat + g1 * y_lat
        if not last:
            h_ctx = h_ctx + cg1 * y_ctx

        e = i // 2
        b_lat = modulate(rmsnorm(h_lat, norm_g[i, 1]), sh2, sc2)
        if i % 2 == 0:
            f_lat = swiglu(b_lat, ffn_w1[e], ffn_w3[e], ffn_w2[e])
            if not last:
                b_ctx = modulate(rmsnorm(h_ctx, norm_g[i, 1]), csh2, csc2)
                f_ctx = swiglu(b_ctx, ffn_w1[e], ffn_w3[e], ffn_w2[e])
        else:
            if last:
                f_lat = moe_swiglu(b_lat.reshape(B * L, D), moe_w_router[e], moe_w1[e], moe_w3[e],
                                   moe_w2[e]).reshape(B, L, D)
            else:
                b_ctx = modulate(rmsnorm(h_ctx, norm_g[i, 1]), csh2, csc2)
                n_ctx = b_ctx.shape[1]
                toks = jnp.concatenate([b_lat.reshape(B * L, D), b_ctx.reshape(B * n_ctx, D)], axis=0)
                f_all = moe_swiglu(toks, moe_w_router[e], moe_w1[e], moe_w3[e], moe_w2[e])
                f_lat = f_all[:B * L].reshape(B, L, D)
                f_ctx = f_all[B * L:].reshape(B, n_ctx, D)
        h_lat = h_lat + g2 * f_lat
        if not last:
            h_ctx = h_ctx + cg2 * f_ctx
    return rmsnorm(h_lat, final_g)
```

```cpp
#include <hip/hip_runtime.h>
#include <cstdio>
#include <cstdint>

#define LAS __attribute__((address_space(3)))
#define GAS __attribute__((address_space(1)))
typedef unsigned short bf16_t;
typedef short bf16x8 __attribute__((ext_vector_type(8)));
typedef float f32x4 __attribute__((ext_vector_type(4)));
typedef float f32x2 __attribute__((ext_vector_type(2)));
typedef unsigned u32x4 __attribute__((ext_vector_type(4)));
typedef unsigned u32x2 __attribute__((ext_vector_type(2)));

constexpr int D = 1024, NB = 4, SEQ = 8192, CTXL = 256, DEPTH = 4;
constexpr int NLAT = NB * SEQ, NCTX = NB * CTXL, MT = NLAT + NCTX;
constexpr int GRIDW = 64, GROWS = SEQ / GRIDW;
constexpr int NAH = 16, NAHD = 64;
constexpr int MLI = 2048, MLH = 4, MLHD = 512, MLCH = 64;
constexpr int FFD = 2816, NEXP = 8, FFE = 3584;
constexpr float NORM_EPS = 1e-6f;
constexpr int NMODV = 8;

__device__ __forceinline__ float bf_lo(unsigned w) { return __uint_as_float(w << 16); }
__device__ __forceinline__ float bf_hi(unsigned w) { return __uint_as_float(w & 0xffff0000u); }
__device__ __forceinline__ float bf2f(bf16_t b) { return __uint_as_float(((unsigned)b) << 16); }
__device__ __forceinline__ unsigned cvt_pk_bf16(float lo, float hi) { unsigned r; asm volatile("v_cvt_pk_bf16_f32 %0, %1, %2" : "=v"(r) : "v"(lo), "v"(hi)); return r; }
__device__ __forceinline__ bf16_t f2bf(float f) { return (bf16_t)(cvt_pk_bf16(f, 0.f) & 0xffffu); }
__device__ __forceinline__ float fast_rcp(float x) { return __builtin_amdgcn_rcpf(x); }
__device__ __forceinline__ float silu_f(float x) { return x * fast_rcp(1.0f + __expf(-x)); }
template <int CTRL, int RMASK> __device__ __forceinline__ float dpp_get(float src) { return __builtin_bit_cast(float, __builtin_amdgcn_update_dpp(0, __builtin_bit_cast(int, src), CTRL, RMASK, 0xF, false)); }
__device__ __forceinline__ float wave_sum(float v) {
    v += dpp_get<0xB1, 0xF>(v);
    v += dpp_get<0x4E, 0xF>(v);
    v += dpp_get<0x141, 0xF>(v);
    v += dpp_get<0x140, 0xF>(v);
    v += dpp_get<0x142, 0xA>(v);
    v += dpp_get<0x143, 0xC>(v);
    return __builtin_bit_cast(float, __builtin_amdgcn_readlane(__builtin_bit_cast(int, v), 63));
}
__device__ __forceinline__ int row_cond(int row) { return row < NLAT ? (row >> 13) : 4; }

namespace pg8 {
constexpr int BM = 256, BK = 64, HALF = 128, HTB = HALF * BK * 2, STAGE_BYTES = 8 * HTB, NXCD = 8, WGM = 8;
__host__ __device__ __forceinline__ int lds_byte(int r, int c) { const int st = (r >> 4) * 2 + (c >> 5), rr = r & 15, cc = c & 31, ob = rr * 64 + cc * 2; return st * 1024 + (ob ^ (((ob >> 9) & 1) << 5)); }
__host__ __device__ __forceinline__ void stage_rc(int b, int& R, int& C) { const int st = b / 1024, sb = b % 1024, swz = sb ^ (((sb >> 9) & 1) << 5); R = (st >> 1) * 16 + swz / 64; C = (st & 1) * 32 + (swz % 64) / 2; }
__host__ __device__ __forceinline__ int perm32(int rho) { const int n = rho >> 4, i = rho & 15; return 8 * (i >> 2) + 4 * n + (i & 3); }

struct Unit {
    const char* a;
    const char* b;
    const int* rows;
    int nrows;
    int orow, ocol;
    int aux;
};
__device__ __forceinline__ bool tile_order(int i, int G, int c, int nM, int nN, int& pm, int& pn) {
    const int nwg = nM * nN; const long L = (long)i * G + c; if (L >= nwg) return false;
    int wgid = (int)L; { const int q = nwg / NXCD, r = nwg % NXCD, xcd = wgid % NXCD, off = wgid / NXCD; wgid = (xcd < r ? xcd * (q + 1) : r * (q + 1) + (xcd - r) * q) + off; }
    const int nig = WGM * nN, gid = wgid / nig, fm = gid * WGM, gsz = (nM - fm) < WGM ? (nM - fm) : WGM;
    pm = fm + ((wgid % nig) % gsz); pn = (wgid % nig) / gsz; return true;
}
struct PlainOrder {
    const bf16_t* A; const bf16_t* Bt; int lda, ldb, nM, nN, G, c, a_pn, ocol_step, pm0;
    __device__ __forceinline__ bool next(int i, Unit& u) const {
        int pm, pn; if (!tile_order(i, G, c, nM, nN, pm, pn)) return false;
        pm += pm0;
        u.a = (const char*)(A + (size_t)pm * BM * lda + (size_t)pn * a_pn); u.b = (const char*)(Bt + (size_t)pn * BM * ldb);
        u.rows = nullptr; u.nrows = 256; u.orow = pm * BM; u.ocol = pn * ocol_step; u.aux = row_cond(pm * BM); return true;
    }
};

struct EpiBf16 {
    static constexpr bool PERM = true;
    bf16_t* O; int ldc; const float* bias; int split_cols; size_t split_stride;
    __device__ __forceinline__ void operator()(const f32x4 (&acc)[2][2][4][2], const Unit& u, int wr, int wc, int fr, int fq) const {
        const int row0 = u.orow + wr * 64 + fr; int colt = u.ocol; bf16_t* base = O;
        if (split_cols) { const int t = colt / split_cols; base += (size_t)t * split_stride; colt -= t * split_cols; }
        const int col0 = colt + wc * 32 + 8 * fq, bcol0 = u.ocol + wc * 32 + 8 * fq;
        f32x4 bv[2][2];
#pragma unroll
        for (int bj = 0; bj < 2; ++bj)
#pragma unroll
            for (int n = 0; n < 2; ++n) bv[bj][n] = bias ? *(const f32x4*)(bias + bcol0 + bj * HALF + 4 * n) : (f32x4){0.f, 0.f, 0.f, 0.f};
#pragma unroll
        for (int ai = 0; ai < 2; ++ai)
#pragma unroll
            for (int m = 0; m < 4; ++m) { bf16_t* rowp = base + (size_t)(row0 + ai * HALF + m * 16) * ldc + col0;
#pragma unroll
                for (int bj = 0; bj < 2; ++bj) { const f32x4 v0 = acc[ai][bj][m][0] + bv[bj][0], v1 = acc[ai][bj][m][1] + bv[bj][1];
                    u32x4 w; w.x = cvt_pk_bf16(v0[0], v0[1]); w.y = cvt_pk_bf16(v0[2], v0[3]); w.z = cvt_pk_bf16(v1[0], v1[1]); w.w = cvt_pk_bf16(v1[2], v1[3]);
                    *(u32x4*)(rowp + bj * HALF) = w; } }
    }
};
struct EpiSwiglu {
    static constexpr bool PERM = true;
    bf16_t* T; int ldc;
    __device__ __forceinline__ void operator()(const f32x4 (&acc)[2][2][4][2], const Unit& u, int wr, int wc, int fr, int fq) const {
        const int row0 = u.orow + wr * 64 + fr, col0 = u.ocol + wc * 32 + 8 * fq;
#pragma unroll
        for (int ai = 0; ai < 2; ++ai)
#pragma unroll
            for (int m = 0; m < 4; ++m) { bf16_t* rowp = T + (size_t)(row0 + ai * HALF + m * 16) * ldc + col0;
                float t[8];
#pragma unroll
                for (int n = 0; n < 2; ++n)
#pragma unroll
                    for (int j = 0; j < 4; ++j) t[n * 4 + j] = silu_f(acc[ai][0][m][n][j]) * acc[ai][1][m][n][j];
                u32x4 w; w.x = cvt_pk_bf16(t[0], t[1]); w.y = cvt_pk_bf16(t[2], t[3]); w.z = cvt_pk_bf16(t[4], t[5]); w.w = cvt_pk_bf16(t[6], t[7]);
                *(u32x4*)rowp = w; }
    }
};
typedef int v8i32 __attribute__((ext_vector_type(8)));
struct EpiSwigluF8 {
    static constexpr bool PERM = true;
    unsigned char* T; int ldc; float ascale, oscale; int dry;
    __device__ __forceinline__ void operator()(const f32x4 (&acc)[2][2][4][2], const Unit& u, int wr, int wc, int fr, int fq) const {
        if (dry) { float k = 0.f;
#pragma unroll
            for (int ai = 0; ai < 2; ++ai)
#pragma unroll
                for (int bj = 0; bj < 2; ++bj)
#pragma unroll
                    for (int m = 0; m < 4; ++m)
#pragma unroll
                        for (int n = 0; n < 2; ++n) k += acc[ai][bj][m][n][0];
            if (k == 1.2345e30f) T[0] = 1; return; }
        const int row0 = u.orow + wr * 64 + fr, col0 = u.ocol + wc * 32 + 8 * fq;
#pragma unroll
        for (int ai = 0; ai < 2; ++ai)
#pragma unroll
            for (int m = 0; m < 4; ++m) { unsigned char* rowp = T + (size_t)(row0 + ai * HALF + m * 16) * ldc + col0;
                float t[8];
                const float kexp = -1.4426950408889634f * ascale, knum = ascale * ascale * oscale;
#pragma unroll
                for (int n = 0; n < 2; ++n)
#pragma unroll
                    for (int jp = 0; jp < 2; ++jp) { const f32x2 u2 = (f32x2){acc[ai][0][m][n][2 * jp], acc[ai][0][m][n][2 * jp + 1]}, v2 = (f32x2){acc[ai][1][m][n][2 * jp], acc[ai][1][m][n][2 * jp + 1]};
                        const f32x2 ea = u2 * kexp; f32x2 d2 = (f32x2){__builtin_amdgcn_exp2f(ea[0]), __builtin_amdgcn_exp2f(ea[1])}; d2 = d2 + 1.0f;
                        const f32x2 r2 = (f32x2){fast_rcp(d2[0]), fast_rcp(d2[1])}; const f32x2 t2 = ((u2 * v2) * knum) * r2;
                        t[n * 4 + 2 * jp] = __builtin_amdgcn_fmed3f(t2[0], -448.f, 448.f); t[n * 4 + 2 * jp + 1] = __builtin_amdgcn_fmed3f(t2[1], -448.f, 448.f); }
                u32x2 w; int p0 = __builtin_amdgcn_cvt_pk_fp8_f32(t[0], t[1], 0, false); p0 = __builtin_amdgcn_cvt_pk_fp8_f32(t[2], t[3], p0, true);
                int p1 = __builtin_amdgcn_cvt_pk_fp8_f32(t[4], t[5], 0, false); p1 = __builtin_amdgcn_cvt_pk_fp8_f32(t[6], t[7], p1, true);
                w.x = (unsigned)p0; w.y = (unsigned)p1; *(u32x2*)rowp = w; }
    }
};
struct EpiBf16S {
    static constexpr bool PERM = true;
    bf16_t* O; int ldc; float ascale;
    __device__ __forceinline__ void operator()(const f32x4 (&acc)[2][2][4][2], const Unit& u, int wr, int wc, int fr, int fq) const {
        const int row0 = u.orow + wr * 64 + fr, col0 = u.ocol + wc * 32 + 8 * fq;
#pragma unroll
        for (int ai = 0; ai < 2; ++ai)
#pragma unroll
            for (int m = 0; m < 4; ++m) { bf16_t* rowp = O + (size_t)(row0 + ai * HALF + m * 16) * ldc + col0;
#pragma unroll
                for (int bj = 0; bj < 2; ++bj) { const f32x4 v0 = acc[ai][bj][m][0] * ascale, v1 = acc[ai][bj][m][1] * ascale;
                    u32x4 w; w.x = cvt_pk_bf16(v0[0], v0[1]); w.y = cvt_pk_bf16(v0[2], v0[3]); w.z = cvt_pk_bf16(v1[0], v1[1]); w.w = cvt_pk_bf16(v1[2], v1[3]);
                    *(u32x4*)(rowp + bj * HALF) = w; } }
    }
};
struct EpiRes {
    static constexpr bool PERM = false;
    bf16_t* H; const float* gs; const float* gb; int cstride; int dry; const float* in_lat; const float* in_ctx; float sc = 1.0f;
    __device__ __forceinline__ void operator()(const f32x4 (&acc)[2][2][4][2], const Unit& u, int wr, int wc, int fr, int fq) const {
        const int row0 = u.orow + wr * 64 + fr, col0 = u.ocol + wc * 32 + 4 * fq;
        const float* gsc = gs + (size_t)u.aux * cstride + col0; const float* gbc = gb ? gb + (size_t)u.aux * cstride + col0 : nullptr;
        f32x4 gv[2][2], bv[2][2]; const float dscale = dry ? 0.f : 1.f;
#pragma unroll
        for (int bj = 0; bj < 2; ++bj)
#pragma unroll
            for (int n = 0; n < 2; ++n) { gv[bj][n] = *(const f32x4*)(gsc + bj * HALF + n * 16) * sc; bv[bj][n] = gbc ? *(const f32x4*)(gbc + bj * HALF + n * 16) : (f32x4){0.f, 0.f, 0.f, 0.f}; }
        if (in_lat) {
#pragma unroll
            for (int am = 0; am < 4; ++am) { const int ai = am >> 1, m0 = 2 * (am & 1); f32x4 hv[2][2][2];
#pragma unroll
                for (int mm = 0; mm < 2; ++mm) { const int row = row0 + ai * HALF + (m0 + mm) * 16; const float* srcp = u.orow < NLAT ? in_lat + (size_t)row * D + col0 : in_ctx + (size_t)(row - NLAT) * D + col0;
#pragma unroll
                    for (int bj = 0; bj < 2; ++bj)
#pragma unroll
                        for (int n = 0; n < 2; ++n) hv[mm][bj][n] = *(const f32x4*)(srcp + bj * HALF + n * 16); }
#pragma unroll
                for (int mm = 0; mm < 2; ++mm) { bf16_t* rowp = H + (size_t)(row0 + ai * HALF + (m0 + mm) * 16) * D + col0;
#pragma unroll
                    for (int bj = 0; bj < 2; ++bj)
#pragma unroll
                        for (int n = 0; n < 2; ++n) { const f32x4 h = hv[mm][bj][n] + (gv[bj][n] * acc[ai][bj][m0 + mm][n] + bv[bj][n]) * dscale;
                            u32x2 ow; ow.x = cvt_pk_bf16(h[0], h[1]); ow.y = cvt_pk_bf16(h[2], h[3]); *(u32x2*)(rowp + bj * HALF + n * 16) = ow; } }
                asm volatile("" ::: "memory"); }
        } else {
#pragma unroll
            for (int ai = 0; ai < 2; ++ai) { u32x2 hw[4][2][2];
#pragma unroll
                for (int m = 0; m < 4; ++m) { const bf16_t* rowp = H + (size_t)(row0 + ai * HALF + m * 16) * D + col0;
#pragma unroll
                    for (int bj = 0; bj < 2; ++bj)
#pragma unroll
                        for (int n = 0; n < 2; ++n) hw[m][bj][n] = *(const u32x2*)(rowp + bj * HALF + n * 16); }
#pragma unroll
                for (int m = 0; m < 4; ++m) { bf16_t* rowp = H + (size_t)(row0 + ai * HALF + m * 16) * D + col0;
#pragma unroll
                    for (int bj = 0; bj < 2; ++bj)
#pragma unroll
                        for (int n = 0; n < 2; ++n) { const u32x2 w_ = hw[m][bj][n]; f32x4 h = (f32x4){bf_lo(w_.x), bf_hi(w_.x), bf_lo(w_.y), bf_hi(w_.y)}; h = h + (gv[bj][n] * acc[ai][bj][m][n] + bv[bj][n]) * dscale;
                            u32x2 ow; ow.x = cvt_pk_bf16(h[0], h[1]); ow.y = cvt_pk_bf16(h[2], h[3]); *(u32x2*)(rowp + bj * HALF + n * 16) = ow; } }
                asm volatile("" ::: "memory"); }
        }
    }
};

template <class Epi, class Sched, bool GATHER, bool FP8 = false>
__device__ __forceinline__ void gemm_phase(LAS unsigned char* lds, const int lda, const int ldb, const int K, const Sched& S, const Epi& E) {
    int tid = threadIdx.x; asm volatile("" : "+v"(tid));
    const int wid = __builtin_amdgcn_readfirstlane(tid >> 6), lane = tid & 63, wr = wid >> 2, wc = wid & 3, fr = lane & 15, fq = lane >> 4;
    const int nt = K / BK;
    unsigned voffA[2], voffB[2];
#pragma unroll
    for (int i = 0; i < 2; ++i) { int R, C; stage_rc(tid * 16 + i * 8192, R, C); const int Rb = Epi::PERM ? ((R & ~31) + perm32(R & 31)) : R;
        voffA[i] = (unsigned)(R * lda + C) * 2u; voffB[i] = (unsigned)(Rb * ldb + C) * 2u; }
    const size_t kstep = (size_t)(BK * 2);
    const size_t hstepA = GATHER ? (size_t)0 : (size_t)HALF * lda * 2, hstepB = (size_t)HALF * ldb * 2;
    const unsigned ldsw = (unsigned)wid * 1024u;
    const int aoff = lds_byte(wr * 64 + fr, fq * 8), boff = lds_byte(wc * 32 + fr, fq * 8);
#define PG8_SA(b, h) (((b) * 2 + (h)) * HTB)
#define PG8_SB(b, h) ((4 + (b) * 2 + (h)) * HTB)
#define PG8_STAGE(bufoff, gbase, voff) do { _Pragma("unroll") for (int _i = 0; _i < 2; ++_i) \
        __builtin_amdgcn_global_load_lds((const unsigned*)((const char*)(gbase) + (voff)[_i]), (LAS unsigned*)(lds + (bufoff) + ldsw + _i * 8192), 16, 0, 0); } while (0)
#define PG8_LD8(p_) ({ const u32x4 lo_ = *(const LAS u32x4*)(p_), hi_ = *(const LAS u32x4*)((p_) + 1024); (v8i32){(int)lo_.x, (int)lo_.y, (int)lo_.z, (int)lo_.w, (int)hi_.x, (int)hi_.y, (int)hi_.z, (int)hi_.w}; })
#define PG8_LDA(dst, b, h) do { if constexpr (FP8) { _Pragma("unroll") for (int m = 0; m < 4; ++m) dst##8[m] = PG8_LD8(lds + PG8_SA(b, h) + aoff + m * 2048); } \
        else { _Pragma("unroll") for (int m = 0; m < 4; ++m) _Pragma("unroll") for (int k = 0; k < 2; ++k) dst[m][k] = *(const LAS bf16x8*)(lds + PG8_SA(b, h) + aoff + m * 2048 + k * 1024); } } while (0)
#define PG8_LDB(dst, b, h) do { if constexpr (FP8) { _Pragma("unroll") for (int n = 0; n < 2; ++n) dst##8[n] = PG8_LD8(lds + PG8_SB(b, h) + boff + n * 2048); } \
        else { _Pragma("unroll") for (int n = 0; n < 2; ++n) _Pragma("unroll") for (int k = 0; k < 2; ++k) dst[n][k] = *(const LAS bf16x8*)(lds + PG8_SB(b, h) + boff + n * 2048 + k * 1024); } } while (0)
#define PG8_MMA(ai, bj, At, Bt) do { __builtin_amdgcn_s_setprio(1); _Pragma("unroll") for (int m = 0; m < 4; ++m) _Pragma("unroll") for (int n = 0; n < 2; ++n) { \
        if constexpr (FP8) asm volatile("s_nop 1\n\tv_mfma_scale_f32_16x16x128_f8f6f4 %0, %1, %2, %0, %3, %3 op_sel_hi:[0,0,0]" : "+v"(acc[ai][bj][m][n]) : "v"(Bt##8[n]), "v"(At##8[m]), "v"(f8one)); \
        else { _Pragma("unroll") for (int k = 0; k < 2; ++k) acc[ai][bj][m][n] = __builtin_amdgcn_mfma_f32_16x16x32_bf16(Bt[n][k], At[m][k], acc[ai][bj][m][n], 0, 0, 0); } } \
        __builtin_amdgcn_s_setprio(0); } while (0)
#define PG8_WAIT_V(n) asm volatile("s_waitcnt vmcnt(" #n ")" ::: "memory")
#define PG8_WAIT_L(n) asm volatile("s_waitcnt lgkmcnt(" #n ")" ::: "memory")
#define PG8_BAR __builtin_amdgcn_s_barrier()
#define PG8_SCHED __builtin_amdgcn_sched_barrier(0)
#define PG8_GOFF(dst, un) do { _Pragma("unroll") for (int _h = 0; _h < 2; ++_h) _Pragma("unroll") for (int _i = 0; _i < 2; ++_i) { int _R, _C; stage_rc(tid * 16 + _i * 8192, _R, _C); const int _s = _h * HALF + _R; \
        const int _r = (_s < (un).nrows) ? (un).rows[_s] : 0; dst[_h][_i] = (unsigned)_r * (unsigned)(lda * 2) + (unsigned)_C * 2u; } \
        asm volatile("" : "+v"(dst[0][0]), "+v"(dst[0][1]), "+v"(dst[1][0]), "+v"(dst[1][1])); } while (0)
    Unit cur, nxt; int ui = 0;
    if (!S.next(0, cur)) return;
#ifdef GEMM_STAGGER
    { const int sg = (blockIdx.x >> 3) & 3; for (int i = 0; i < sg; ++i) __builtin_amdgcn_s_sleep(GEMM_STAGGER); }
#endif
    f32x4 acc[2][2][4][2];
#pragma unroll
    for (int a = 0; a < 2; ++a)
#pragma unroll
        for (int b = 0; b < 2; ++b)
#pragma unroll
            for (int m = 0; m < 4; ++m)
#pragma unroll
                for (int n = 0; n < 2; ++n) acc[a][b][m][n] = (f32x4){0.f, 0.f, 0.f, 0.f};
    bf16x8 At[4][2], B0[2][2], B1[2][2]; v8i32 At8[4], B08[2], B18[2];
    const int f8one = 0x7f7f7f7f;
    unsigned oC[2][2];
    LAS u32x4* oNl = (LAS u32x4*)(lds + STAGE_BYTES) + tid;
    if constexpr (GATHER) { PG8_GOFF(oC, cur); }
    else {
#pragma unroll
        for (int h = 0; h < 2; ++h)
#pragma unroll
            for (int i = 0; i < 2; ++i) oC[h][i] = voffA[i];
    }
    const char* cA = cur.a; const char* cB = cur.b;
    PG8_STAGE(PG8_SB(0, 0), cB, voffB); PG8_STAGE(PG8_SB(0, 1), cB + hstepB, voffB); PG8_STAGE(PG8_SA(0, 0), cA, oC[0]); PG8_STAGE(PG8_SA(0, 1), cA + hstepA, oC[1]);
    if (wr == 1) PG8_BAR;
    PG8_WAIT_V(2); PG8_BAR;
    PG8_STAGE(PG8_SB(1, 0), cB + kstep, voffB); PG8_STAGE(PG8_SA(1, 0), cA + kstep, oC[0]); PG8_STAGE(PG8_SB(1, 1), cB + hstepB + kstep, voffB);
    PG8_WAIT_V(6); PG8_BAR;
    for (;;) {
        const bool has_next = S.next(ui + 1, nxt);
        if constexpr (GATHER) { unsigned oN[2][2]; if (has_next) { PG8_GOFF(oN, nxt); } else {
#pragma unroll
            for (int h = 0; h < 2; ++h)
#pragma unroll
                for (int i = 0; i < 2; ++i) oN[h][i] = oC[h][i]; }
            *oNl = (u32x4){oN[0][0], oN[0][1], oN[1][0], oN[1][1]}; }
        const char* nA = has_next ? nxt.a : cA; const char* nB = has_next ? nxt.b : cB;
        for (int t = 0; t < nt; t += 2) {
            const bool last = (t == nt - 2);
            const char* a1 = cA + (size_t)(t + 1) * kstep;
            const char* a2 = last ? nA : cA + (size_t)(t + 2) * kstep; const char* b2 = last ? nB : cB + (size_t)(t + 2) * kstep;
            const char* a3 = a2 + kstep; const char* b3 = b2 + kstep;
            PG8_LDB(B0, 0, 0); PG8_LDB(B1, 0, 1); PG8_SCHED; PG8_LDA(At, 0, 0); PG8_STAGE(PG8_SA(1, 1), a1 + hstepA, oC[1]);
            if constexpr (GATHER) { if (last) { const u32x4 t4 = *oNl; oC[0][0] = t4.x; oC[0][1] = t4.y; oC[1][0] = t4.z; oC[1][1] = t4.w; } }
            PG8_WAIT_V(8); PG8_WAIT_L(0); PG8_BAR; PG8_MMA(0, 0, At, B0); PG8_MMA(0, 1, At, B1); PG8_BAR; PG8_SCHED;
            PG8_LDA(At, 0, 1); PG8_STAGE(PG8_SB(0, 0), b2, voffB); PG8_STAGE(PG8_SB(0, 1), b2 + hstepB, voffB); PG8_STAGE(PG8_SA(0, 0), a2, oC[0]);
            PG8_WAIT_V(8); PG8_WAIT_L(0); PG8_BAR; PG8_MMA(1, 0, At, B0); PG8_MMA(1, 1, At, B1); PG8_BAR; PG8_SCHED;
            PG8_LDB(B0, 1, 0); PG8_LDB(B1, 1, 1); PG8_SCHED; PG8_LDA(At, 1, 0); PG8_STAGE(PG8_SA(0, 1), a2 + hstepA, oC[1]);
            PG8_WAIT_V(8); PG8_WAIT_L(0); PG8_BAR; PG8_MMA(0, 0, At, B0); PG8_MMA(0, 1, At, B1); PG8_BAR; PG8_SCHED;
            PG8_LDA(At, 1, 1); PG8_STAGE(PG8_SB(1, 0), b3, voffB); PG8_STAGE(PG8_SB(1, 1), b3 + hstepB, voffB); PG8_STAGE(PG8_SA(1, 0), a3, oC[0]);
            PG8_WAIT_V(8); PG8_WAIT_L(0); PG8_BAR; PG8_MMA(1, 0, At, B0); PG8_MMA(1, 1, At, B1); PG8_BAR; PG8_SCHED;
        }
#ifndef GEMM_NOALIGN
        if (wr == 0) PG8_BAR;
#endif
        E(acc, cur, wr, wc, fr, fq);
        if (!has_next) break;
#pragma unroll
        for (int a = 0; a < 2; ++a)
#pragma unroll
            for (int b = 0; b < 2; ++b)
#pragma unroll
                for (int m = 0; m < 4; ++m)
#pragma unroll
                    for (int n = 0; n < 2; ++n) acc[a][b][m][n] = (f32x4){0.f, 0.f, 0.f, 0.f};
        cur = nxt; cA = nA; cB = nB; ++ui;
#ifndef GEMM_NOALIGN
        if (wr == 1) PG8_BAR;
#endif
    }
    PG8_WAIT_V(0);
#ifdef GEMM_NOALIGN
    if (wr == 0) PG8_BAR;
#endif
    PG8_BAR;
#undef PG8_SA
#undef PG8_SB
#undef PG8_STAGE
#undef PG8_LDA
#undef PG8_LDB
#undef PG8_MMA
#undef PG8_LD8
#undef PG8_WAIT_V
#undef PG8_WAIT_L
#undef PG8_BAR
#undef PG8_SCHED
#undef PG8_GOFF
}
}
constexpr size_t MiB = (size_t)1 << 20;
constexpr size_t WS_CTL = 0, CTL_ZERO_BYTES = 1 * MiB;
constexpr size_t WS_MOD = 1 * MiB;
constexpr size_t WS_WGT = 2 * MiB;
constexpr size_t WS_LIST = 3 * MiB;
constexpr size_t WS_POS = 5 * MiB;
constexpr size_t WS_GATE = 6 * MiB;
constexpr size_t WS_H = 8 * MiB;
constexpr size_t WS_WQKV = 140 * MiB, WS_WOUT = 152 * MiB, WS_WPOOL = 156 * MiB, WS_WUP = 157 * MiB, WS_WDOWN = 165 * MiB, WS_WF13 = 169 * MiB, WS_WF2 = 191 * MiB;
constexpr size_t WS_A = 202 * MiB;
constexpr size_t WS_R = 268 * MiB;
constexpr size_t WS_Q = WS_R, WS_K = WS_R + 66 * MiB, WS_V = WS_R + 132 * MiB, WS_O = WS_R + 198 * MiB;
constexpr size_t WS_T = WS_R;
constexpr size_t WS_PL = WS_R;
constexpr size_t WS_XM = WS_R, WS_Z = WS_R + 132 * MiB, WS_XC = WS_R + 264 * MiB, WS_GT = WS_R + 396 * MiB, WS_HF = WS_R + 399 * MiB, WS_HB = WS_R + 531 * MiB, WS_OA = WS_XM;
constexpr size_t WS_MT = WS_R, WS_MY = WS_R + 238 * MiB, WS_AG = WS_R + 374 * MiB, WS_WM13 = 778 * MiB, WS_WM2 = 890 * MiB;
constexpr size_t WS_END = 964 * MiB;
constexpr int MOE_CH = 136;
static_assert(WS_HB + 132 * MiB <= WS_END && WS_WM2 + 56 * MiB <= WS_END && WS_MY + 136 * MiB <= WS_AG && WS_AG + 136 * MiB <= WS_WM13, "ws map");
constexpr int CW_BAR = 4096;
constexpr int CW_CNT = 1024;

constexpr int LDS_BYTES = 163840;
constexpr int MISC_OFF = LDS_BYTES - 256;

#define RLX_AGENT __ATOMIC_RELAXED, __HIP_MEMORY_SCOPE_AGENT
#define LDS_WAIT() asm volatile("s_waitcnt lgkmcnt(0)" ::: "memory")
#define VM_WAIT() asm volatile("s_waitcnt vmcnt(0)" ::: "memory")

#define XB_TMO      128
#define XB_XCNT(j)  (256  + 64 * (j))
#define XB_XSUB(j)  (1280 + 64 * (j))
#define XB_XGEN(j)  (2304 + 64 * (j))
#define XB_TOP      3328
#define XB_TOPGEN   3392
#define XCD_BAR_WORDS 3456
#define XB_SPIN_CAP (1u << 20)
__device__ __forceinline__ unsigned xb_ld(unsigned* p)              { return __hip_atomic_load(p, __ATOMIC_RELAXED, __HIP_MEMORY_SCOPE_AGENT); }
__device__ __forceinline__ unsigned xb_add(unsigned* p, unsigned v) { return __hip_atomic_fetch_add(p, v, __ATOMIC_RELAXED, __HIP_MEMORY_SCOPE_AGENT); }
__device__ __forceinline__ unsigned xb_xcc_id() { return (unsigned)__builtin_amdgcn_s_getreg((3 << 11) | 20) & 0xFu; }
#define XB_SPIN(cond, bar) do { unsigned _sp = 0; while (cond) { __builtin_amdgcn_s_sleep(1); \
    if ((++_sp & 255u) == 0u) { if (xb_ld(&(bar)[XB_TMO])) break; if (_sp > XB_SPIN_CAP) { atomicAdd(&(bar)[XB_TMO], 1u); break; } } } } while (0)
struct XcdBarrier { unsigned* bar; unsigned x; volatile LAS unsigned* st; int wave; };
__device__ __forceinline__ int xb_lane() { return (int)__builtin_amdgcn_mbcnt_hi(~0u, __builtin_amdgcn_mbcnt_lo(~0u, 0u)); }
__device__ __forceinline__ XcdBarrier xcd_barrier_post(unsigned* bar, volatile LAS unsigned* st) {
    XcdBarrier b; b.bar = bar; b.x = xb_xcc_id(); b.st = st; b.wave = __builtin_amdgcn_readfirstlane((int)(threadIdx.x >> 6));
    if (threadIdx.x == 0) (void)xb_add(&bar[XB_XCNT(b.x)], 1u);
    return b;
}
__device__ __forceinline__ void xcd_barrier_complete(unsigned* bar, unsigned x, unsigned& nloc, unsigned& nx) {
    const unsigned G = gridDim.x * gridDim.y * gridDim.z;
    unsigned sum, cnt, mine, sp = 0u;
    for (;;) {
        sum = 0u; cnt = 0u; mine = 0u;
#pragma unroll
        for (unsigned j = 0; j < 16; ++j) { const unsigned c = xb_ld(&bar[XB_XCNT(j)]); sum += c; cnt += (c > 0u) ? 1u : 0u; mine = (j == x) ? c : mine; }
        if (sum == G) break;
        __builtin_amdgcn_s_sleep(1);
        if ((++sp & 255u) == 0u) { if (xb_ld(&bar[XB_TMO])) break; if (sp > XB_SPIN_CAP) { atomicAdd(&bar[XB_TMO], 1u); break; } }
    }
    nloc = mine > 0u ? mine : 1u; nx = cnt > 0u ? cnt : 1u;
}
__device__ __forceinline__ void xcd_barrier(const XcdBarrier& b) {
    asm volatile("s_waitcnt vmcnt(0)" ::: "memory");
    __syncthreads();
    if (b.wave == 0 && xb_lane() == 0) {
        unsigned* bar = b.bar;
        __builtin_amdgcn_s_waitcnt(0);
        unsigned nloc = b.st[0], nx = b.st[1];
        if (nloc == 0u) { xcd_barrier_complete(bar, b.x, nloc, nx); b.st[0] = nloc; b.st[1] = nx; }
        const unsigned old = xb_add(&bar[XB_XSUB(b.x)], 1u);
        const unsigned gen = old / nloc;
        if (old + 1u == (gen + 1u) * nloc) {
            __builtin_amdgcn_fence(__ATOMIC_RELEASE, "agent");
            asm volatile("s_waitcnt vmcnt(0)" ::: "memory");
            const unsigned og = xb_add(&bar[XB_TOP], 1u);
            const unsigned tg = og / nx;
            if (og + 1u == (tg + 1u) * nx) xb_add(&bar[XB_TOPGEN], 1u);
            else XB_SPIN(xb_ld(&bar[XB_TOPGEN]) == tg, bar);
            __builtin_amdgcn_fence(__ATOMIC_ACQUIRE, "agent");
            xb_add(&bar[XB_XGEN(b.x)], 1u);
            asm volatile("s_waitcnt vmcnt(0)" ::: "memory");
        } else {
            XB_SPIN(xb_ld(&bar[XB_XGEN(b.x)]) == gen, bar);
            __builtin_amdgcn_fence(__ATOMIC_ACQUIRE, "agent");
            asm volatile("s_waitcnt vmcnt(0)" ::: "memory");
        }
    }
    __syncthreads();
}

struct Args { const float* in[33]; float* out; unsigned char* ws; int lo, hi, pad0, pad1; };
enum { I_X = 0, I_C, I_CTX, I_CCTX, I_WMOD, I_BMOD, I_NORMG, I_FINALG, I_NAWQKV, I_NABQKV, I_NARPB, I_NAWOUT, I_NABOUT, I_POOLW, I_POOLS, I_MLWUP, I_MLCONVW, I_MLCONVB,
       I_MLWQ, I_MLWK, I_MLWV, I_MLWG, I_MLBG, I_MLGN, I_MLSKIP, I_MLWDOWN, I_FW1, I_FW3, I_FW2, I_MROUTER, I_MW1, I_MW3, I_MW2 };

struct PArgs { const LAS unsigned long long* tab; float* out; unsigned char* ws;
    __device__ __forceinline__ const float* in(int i) const { const unsigned long long v = tab[i]; const unsigned lo = __builtin_amdgcn_readfirstlane((unsigned)v), hi = __builtin_amdgcn_readfirstlane((unsigned)(v >> 32));
        return (const float*)(const __attribute__((address_space(1))) float*)(((unsigned long long)hi << 32) | lo); } };
struct Ctx {
    LAS unsigned char* lds; int tid, lane, wave, G, bid;
};

__device__ __forceinline__ Ctx fresh_ctx(const Ctx& X0) {
    Ctx Y = X0; int t = X0.wave * 64 + (int)__builtin_amdgcn_mbcnt_hi(~0u, __builtin_amdgcn_mbcnt_lo(~0u, 0u)); asm volatile("" : "+v"(t)); Y.tid = t; Y.lane = t & 63; Y.wave = __builtin_amdgcn_readfirstlane(t >> 6); return Y;
}
__device__ __forceinline__ void conv_item(const float* W, int K, int N, bf16_t* WT, int mode, int half, LAS float* scr, int item, int lane) {
    const int nblk = N / 64, kb = item / nblk, nb = item % nblk, k0 = 64 * kb, n0 = 64 * nb;
    const float* src = W + (size_t)(k0 + (lane >> 4)) * N + n0 + 4 * (lane & 15);
    f32x4 v[16];
#pragma unroll
    for (int i = 0; i < 16; ++i) v[i] = *(const f32x4*)(src + (size_t)(4 * i) * N);
#pragma unroll
    for (int i = 0; i < 16; ++i) { LAS float* d = scr + (4 * i + (lane >> 4)) * 65 + 4 * (lane & 15); d[0] = v[i][0]; d[1] = v[i][1]; d[2] = v[i][2]; d[3] = v[i][3]; }
    LDS_WAIT(); asm volatile("" ::: "memory");
    const int c = lane & 7;
#pragma unroll
    for (int j = 0; j < 8; ++j) { const int n = (lane >> 3) + 8 * j; const LAS float* sp = scr + (8 * c) * 65 + n;
        const int nn = n0 + n; const int drow = mode ? ((nn >> 7) * 256 + (nn & 127) + 128 * half) : nn;
        u32x4 o; o.x = cvt_pk_bf16(sp[0 * 65], sp[1 * 65]); o.y = cvt_pk_bf16(sp[2 * 65], sp[3 * 65]); o.z = cvt_pk_bf16(sp[4 * 65], sp[5 * 65]); o.w = cvt_pk_bf16(sp[6 * 65], sp[7 * 65]);
        *(u32x4*)(WT + (size_t)drow * K + k0 + 8 * c) = o; }
    LDS_WAIT(); asm volatile("" ::: "memory");
}
__device__ __forceinline__ void conv_item_f8(const float* W, int K, int N, unsigned char* WT, int mode, int half, float scale, LAS float* scr, int item, int lane) {
    const int nblk = N / 64, kb = item / nblk, nb = item % nblk, k0 = 64 * kb, n0 = 64 * nb;
    const float* src = W + (size_t)(k0 + (lane >> 4)) * N + n0 + 4 * (lane & 15);
    f32x4 v[16];
#pragma unroll
    for (int i = 0; i < 16; ++i) v[i] = *(const f32x4*)(src + (size_t)(4 * i) * N);
#pragma unroll
    for (int i = 0; i < 16; ++i) { LAS float* d = scr + (4 * i + (lane >> 4)) * 65 + 4 * (lane & 15); d[0] = v[i][0]; d[1] = v[i][1]; d[2] = v[i][2]; d[3] = v[i][3]; }
    LDS_WAIT(); asm volatile("" ::: "memory");
    const int c = lane & 3;
#pragma unroll
    for (int j = 0; j < 4; ++j) { const int n = (lane >> 2) + 16 * j; const LAS float* sp = scr + (16 * c) * 65 + n;
        const int nn = n0 + n; const int drow = mode ? ((nn >> 7) * 256 + (nn & 127) + 128 * half) : nn;
        u32x4 o;
#pragma unroll
        for (int q = 0; q < 4; ++q) { float w4[4];
#pragma unroll
            for (int r = 0; r < 4; ++r) w4[r] = __builtin_fminf(__builtin_fmaxf(sp[(4 * q + r) * 65] * scale, -448.f), 448.f);
            int pk = __builtin_amdgcn_cvt_pk_fp8_f32(w4[0], w4[1], 0, false); pk = __builtin_amdgcn_cvt_pk_fp8_f32(w4[2], w4[3], pk, true); o[q] = (unsigned)pk; }
        *(u32x4*)(WT + (size_t)drow * K + k0 + 16 * c) = o; }
    LDS_WAIT(); asm volatile("" ::: "memory");
}
constexpr float F8_SW1 = 32.0f, F8_SW2 = 64.0f, F8_ST = 2.0f, F8_SWD = 64.0f;
struct ConvDesc { const float* W; bf16_t* WT; int K, N, mode, half; };
__device__ __forceinline__ ConvDesc conv_desc_base(const PArgs& a, int mi) {
    unsigned char* ws = a.ws; ConvDesc d;
    if (mi < 2)       { const int j = mi;      d = ConvDesc{a.in(I_NAWQKV) + (size_t)j * D * 3 * D, (bf16_t*)(ws + WS_WQKV) + (size_t)j * 3 * D * D, D, 3 * D, 0, 0}; }
    else if (mi < 4)  { const int j = mi - 2;  d = ConvDesc{a.in(I_NAWOUT) + (size_t)j * D * D, (bf16_t*)(ws + WS_WOUT) + (size_t)j * D * D, D, D, 0, 0}; }
    else if (mi < 6)  { const int j = mi - 4;  d = ConvDesc{a.in(I_FW1) + (size_t)j * D * FFD, (bf16_t*)(ws + WS_WF13) + (size_t)j * 2 * FFD * D, D, FFD, 1, 0}; }
    else if (mi < 8)  { const int j = mi - 6;  d = ConvDesc{a.in(I_FW3) + (size_t)j * D * FFD, (bf16_t*)(ws + WS_WF13) + (size_t)j * 2 * FFD * D, D, FFD, 1, 1}; }
    else if (mi < 10) { const int j = mi - 8;  d = ConvDesc{a.in(I_FW2) + (size_t)j * FFD * D, (bf16_t*)(ws + WS_WF2 + (size_t)j * D * FFD), FFD, D, 0, 0}; }
    else if (mi < 14) { const int g = mi - 10; d = ConvDesc{a.in(I_POOLW) + (size_t)g * 256 * 256, (bf16_t*)(ws + WS_WPOOL) + (size_t)g * 256 * 256, 256, 256, 0, 0}; }
    else if (mi == 14) { d = ConvDesc{a.in(I_MLWUP), (bf16_t*)(ws + WS_WUP), D, 2 * MLI, 0, 0}; }
    else { d = ConvDesc{a.in(I_MLWDOWN), (bf16_t*)(ws + WS_WDOWN), MLI, D, 0, 0}; }
    return d;
}
__device__ __forceinline__ ConvDesc conv_desc_moe(const PArgs& a, int le, int mi) {
    unsigned char* ws = a.ws; const int e = mi & 7, k = mi >> 3; ConvDesc d;
    if (k == 0)      d = ConvDesc{a.in(I_MW1) + ((size_t)le * NEXP + e) * D * FFE, (bf16_t*)(ws + WS_WM13 + (size_t)e * 2 * FFE * D), D, FFE, 1, 0};
    else if (k == 1) d = ConvDesc{a.in(I_MW3) + ((size_t)le * NEXP + e) * D * FFE, (bf16_t*)(ws + WS_WM13 + (size_t)e * 2 * FFE * D), D, FFE, 1, 1};
    else             d = ConvDesc{a.in(I_MW2) + ((size_t)le * NEXP + e) * FFE * D, (bf16_t*)(ws + WS_WM2 + (size_t)e * D * FFE), FFE, D, 0, 0};
    return d;
}
constexpr int CONV_SPLIT = 48;
__device__ __forceinline__ void conv_weights(const Ctx& X0, const PArgs& a, int moe_le, int gsub = 0, int bsub = 0) {
    Ctx X = fresh_ctx(X0); if (gsub > 0) { X.G = gsub; X.bid = bsub; }
    LAS float* scr = (LAS float*)(X.lds + X.wave * 16640);
    const int NGW = X.G * 8, nmat = moe_le < 0 ? 16 : 24;
    for (int mi = 0; mi < nmat; ++mi) {
        const ConvDesc d = moe_le < 0 ? conv_desc_base(a, mi) : conv_desc_moe(a, moe_le, mi);
        const int nitems = (d.K / 64) * (d.N / 64); const int gw = (X.bid * 8 + X.wave + mi * 397) % NGW;
        if (moe_le < 0 && (mi == 8 || mi == 9)) { for (int it = gw; it < nitems; it += NGW) conv_item_f8(d.W, d.K, d.N, (unsigned char*)d.WT, d.mode, d.half, F8_SWD, scr, it, X.lane); }
        else if (moe_le < 0) { for (int it = gw; it < nitems; it += NGW) conv_item(d.W, d.K, d.N, d.WT, d.mode, d.half, scr, it, X.lane); }
        else { const float sc = (mi >> 3) == 2 ? F8_SW2 : F8_SW1; for (int it = gw; it < nitems; it += NGW) conv_item_f8(d.W, d.K, d.N, (unsigned char*)d.WT, d.mode, d.half, sc, scr, it, X.lane); }
    }
}
__device__ __forceinline__ void prologue_phase(const Ctx& X0, const PArgs& a) {
    const Ctx X = fresh_ctx(X0);
    unsigned char* ws = a.ws;
    conv_weights(X, a, -1);
    if (X.G < CONV_SPLIT * 2) conv_weights(X, a, 0);
    { bf16_t* g1t = (bf16_t*)(ws + WS_WGT); bf16_t* g2t = g1t + 16 * MLI; const float* wg = a.in(I_MLWG); const float* wq = a.in(I_MLWQ); const float* wk = a.in(I_MLWK); const float* wv = a.in(I_MLWV);
      for (int i = X.bid * 512 + X.tid; i < 16 * MLI; i += X.G * 512) { const int g = i / MLI, c = i % MLI, n = c >> 2, cc = c & 3; float s1 = 0.f, s2 = 0.f;
#pragma unroll
          for (int j = 0; j < 4; ++j) { s1 += wq[n * 16 + cc * 4 + j] * wg[(4 * n + j) * 16 + g] + wk[n * 16 + cc * 4 + j] * wg[(MLI + 4 * n + j) * 16 + g]; s2 += wv[n * 16 + cc * 4 + j] * wg[(2 * MLI + 4 * n + j) * 16 + g]; }
          g1t[i] = f2bf(s1); g2t[i] = f2bf(s2); } }
    { u32x4* wbd = (u32x4*)(ws + WS_WGT + 131072); const float* wq = a.in(I_MLWQ); const float* wk = a.in(I_MLWK);
      for (int i = X.bid * 512 + X.tid; i < 64 * 4 * 64; i += X.G * 512) { const int ln = i & 63, k = (i >> 6) & 3, jj = i >> 8, ql = ln & 15, g = ln >> 4, nt = k & 1; const float* wsrc = (k < 2) ? wq : wk; const float sc = (k < 2) ? 1.0f : 0.044194173824159216f;
          float f[8];
#pragma unroll
          for (int j = 0; j < 8; ++j) { const int cl = 8 * g + j, nl = (k < 2) ? 16 * nt + ql : 8 * (ql >> 2) + 4 * nt + (ql & 3); const bool on = (cl >> 2) == (nl >> 2); const int nb = (32 * jj + cl) >> 2; f[j] = on ? wsrc[nb * 16 + (cl & 3) * 4 + (nl & 3)] * sc : 0.f; }
          u32x4 o; o.x = cvt_pk_bf16(f[0], f[1]); o.y = cvt_pk_bf16(f[2], f[3]); o.z = cvt_pk_bf16(f[4], f[5]); o.w = cvt_pk_bf16(f[6], f[7]); wbd[i] = o; } }
    __syncthreads();
    LAS float* sc = (LAS float*)(X.lds);
    LAS float* part = (LAS float*)(X.lds + 20480);
    for (int i = X.tid; i < 5 * D; i += 512) { const int j = i >> 10, k = i & 1023; const float v = j < 4 ? a.in(I_C)[j * D + k] : a.in(I_CCTX)[k]; sc[i] = v / (1.0f + expf(-v)); }
    __syncthreads();
    float* MOD = (float*)(ws + WS_MOD);
    for (int item = X.bid; item < DEPTH * 96; item += X.G) {
        const int L = item / 96, cg = item % 96, cl = X.tid & 63, ks = X.tid >> 6, col = cg * 64 + cl;
        float acc[5] = {0.f, 0.f, 0.f, 0.f, 0.f};
        const float* wp = a.in(I_WMOD) + ((size_t)L * D + ks * 128) * (6 * D) + col;
#pragma unroll 4
        for (int k = 0; k < 128; ++k) { const float w = wp[(size_t)k * (6 * D)];
#pragma unroll
            for (int j = 0; j < 5; ++j) acc[j] += sc[j * D + ks * 128 + k] * w; }
#pragma unroll
        for (int j = 0; j < 5; ++j) part[(ks * 64 + cl) * 5 + j] = acc[j];
        __syncthreads();
        if (X.tid < 320) { const int j = X.tid >> 6; float m = a.in(I_BMOD)[L * 6 * D + col];
#pragma unroll
            for (int s = 0; s < 8; ++s) m += part[(s * 64 + cl) * 5 + j];
            const int which = cg >> 4, c = (cg & 15) * 64 + cl; float* mp = MOD + (size_t)((L * 5 + j) * NMODV) * D;
            mp[which * D + c] = m;
            if (which == 2) { const int kind = L % 3, jj = L / 3;
                mp[6 * D + c] = m * (kind == 1 ? a.in(I_POOLS)[c] : 1.0f);
                mp[7 * D + c] = m * (kind == 0 ? a.in(I_NABOUT)[jj * D + c] : 0.0f); } }
        __syncthreads();
    }
}

__device__ __forceinline__ void moe_tstart(const unsigned* cntw, int (&ts)[9], int (&cn)[8]) {
    int acc = 0;
#pragma unroll
    for (int e = 0; e < 8; ++e) { cn[e] = (int)__hip_atomic_load(cntw + 64 * e, RLX_AGENT); ts[e] = acc; acc += (cn[e] + 255) >> 8; }
    ts[8] = acc;
}
__device__ __forceinline__ void norm_phase(const Ctx& X0, const PArgs& a, int L, int which, int rbeg, int rend, int gsub, int bsub, bool combine, int comb_L, int comb_set, bool route, int route_set, bool final_, bool dry = false) {
    const Ctx X = fresh_ctx(X0);
    unsigned char* ws = a.ws;
    bf16_t* H = (bf16_t*)(ws + WS_H); bf16_t* A = (bf16_t*)(ws + WS_A); const float* MOD = (const float*)(ws + WS_MOD);
    unsigned* ctl = (unsigned*)(ws + WS_CTL);
    const int rpb = (rend - rbeg + gsub - 1) / gsub, row_lo = rbeg + bsub * rpb, row_hi = (row_lo + rpb < rend) ? row_lo + rpb : rend;
    LAS float* wrl = (LAS float*)(X.lds);
    LAS int* lcnt = (LAS int*)(X.lds + 32768);
    LAS int* info = (LAS int*)(X.lds + 32768 + 64);
    int ts[9], cn[8];
    if (combine) moe_tstart(ctl + CW_CNT + 64 * 8 * comb_set, ts, cn);
    if (route) {
        const float* wr = a.in(I_MROUTER) + (size_t)(L / 2) * D * NEXP;
        __syncthreads();
        for (int i = X.tid; i < D * NEXP; i += 512) wrl[i] = wr[i];
        if (X.tid < 16) lcnt[X.tid] = 0;
        __syncthreads();
    }
    const bf16_t* Y = (const bf16_t*)(ws + WS_MY); const int* POS = (const int*)(ws + WS_POS); const float* GATE = (const float*)(ws + WS_GATE);
    f32x4 rawA[4], rawB[4], rawC[4]; int pA0 = 0, pA1 = 0, pB0 = 0, pB1 = 0, pC0 = 0, pC1 = 0; float gA0 = 0.f, gA1 = 0.f, gB0 = 0.f, gB1 = 0.f, gC0 = 0.f, gC1 = 0.f; int pcond = -1; f32x4 pg[4], ps[4];
    const float* xin = a.in(I_X); const float* cin = a.in(I_CTX); const bool from_in = (L == 0 && which == 0 && !final_);
#define NP_LOAD(raw_, p0_, p1_, g0_, g1_, row_) do { if (from_in) { const f32x4* hr_ = (const f32x4*)((row_) < NLAT ? xin + (size_t)(row_) * D : cin + (size_t)((row_) - NLAT) * D) + X.lane; _Pragma("unroll") for (int j_ = 0; j_ < 4; ++j_) raw_[j_] = hr_[64 * j_]; } \
        else { const u32x2* hr_ = (const u32x2*)(H + (size_t)(row_) * D) + X.lane; _Pragma("unroll") for (int j_ = 0; j_ < 4; ++j_) { const u32x2 w_ = hr_[64 * j_]; raw_[j_][0] = __uint_as_float(w_.x); raw_[j_][1] = __uint_as_float(w_.y); } } \
        if (combine) { p0_ = POS[(row_) * 2]; p1_ = POS[(row_) * 2 + 1]; g0_ = GATE[(row_) * 2]; g1_ = GATE[(row_) * 2 + 1]; } } while (0)
    if (row_lo + X.wave < row_hi) NP_LOAD(rawA, pA0, pA1, gA0, gA1, row_lo + X.wave);
    if (row_lo + X.wave + 8 < row_hi) NP_LOAD(rawB, pB0, pB1, gB0, gB1, row_lo + X.wave + 8);
    if (row_lo + X.wave + 16 < row_hi) NP_LOAD(rawC, pC0, pC1, gC0, gC1, row_lo + X.wave + 16);
    for (int row = row_lo + X.wave; row < row_hi; row += 8) {
        const int cond = row_cond(row);
        f32x4 v[4];
#pragma unroll
        for (int j = 0; j < 4; ++j) { if (from_in) v[j] = rawA[j]; else { const unsigned w0 = __float_as_uint(rawA[j][0]), w1 = __float_as_uint(rawA[j][1]); v[j] = (f32x4){bf_lo(w0), bf_hi(w0), bf_lo(w1), bf_hi(w1)}; } }
        const int p0 = pA0, p1 = pA1; const float g0 = gA0, g1 = gA1;
#pragma unroll
        for (int j = 0; j < 4; ++j) { rawA[j] = rawB[j]; rawB[j] = rawC[j]; }
        pA0 = pB0; pA1 = pB1; gA0 = gB0; gA1 = gB1; pB0 = pC0; pB1 = pC1; gB0 = gC0; gB1 = gC1;
        if (row + 24 < row_hi) NP_LOAD(rawC, pC0, pC1, gC0, gC1, row + 24);
        if (cond != pcond) { pcond = cond;
            if (final_) { const float* fg = a.in(I_FINALG);
#pragma unroll
                for (int j = 0; j < 4; ++j) { pg[j] = *(const f32x4*)(fg + 256 * j + 4 * X.lane); ps[j] = (f32x4){0.f, 0.f, 0.f, 0.f}; } }
            else { const float* ng = a.in(I_NORMG) + (size_t)(L * 2 + which) * D; const float* sh = MOD + (size_t)((L * 5 + cond) * NMODV + which * 3) * D; const float* scl = sh + D;
#pragma unroll
                for (int j = 0; j < 4; ++j) { const int c = 256 * j + 4 * X.lane; pg[j] = *(const f32x4*)(ng + c) * (*(const f32x4*)(scl + c) + 1.0f); ps[j] = *(const f32x4*)(sh + c); } } }
        if (combine) {
            const int e0 = p0 >> 24, e1 = p1 >> 24; int t0 = 0, t1 = 0;
#pragma unroll
            for (int e = 0; e < 8; ++e) { t0 = (e == e0) ? ts[e] : t0; t1 = (e == e1) ? ts[e] : t1; }
            const size_t y0 = ((size_t)t0 * 256 + (p0 & 0xffffff)) * D, y1 = ((size_t)t1 * 256 + (p1 & 0xffffff)) * D;
            const float* g2 = MOD + (size_t)((comb_L * 5 + cond) * NMODV + 5) * D;
#pragma unroll
            for (int j = 0; j < 4; ++j) { const int c = 256 * j + 4 * X.lane;
                const u32x2 w0 = *(const u32x2*)(Y + y0 + c), w1 = *(const u32x2*)(Y + y1 + c); const f32x4 gg = *(const f32x4*)(g2 + c);
                v[j][0] += gg[0] * (g0 * bf_lo(w0.x) + g1 * bf_lo(w1.x)); v[j][1] += gg[1] * (g0 * bf_hi(w0.x) + g1 * bf_hi(w1.x));
                v[j][2] += gg[2] * (g0 * bf_lo(w0.y) + g1 * bf_lo(w1.y)); v[j][3] += gg[3] * (g0 * bf_hi(w0.y) + g1 * bf_hi(w1.y)); }
            if (!final_ && !dry) { u32x2* hw = (u32x2*)(H + (size_t)row * D) + X.lane;
#pragma unroll
                for (int j = 0; j < 4; ++j) { u32x2 w; w.x = cvt_pk_bf16(v[j][0], v[j][1]); w.y = cvt_pk_bf16(v[j][2], v[j][3]); hw[64 * j] = w; } }
        }
        float ss = 0.f;
#pragma unroll
        for (int j = 0; j < 4; ++j) ss += (v[j][0] * v[j][0] + v[j][1] * v[j][1]) + (v[j][2] * v[j][2] + v[j][3] * v[j][3]);
        const float rs = 1.0f / sqrtf(wave_sum(ss) * (1.0f / D) + NORM_EPS);
        if (final_) {
            f32x4* o = (f32x4*)(a.out + (size_t)row * D) + X.lane;
#pragma unroll
            for (int j = 0; j < 4; ++j) o[64 * j] = v[j] * rs * pg[j];
            continue;
        }
        float lg[8] = {0.f, 0.f, 0.f, 0.f, 0.f, 0.f, 0.f, 0.f};
#pragma unroll
        for (int j = 0; j < 4; ++j) { const int c = 256 * j + 4 * X.lane;
            const f32x4 y = v[j] * rs * pg[j] + ps[j];
            u32x2 w; w.x = cvt_pk_bf16(y[0], y[1]); w.y = cvt_pk_bf16(y[2], y[3]);
            *(u32x2*)(A + (size_t)row * D + c) = w;
            if (route) {
#pragma unroll
                for (int i = 0; i < 4; ++i) { const f32x4 wa = *(const LAS f32x4*)(wrl + (c + i) * 8), wb = *(const LAS f32x4*)(wrl + (c + i) * 8 + 4);
                    lg[0] += y[i] * wa[0]; lg[1] += y[i] * wa[1]; lg[2] += y[i] * wa[2]; lg[3] += y[i] * wa[3];
                    lg[4] += y[i] * wb[0]; lg[5] += y[i] * wb[1]; lg[6] += y[i] * wb[2]; lg[7] += y[i] * wb[3]; } }
        }
        if (route) {
#pragma unroll
            for (int e = 0; e < 8; ++e) lg[e] = wave_sum(lg[e]);
            int e0 = 0; float l0 = lg[0];
#pragma unroll
            for (int e = 1; e < 8; ++e) if (lg[e] > l0) { l0 = lg[e]; e0 = e; }
            int e1 = -1; float l1 = -3.0e38f;
#pragma unroll
            for (int e = 0; e < 8; ++e) if (e != e0 && lg[e] > l1) { l1 = lg[e]; e1 = e; }
            if (X.lane == 0) {
                const float g0 = 1.0f / (1.0f + expf(l1 - l0));
                const int s0 = __hip_atomic_fetch_add(lcnt + e0, 1, __ATOMIC_RELAXED, __HIP_MEMORY_SCOPE_WORKGROUP);
                const int s1 = __hip_atomic_fetch_add(lcnt + e1, 1, __ATOMIC_RELAXED, __HIP_MEMORY_SCOPE_WORKGROUP);
                LAS int* ip = info + (row - row_lo) * 6; ip[0] = e0; ip[1] = e1; ip[2] = s0; ip[3] = s1; ip[4] = __float_as_int(g0); ip[5] = __float_as_int(1.0f - g0);
            }
        }
    }
#undef NP_LOAD
    if (route && !dry) {
        __syncthreads();
        if (X.tid < 8) lcnt[8 + X.tid] = (int)__hip_atomic_fetch_add(ctl + CW_CNT + 64 * (8 * route_set + X.tid), (unsigned)lcnt[X.tid], RLX_AGENT);
        __syncthreads();
        int* LIST = (int*)(ws + WS_LIST); int* POSW = (int*)(ws + WS_POS); float* GATEW = (float*)(ws + WS_GATE);
        for (int r = X.tid; r < row_hi - row_lo; r += 512) { const LAS int* ip = info + r * 6; const int row = row_lo + r;
            const int e0 = ip[0], e1 = ip[1], s0 = lcnt[8 + e0] + ip[2], s1 = lcnt[8 + e1] + ip[3];
            LIST[(size_t)e0 * MT + s0] = row; LIST[(size_t)e1 * MT + s1] = row;
            POSW[row * 2] = (e0 << 24) | s0; POSW[row * 2 + 1] = (e1 << 24) | s1;
            GATEW[row * 2] = __int_as_float(ip[4]); GATEW[row * 2 + 1] = __int_as_float(ip[5]); }
        __syncthreads();
    }
}

__device__ __forceinline__ void poolprep_phase(const Ctx& X0, const PArgs& a, int nrows) {
    const Ctx X = fresh_ctx(X0);
    const bf16_t* __restrict__ A = (const bf16_t*)(a.ws + WS_A); bf16_t* __restrict__ PL = (bf16_t*)(a.ws + WS_PL);
    for (int row = X.bid * 8 + X.wave; row < nrows; row += X.G * 8) {
        int base, t, len; if (row < NLAT) { base = row & ~(SEQ - 1); t = row & (SEQ - 1); len = SEQ; } else { const int r = row - NLAT; base = NLAT + (r & ~(CTXL - 1)); t = r & (CTXL - 1); len = CTXL; }
#pragma unroll
        for (int g = 0; g < 4; ++g) { const int w = 2 << g, lo = (t - w / 2 > 0) ? t - w / 2 : 0, hi = (t + w / 2 < len) ? t + w / 2 : len; const int c = g * 256 + 4 * X.lane;
            float s0 = 0.f, s1 = 0.f, s2 = 0.f, s3 = 0.f;
            for (int s = lo; s < hi; ++s) { const u32x2 x = *(const u32x2*)(A + (size_t)(base + s) * D + c); s0 += bf_lo(x.x); s1 += bf_hi(x.x); s2 += bf_lo(x.y); s3 += bf_hi(x.y); }
            const u32x2 me = *(const u32x2*)(A + (size_t)row * D + c); const float inv = 1.0f / (float)(hi - lo);
            u32x2 o; o.x = cvt_pk_bf16(s0 * inv - bf_lo(me.x), s1 * inv - bf_hi(me.x)); o.y = cvt_pk_bf16(s2 * inv - bf_lo(me.y), s3 * inv - bf_hi(me.y));
            *(u32x2*)(PL + (size_t)row * D + c) = o; }
    }
}
typedef short s16x4 __attribute__((ext_vector_type(4)));
__device__ __forceinline__ int launder_i(int x) { asm volatile("" : "+v"(x)); return x; }
__device__ __forceinline__ float swz_xor(float v, int m) { return m == 1 ? __int_as_float(__builtin_amdgcn_ds_swizzle(__float_as_int(v), (1 << 10) | 0x1f)) : (m == 2 ? __int_as_float(__builtin_amdgcn_ds_swizzle(__float_as_int(v), (2 << 10) | 0x1f)) : __int_as_float(__builtin_amdgcn_ds_swizzle(__float_as_int(v), (4 << 10) | 0x1f))); }
typedef __bf16 bf16x2_t __attribute__((ext_vector_type(2)));
__device__ __forceinline__ unsigned cvtpk(float lo, float hi) { f32x2 v = {lo, hi}; bf16x2_t b = __builtin_convertvector(v, bf16x2_t); return __builtin_bit_cast(unsigned, b); }
__device__ __forceinline__ s16x4 lds_tr16(const LAS unsigned char* p) { return __builtin_bit_cast(s16x4, __builtin_amdgcn_ds_read_tr16_b64_v4i16((LAS s16x4*)p)); }

__device__ __forceinline__ void seq_of_row(int row, int& base, int& t, int& len) {
    if (row < NLAT) { base = row & ~(SEQ - 1); t = row & (SEQ - 1); len = SEQ; } else { const int r = row - NLAT; base = NLAT + (r & ~(CTXL - 1)); t = r & (CTXL - 1); len = CTXL; }
}

__device__ __forceinline__ void feat_phase(const Ctx& X0, const PArgs& a) {
    const Ctx X = fresh_ctx(X0);
    unsigned char* ws = a.ws;
    const bf16_t* XM = (const bf16_t*)(ws + WS_XM); bf16_t* XC = (bf16_t*)(ws + WS_XC); float* GT = (float*)(ws + WS_GT); const bf16_t* G1T = (const bf16_t*)(ws + WS_WGT); const bf16_t* G2T = G1T + 16 * MLI;
    LAS float* cwl = (LAS float*)X.lds;
    { const float* cw = a.in(I_MLCONVW); const float* cb = a.in(I_MLCONVB);
      for (int i = X.tid; i < 4 * MLI; i += 512) cwl[i] = cw[i];
      for (int i = X.tid; i < MLI; i += 512) cwl[4 * MLI + i] = cb[i]; }
    __syncthreads();
    const int fr = X.lane & 15, fq = X.lane >> 4;
    for (int item = X.bid * 8 + X.wave; item < MT / 16; item += X.G * 8) {
        const int row = item * 16 + fr; int base, t, len; seq_of_row(row, base, t, len);
        f32x4 acc = (f32x4){0.f, 0.f, 0.f, 0.f};
        const bool v0 = t >= 2, v1 = t >= 1, v3 = t + 1 < len;
        const bf16_t* xr = XM + (size_t)row * MLI + 8 * fq;
#pragma unroll 2
        for (int jj = 0; jj < MLI / 32; ++jj) {
            const int c0 = 32 * jj + 8 * fq;
            u32x4 w[4]; const u32x4 z4 = (u32x4){0u, 0u, 0u, 0u};
            w[0] = v0 ? *(const u32x4*)(xr + 32 * jj - 2 * MLI) : z4; w[1] = v1 ? *(const u32x4*)(xr + 32 * jj - MLI) : z4; w[2] = *(const u32x4*)(xr + 32 * jj); w[3] = v3 ? *(const u32x4*)(xr + 32 * jj + MLI) : z4;
            const bf16x8 b1 = *(const bf16x8*)(G1T + (size_t)fr * MLI + c0), b2 = *(const bf16x8*)(G2T + (size_t)fr * MLI + c0);
            float xc[8];
            { const f32x4 ba = *(const LAS f32x4*)(cwl + 4 * MLI + c0), bb = *(const LAS f32x4*)(cwl + 4 * MLI + c0 + 4);
              xc[0] = ba[0]; xc[1] = ba[1]; xc[2] = ba[2]; xc[3] = ba[3]; xc[4] = bb[0]; xc[5] = bb[1]; xc[6] = bb[2]; xc[7] = bb[3]; }
#pragma unroll
            for (int tap = 0; tap < 4; ++tap) { const f32x4 ca = *(const LAS f32x4*)(cwl + tap * MLI + c0), cc = *(const LAS f32x4*)(cwl + tap * MLI + c0 + 4);
                xc[0] += bf_lo(w[tap].x) * ca[0]; xc[1] += bf_hi(w[tap].x) * ca[1]; xc[2] += bf_lo(w[tap].y) * ca[2]; xc[3] += bf_hi(w[tap].y) * ca[3];
                xc[4] += bf_lo(w[tap].z) * cc[0]; xc[5] += bf_hi(w[tap].z) * cc[1]; xc[6] += bf_lo(w[tap].w) * cc[2]; xc[7] += bf_hi(w[tap].w) * cc[3]; }
#pragma unroll
            for (int i = 0; i < 8; ++i) xc[i] = silu_f(xc[i]);
            u32x4 o; o.x = cvtpk(xc[0], xc[1]); o.y = cvtpk(xc[2], xc[3]); o.z = cvtpk(xc[4], xc[5]); o.w = cvtpk(xc[6], xc[7]);
            *(u32x4*)(XC + (size_t)row * MLI + c0) = o;
            acc = __builtin_amdgcn_mfma_f32_16x16x32_bf16(__builtin_bit_cast(bf16x8, o), b1, acc, 0, 0, 0);
            acc = __builtin_amdgcn_mfma_f32_16x16x32_bf16(__builtin_bit_cast(bf16x8, w[2]), b2, acc, 0, 0, 0);
        }
        const float bg = a.in(I_MLBG)[fr];
#pragma unroll
        for (int r = 0; r < 4; ++r) GT[(size_t)(item * 16 + 4 * fq + r) * 16 + fr] = acc[r] + bg;
    }
}

__device__ __forceinline__ int chain_row(int b, int dir, int p) {
    if (p < CTXL) return NLAT + b * CTXL + (dir ? CTXL - 1 - p : p);
    const int tt = p - CTXL; return b * SEQ + (dir ? SEQ - 1 - tt : tt);
}
__device__ __forceinline__ void scan_naive_phase(const Ctx& X0, const PArgs& a) {
    const Ctx X = fresh_ctx(X0);
    unsigned char* ws = a.ws;
    const bf16_t* XM = (const bf16_t*)(ws + WS_XM); const bf16_t* XC = (const bf16_t*)(ws + WS_XC); const float* GT = (const float*)(ws + WS_GT);
    LAS bf16_t* qL = (LAS bf16_t*)(X.lds); LAS bf16_t* kL = (LAS bf16_t*)(X.lds + 65536); LAS float* vL = (LAS float*)(X.lds + 131072); LAS float* gL = (LAS float*)(X.lds + 131072 + 16384);
    const float* wq = a.in(I_MLWQ); const float* wk = a.in(I_MLWK); const float* wv = a.in(I_MLWV);
    const float kscale = 0.044194173824159216f;
    for (int item = X.bid; item < 256; item += X.G) {
        const int chain = item >> 3, sl = item & 7, b = chain >> 3, h = (chain >> 1) & 3, dir = chain & 1;
        bf16_t* HO = (bf16_t*)(ws + (dir ? WS_HB : WS_HF));
        const int d = X.tid >> 3, ep = X.tid & 7;
        float C[64], n[64];
#pragma unroll
        for (int j = 0; j < 64; ++j) { C[j] = 0.f; n[j] = 0.f; }
        const int bc = X.tid & 127, nbq = h * 128 + bc;
        float wqr[16], wkr[16];
#pragma unroll
        for (int i = 0; i < 16; ++i) { wqr[i] = wq[nbq * 16 + i]; wkr[i] = wk[nbq * 16 + i] * kscale; }
        for (int ch = 0; ch < (CTXL + SEQ) / 64; ++ch) {
            __syncthreads();
            for (int i = 0; i < 16; ++i) { const int tl = (X.tid >> 7) + 4 * i; const int row = chain_row(b, dir, ch * 64 + tl);
                const u32x2 w = *(const u32x2*)(XC + (size_t)row * MLI + h * 512 + 4 * bc);
                const float x0 = bf_lo(w.x), x1 = bf_hi(w.x), x2 = bf_lo(w.y), x3 = bf_hi(w.y);
                float qo[4], ko[4];
#pragma unroll
                for (int dd = 0; dd < 4; ++dd) { qo[dd] = x0 * wqr[dd] + x1 * wqr[4 + dd] + x2 * wqr[8 + dd] + x3 * wqr[12 + dd]; ko[dd] = x0 * wkr[dd] + x1 * wkr[4 + dd] + x2 * wkr[8 + dd] + x3 * wkr[12 + dd]; }
                u32x2 oq, ok; oq.x = cvt_pk_bf16(qo[0], qo[1]); oq.y = cvt_pk_bf16(qo[2], qo[3]); ok.x = cvt_pk_bf16(ko[0], ko[1]); ok.y = cvt_pk_bf16(ko[2], ko[3]);
                *(LAS u32x2*)(qL + tl * 512 + 4 * bc) = oq; *(LAS u32x2*)(kL + tl * 512 + 4 * bc) = ok; }
            for (int i = 0; i < 2; ++i) { const int id = X.tid + 512 * i, tl = id >> 4, vb = id & 15; const int row = chain_row(b, dir, ch * 64 + tl); const int nb = h * 128 + sl * 16 + vb;
                const u32x2 w = *(const u32x2*)(XM + (size_t)row * MLI + 4 * nb);
                const float x0 = bf_lo(w.x), x1 = bf_hi(w.x), x2 = bf_lo(w.y), x3 = bf_hi(w.y); const float* pv = wv + nb * 16;
#pragma unroll
                for (int dd = 0; dd < 4; ++dd) vL[tl * 64 + 4 * vb + dd] = x0 * pv[dd] + x1 * pv[4 + dd] + x2 * pv[8 + dd] + x3 * pv[12 + dd]; }
            if (X.tid < 64) { const int row = chain_row(b, dir, ch * 64 + X.tid); const float ip = GT[(size_t)row * 16 + (2 * dir) * 4 + h], fp = GT[(size_t)row * 16 + (2 * dir + 1) * 4 + h];
                gL[X.tid * 2] = expf(ip); gL[X.tid * 2 + 1] = 1.0f / (1.0f + expf(-fp)); }
            __syncthreads();
            for (int tl = 0; tl < 64; ++tl) {
                const float ig = gL[tl * 2], fg = gL[tl * 2 + 1]; const float iv = ig * vL[tl * 64 + d];
                float num = 0.f, den = 0.f;
#pragma unroll
                for (int g8 = 0; g8 < 8; ++g8) {
                    const u32x4 kw = *(const LAS u32x4*)(kL + tl * 512 + 64 * ep + 8 * g8), qw = *(const LAS u32x4*)(qL + tl * 512 + 64 * ep + 8 * g8);
                    const float kk[8] = {bf_lo(kw.x), bf_hi(kw.x), bf_lo(kw.y), bf_hi(kw.y), bf_lo(kw.z), bf_hi(kw.z), bf_lo(kw.w), bf_hi(kw.w)};
                    const float qq[8] = {bf_lo(qw.x), bf_hi(qw.x), bf_lo(qw.y), bf_hi(qw.y), bf_lo(qw.z), bf_hi(qw.z), bf_lo(qw.w), bf_hi(qw.w)};
#pragma unroll
                    for (int j = 0; j < 8; ++j) { const int e = g8 * 8 + j; C[e] = fg * C[e] + iv * kk[j]; n[e] = fg * n[e] + ig * kk[j]; num += C[e] * qq[j]; den += n[e] * qq[j]; }
                }
                num += __shfl_xor(num, 1); den += __shfl_xor(den, 1); num += __shfl_xor(num, 2); den += __shfl_xor(den, 2); num += __shfl_xor(num, 4); den += __shfl_xor(den, 4);
                if (ep == 0) { const int row = chain_row(b, dir, ch * 64 + tl); const float dn = fabsf(den) > 1.0f ? fabsf(den) : 1.0f;
                    HO[(size_t)row * MLI + h * 512 + sl * 64 + d] = f2bf(num / dn); }
            }
        }
    }
}

__device__ __forceinline__ void outprep_phase(const Ctx& X0, const PArgs& a) {
    const Ctx X = fresh_ctx(X0);
    unsigned char* ws = a.ws;
    const bf16_t* HF = (const bf16_t*)(ws + WS_HF); const bf16_t* HB = (const bf16_t*)(ws + WS_HB); const bf16_t* XC = (const bf16_t*)(ws + WS_XC); const bf16_t* Z = (const bf16_t*)(ws + WS_Z);
    bf16_t* OA = (bf16_t*)(ws + WS_OA); const float* gn = a.in(I_MLGN); const float* sk = a.in(I_MLSKIP);
    for (int row = X.bid * 8 + X.wave; row < MT; row += X.G * 8) {
#pragma unroll
        for (int hh = 0; hh < 4; ++hh) { const int c = hh * 512 + 8 * X.lane; const size_t o = (size_t)row * MLI + c;
            const u32x4 wf = *(const u32x4*)(HF + o), wb = *(const u32x4*)(HB + o), wx = *(const u32x4*)(XC + o), wz = *(const u32x4*)(Z + o);
            float hs[8] = {bf_lo(wf.x) + bf_lo(wb.x), bf_hi(wf.x) + bf_hi(wb.x), bf_lo(wf.y) + bf_lo(wb.y), bf_hi(wf.y) + bf_hi(wb.y), bf_lo(wf.z) + bf_lo(wb.z), bf_hi(wf.z) + bf_hi(wb.z), bf_lo(wf.w) + bf_lo(wb.w), bf_hi(wf.w) + bf_hi(wb.w)};
            const float xcv[8] = {bf_lo(wx.x), bf_hi(wx.x), bf_lo(wx.y), bf_hi(wx.y), bf_lo(wx.z), bf_hi(wx.z), bf_lo(wx.w), bf_hi(wx.w)};
            const float zv[8] = {bf_lo(wz.x), bf_hi(wz.x), bf_lo(wz.y), bf_hi(wz.y), bf_lo(wz.z), bf_hi(wz.z), bf_lo(wz.w), bf_hi(wz.w)};
            float s = 0.f;
#pragma unroll
            for (int i = 0; i < 8; ++i) s += hs[i];
            const float mu = wave_sum(s) * (1.0f / 512.0f); float q = 0.f;
#pragma unroll
            for (int i = 0; i < 8; ++i) { hs[i] -= mu; q += hs[i] * hs[i]; }
            const float rstd = 1.0f / sqrtf(wave_sum(q) * (1.0f / 512.0f) + NORM_EPS);
            float ov[8];
#pragma unroll
            for (int i = 0; i < 8; ++i) ov[i] = (hs[i] * rstd * gn[c + i] + sk[c + i] * xcv[i]) * silu_f(zv[i]);
            u32x4 w; w.x = cvt_pk_bf16(ov[0], ov[1]); w.y = cvt_pk_bf16(ov[2], ov[3]); w.z = cvt_pk_bf16(ov[4], ov[5]); w.w = cvt_pk_bf16(ov[6], ov[7]);
            *(u32x4*)(OA + o) = w; }
    }
}

__device__ __forceinline__ void attn_naive_phase(const Ctx& X0, const PArgs& a, int j_na, bool with_ctx) {
    const Ctx X = fresh_ctx(X0);
    unsigned char* ws = a.ws;
    const bf16_t* Q = (const bf16_t*)(ws + WS_Q); const bf16_t* K = (const bf16_t*)(ws + WS_K); const bf16_t* V = (const bf16_t*)(ws + WS_V); bf16_t* O = (bf16_t*)(ws + WS_O);
    const float* rpb = a.in(I_NARPB) + (size_t)j_na * NAH * 15 * 31;
    LAS bf16_t* kT = (LAS bf16_t*)(X.lds); LAS bf16_t* vT = (LAS bf16_t*)(X.lds + 8192 + 1024);
    const int PITCH = 72;
    const int nunits = NB * GROWS * NAH + (with_ctx ? NB * NAH * 4 : 0);
    const int qi = X.tid >> 3, kp = X.tid & 7;
    for (int u = X.bid; u < nunits; u += X.G) {
        int b, h, r = 0, r0 = 0, qrow, ntl; bool lat = u < NB * GROWS * NAH;
        if (lat) { b = u / (GROWS * NAH); const int rem = u % (GROWS * NAH); r = rem / NAH; h = rem % NAH; r0 = r - 4; r0 = r0 < 0 ? 0 : (r0 > GROWS - 8 ? GROWS - 8 : r0); qrow = b * SEQ + r * GRIDW + qi; ntl = 12; }
        else { const int v = u - NB * GROWS * NAH; b = v / (NAH * 4); h = (v / 4) % NAH; qrow = NLAT + b * CTXL + (v & 3) * 64 + qi; ntl = 4; }
        float q[64];
        { const u32x4* qp = (const u32x4*)(Q + (size_t)qrow * D + h * 64);
#pragma unroll
          for (int g = 0; g < 8; ++g) { const u32x4 w = qp[g]; q[8 * g] = bf_lo(w.x); q[8 * g + 1] = bf_hi(w.x); q[8 * g + 2] = bf_lo(w.y); q[8 * g + 3] = bf_hi(w.y); q[8 * g + 4] = bf_lo(w.z); q[8 * g + 5] = bf_hi(w.z); q[8 * g + 6] = bf_lo(w.w); q[8 * g + 7] = bf_hi(w.w); } }
        float m = -3.0e38f, l = 0.f, acc[64];
#pragma unroll
        for (int i = 0; i < 64; ++i) acc[i] = 0.f;
        const int c0 = qi - 8 < 0 ? 0 : (qi - 8 > 48 ? 48 : qi - 8);
        for (int tl = 0; tl < ntl; ++tl) {
            const bool local = lat && tl < 8;
            const int krow0 = local ? b * SEQ + (r0 + tl) * GRIDW : NLAT + b * CTXL + (lat ? tl - 8 : tl) * 64;
            __syncthreads();
            { const int kr = X.tid >> 3, kc = (X.tid & 7) * 8;
              *(LAS u32x4*)(kT + kr * PITCH + kc) = *(const u32x4*)(K + (size_t)(krow0 + kr) * D + h * 64 + kc);
              *(LAS u32x4*)(vT + kr * PITCH + kc) = *(const u32x4*)(V + (size_t)(krow0 + kr) * D + h * 64 + kc); }
            __syncthreads();
            for (int j = 0; j < 8; ++j) { const int key = kp + 8 * j;
                if (local && (key < c0 || key >= c0 + 16)) continue;
                float s = 0.f;
#pragma unroll
                for (int g = 0; g < 8; ++g) { const u32x4 w = *(const LAS u32x4*)(kT + key * PITCH + 8 * g);
                    s += q[8 * g] * bf_lo(w.x) + q[8 * g + 1] * bf_hi(w.x) + q[8 * g + 2] * bf_lo(w.y) + q[8 * g + 3] * bf_hi(w.y) + q[8 * g + 4] * bf_lo(w.z) + q[8 * g + 5] * bf_hi(w.z) + q[8 * g + 6] * bf_lo(w.w) + q[8 * g + 7] * bf_hi(w.w); }
                s *= 0.125f;
                if (local) { int dc = key - qi; dc = dc < -15 ? -15 : (dc > 15 ? 15 : dc); s += rpb[(h * 15 + (r0 + tl - r + 7)) * 31 + dc + 15]; }
                if (s > m) { const float sc = __expf(m - s); l *= sc;
#pragma unroll
                    for (int i = 0; i < 64; ++i) acc[i] *= sc;
                    m = s; }
                const float p = __expf(s - m); l += p;
#pragma unroll
                for (int g = 0; g < 8; ++g) { const u32x4 w = *(const LAS u32x4*)(vT + key * PITCH + 8 * g);
                    acc[8 * g] += p * bf_lo(w.x); acc[8 * g + 1] += p * bf_hi(w.x); acc[8 * g + 2] += p * bf_lo(w.y); acc[8 * g + 3] += p * bf_hi(w.y);
                    acc[8 * g + 4] += p * bf_lo(w.z); acc[8 * g + 5] += p * bf_hi(w.z); acc[8 * g + 6] += p * bf_lo(w.w); acc[8 * g + 7] += p * bf_hi(w.w); }
            }
        }
        float mm = m;
        mm = fmaxf(mm, __shfl_xor(mm, 1)); mm = fmaxf(mm, __shfl_xor(mm, 2)); mm = fmaxf(mm, __shfl_xor(mm, 4));
        const float sc = __expf(m - mm); l *= sc;
        l += __shfl_xor(l, 1); l += __shfl_xor(l, 2); l += __shfl_xor(l, 4);
        const float inv = 1.0f / l;
        float mine[8];
#pragma unroll
        for (int i = 0; i < 64; ++i) { float v = acc[i] * sc; v += __shfl_xor(v, 1); v += __shfl_xor(v, 2); v += __shfl_xor(v, 4); if ((i >> 3) == kp) mine[i & 7] = v * inv; }
        u32x4 w; w.x = cvt_pk_bf16(mine[0], mine[1]); w.y = cvt_pk_bf16(mine[2], mine[3]); w.z = cvt_pk_bf16(mine[4], mine[5]); w.w = cvt_pk_bf16(mine[6], mine[7]);
        *(u32x4*)(O + (size_t)qrow * D + h * 64 + kp * 8) = w;
    }
}

template <int CBLO, int CBHI, bool LOCAL>
__device__ __forceinline__ void attn_tile(const LAS unsigned char* kt, const LAS unsigned char* vt, const LAS float* blr, const bf16x8 (&qf)[2], float& m, float& lsum, f32x4 (&o)[4], int ql, int g, int qc, int c0) {
    constexpr int PITCH = 272;
    f32x4 s[4];
#pragma unroll
    for (int cb = CBLO; cb <= CBHI; ++cb) { s[cb] = (f32x4){0.f, 0.f, 0.f, 0.f};
#pragma unroll
        for (int ss = 0; ss < 2; ++ss) { const bf16x8 kf = *(const LAS bf16x8*)(kt + (16 * cb + ql) * PITCH + ss * 64 + g * 16);
            s[cb] = __builtin_amdgcn_mfma_f32_16x16x32_bf16(kf, qf[ss], s[cb], 0, 0, 0); } }
    float mx = -1.0e30f;
#pragma unroll
    for (int cb = CBLO; cb <= CBHI; ++cb)
#pragma unroll
        for (int rg = 0; rg < 4; ++rg) { float v = s[cb][rg] * 0.18033688011112042f;
            if (LOCAL) { const int kc = 16 * cb + 4 * g + rg; int dc = kc - qc; dc = dc < -15 ? -15 : (dc > 15 ? 15 : dc);
                v += blr[dc + 15]; v = (kc >= c0 && kc < c0 + 16) ? v : -1.0e30f; }
            s[cb][rg] = v; mx = fmaxf(mx, v); }
    mx = fmaxf(mx, __shfl_xor(mx, 16)); mx = fmaxf(mx, __shfl_xor(mx, 32));
    const float mn = fmaxf(m, mx), alpha = __builtin_amdgcn_exp2f(m - mn); m = mn;
    float ps = 0.f;
#pragma unroll
    for (int cb = CBLO; cb <= CBHI; ++cb)
#pragma unroll
        for (int rg = 0; rg < 4; ++rg) { const float p = __builtin_amdgcn_exp2f(s[cb][rg] - mn); s[cb][rg] = p; ps += p; }
    lsum = lsum * alpha + ps;
#pragma unroll
    for (int db = 0; db < 4; ++db) o[db] = o[db] * alpha;
#pragma unroll
    for (int pr = 0; pr < 2; ++pr) {
        if (2 * pr + 1 < CBLO || 2 * pr > CBHI) continue;
        const f32x4 z = (f32x4){0.f, 0.f, 0.f, 0.f};
        const f32x4 s0 = (2 * pr >= CBLO && 2 * pr <= CBHI) ? s[2 * pr] : z, s1 = (2 * pr + 1 >= CBLO && 2 * pr + 1 <= CBHI) ? s[2 * pr + 1] : z;
        u32x4 pw; pw.x = cvtpk(s0[0], s0[1]); pw.y = cvtpk(s0[2], s0[3]); pw.z = cvtpk(s1[0], s1[1]); pw.w = cvtpk(s1[2], s1[3]);
        const bf16x8 pf = __builtin_bit_cast(bf16x8, pw);
#pragma unroll
        for (int db = 0; db < 4; ++db) {
            const LAS unsigned char* vp = vt + (32 * pr + 4 * g + (ql >> 2)) * PITCH + (16 * db + 4 * (ql & 3)) * 2;
            const s16x4 t0 = lds_tr16(vp), t1 = lds_tr16(vp + 16 * PITCH);
            const bf16x8 vf = (bf16x8){t0[0], t0[1], t0[2], t0[3], t1[0], t1[1], t1[2], t1[3]};
            o[db] = __builtin_amdgcn_mfma_f32_16x16x32_bf16(vf, pf, o[db], 0, 0, 0); } }
}
__device__ __forceinline__ void attn_phase(const Ctx& X0, const PArgs& a, int j_na, bool with_ctx) {
    const Ctx X = fresh_ctx(X0);
    unsigned char* ws = a.ws;
    const bf16_t* Q = (const bf16_t*)(ws + WS_Q); const bf16_t* K = (const bf16_t*)(ws + WS_K); const bf16_t* V = (const bf16_t*)(ws + WS_V); bf16_t* O = (bf16_t*)(ws + WS_O);
    const float* rpb = a.in(I_NARPB) + (size_t)j_na * NAH * 15 * 31;
    constexpr int PITCH = 272, TILEB = 64 * PITCH;
    LAS unsigned char* Kb = X.lds; LAS unsigned char* Vb = X.lds + 2 * TILEB; LAS float* bl = (LAS float*)(X.lds + 4 * TILEB);
    const int hsel = X.wave >> 2, jb = X.wave & 3, ql = X.lane & 15, g = X.lane >> 4;
    const int nlat = NB * GROWS * 8, nunits = nlat + (with_ctx ? NB * 8 * 4 : 0);
    const int skey = X.tid >> 3, sch = (X.tid & 7) * 16;
    const int qc = 16 * jb + ql, c0 = qc - 8 < 0 ? 0 : (qc - 8 > 48 ? 48 : qc - 8);
    const int nper = (X.G % 8 == 0 && nlat % 8 == 0) ? nlat / 8 : 0, wpx = X.G / 8;
    for (int k = 0; ; ++k) {
        int u;
        if (nper) { const int iu = (X.bid >> 3) + wpx * k; u = iu < nper ? (X.bid & 7) * nper + iu : nlat + (iu - nper) * 8 + (X.bid & 7); }
        else u = X.bid + X.G * k;
        if (u >= nunits) break;
        const bool lat = u < nlat; int b, h0, r = 0, r0 = 0, qrow0, ntl;
        if (lat) { b = u / (GROWS * 8); const int rem = u % (GROWS * 8); h0 = (rem >> 7) * 2; r = rem & 127; r0 = r - 4; r0 = r0 < 0 ? 0 : (r0 > GROWS - 8 ? GROWS - 8 : r0); qrow0 = b * SEQ + r * GRIDW; ntl = 12; }
        else { const int v = u - nlat; b = v >> 5; h0 = ((v >> 2) & 7) * 2; qrow0 = NLAT + b * CTXL + (v & 3) * 64; ntl = 4; }
        const int h = h0 + hsel;
        bf16x8 qf[2];
        { const bf16_t* qp = Q + (size_t)(qrow0 + 16 * jb + ql) * D + h * 64 + 8 * g; qf[0] = *(const bf16x8*)qp; qf[1] = *(const bf16x8*)(qp + 32); }
        __syncthreads();
        if (lat) for (int idx = X.tid; idx < 512; idx += 512) { const int hh = idx >> 8, i = (idx >> 5) & 7, dc = idx & 31; bl[idx] = dc < 31 ? rpb[((h0 + hh) * 15 + (r0 + i - r + 7)) * 31 + dc] * 1.4426950408889634f : 0.f; }
        float m = -1.0e30f, lsum = 0.f; f32x4 o[4];
#pragma unroll
        for (int i = 0; i < 4; ++i) o[i] = (f32x4){0.f, 0.f, 0.f, 0.f};
        u32x4 kr[2], vr[2];
        { const int krow0 = lat ? b * SEQ + r0 * GRIDW : NLAT + b * CTXL; const size_t go = (size_t)(krow0 + skey) * D + h0 * 64 + sch;
          kr[0] = *(const u32x4*)(K + go); kr[1] = *(const u32x4*)(K + go + 8); vr[0] = *(const u32x4*)(V + go); vr[1] = *(const u32x4*)(V + go + 8); }
        for (int tl = 0; tl < ntl; ++tl) {
            const int buf = tl & 1;
            { LAS unsigned char* kd = Kb + buf * TILEB + skey * PITCH + sch * 2; LAS unsigned char* vd = Vb + buf * TILEB + skey * PITCH + sch * 2;
              *(LAS u32x4*)kd = kr[0]; *(LAS u32x4*)(kd + 16) = kr[1]; *(LAS u32x4*)vd = vr[0]; *(LAS u32x4*)(vd + 16) = vr[1]; }
            __syncthreads();
            if (tl + 1 < ntl) { const int t1 = tl + 1; const int krow0 = (lat && t1 < 8) ? b * SEQ + (r0 + t1) * GRIDW : NLAT + b * CTXL + (lat ? t1 - 8 : t1) * 64;
                const size_t go = (size_t)(krow0 + skey) * D + h0 * 64 + sch;
                kr[0] = *(const u32x4*)(K + go); kr[1] = *(const u32x4*)(K + go + 8); vr[0] = *(const u32x4*)(V + go); vr[1] = *(const u32x4*)(V + go + 8); }
            const bool local = lat && tl < 8;
            const LAS unsigned char* kt = Kb + buf * TILEB + hsel * 128; const LAS unsigned char* vt = Vb + buf * TILEB + hsel * 128; const LAS float* blr = bl + hsel * 256 + tl * 32;
            if (!local) attn_tile<0, 3, false>(kt, vt, blr, qf, m, lsum, o, ql, g, qc, c0);
            else if (jb == 0) attn_tile<0, 1, true>(kt, vt, blr, qf, m, lsum, o, ql, g, qc, c0);
            else if (jb == 1) attn_tile<0, 2, true>(kt, vt, blr, qf, m, lsum, o, ql, g, qc, c0);
            else if (jb == 2) attn_tile<1, 3, true>(kt, vt, blr, qf, m, lsum, o, ql, g, qc, c0);
            else attn_tile<2, 3, true>(kt, vt, blr, qf, m, lsum, o, ql, g, qc, c0);
        }
        lsum += __shfl_xor(lsum, 16); lsum += __shfl_xor(lsum, 32);
        const float inv = 1.0f / lsum;
        bf16_t* op = O + (size_t)(qrow0 + 16 * jb + ql) * D + h * 64 + 4 * g;
#pragma unroll
        for (int db = 0; db < 4; ++db) { u32x2 w; w.x = cvtpk(o[db][0] * inv, o[db][1] * inv); w.y = cvtpk(o[db][2] * inv, o[db][3] * inv); *(u32x2*)(op + 16 * db) = w; }
    }
}

constexpr size_t WS_GW = 931 * MiB, WS_DEN = 934 * MiB;
constexpr int QK_PITCH = 1040;
__device__ __forceinline__ int tb_row0(int b, int tb) { return tb < 4 ? NLAT + b * CTXL + tb * 64 : b * SEQ + (tb - 4) * 64; }
template <class RowMap>
__device__ __forceinline__ void stage_qk_direct(const Ctx& X, const bf16_t* XC, int h, const float* wq, const float* wk, LAS unsigned char* qL, LAS unsigned char* kL, const RowMap& rowmap) {
    const int bc = X.tid & 127, nbq = h * 128 + bc, rr = X.tid >> 7; const float kscale = 0.044194173824159216f;
    float wqr[16], wkr[16];
#pragma unroll
    for (int i = 0; i < 16; ++i) { wqr[i] = wq[nbq * 16 + i]; wkr[i] = wk[nbq * 16 + i] * kscale; }
#pragma unroll 4
    for (int i = 0; i < 16; ++i) { const int tl = rr + 4 * i; const int row = rowmap(tl);
        const u32x2 w = *(const u32x2*)(XC + (size_t)row * MLI + h * 512 + 4 * bc);
        const float x0 = bf_lo(w.x), x1 = bf_hi(w.x), x2 = bf_lo(w.y), x3 = bf_hi(w.y);
        float qo[4], ko[4];
#pragma unroll
        for (int dd = 0; dd < 4; ++dd) { qo[dd] = x0 * wqr[dd] + x1 * wqr[4 + dd] + x2 * wqr[8 + dd] + x3 * wqr[12 + dd]; ko[dd] = x0 * wkr[dd] + x1 * wkr[4 + dd] + x2 * wkr[8 + dd] + x3 * wkr[12 + dd]; }
        u32x2 oq, ok; oq.x = cvtpk(qo[0], qo[1]); oq.y = cvtpk(qo[2], qo[3]); ok.x = cvtpk(ko[0], ko[1]); ok.y = cvtpk(ko[2], ko[3]);
        *(LAS u32x2*)(qL + tl * QK_PITCH + 8 * bc) = oq; *(LAS u32x2*)(kL + tl * QK_PITCH + 8 * bc) = ok; }
}
__device__ __forceinline__ void scanA_phase(const Ctx& X0, const PArgs& a) {
    const Ctx X = fresh_ctx(X0);
    unsigned char* ws = a.ws;
    const bf16_t* XM = (const bf16_t*)(ws + WS_XM); const bf16_t* XC = (const bf16_t*)(ws + WS_XC); const float* GT = (const float*)(ws + WS_GT);
    float* GW = (float*)(ws + WS_GW); float* DEN = (float*)(ws + WS_DEN);
    LAS unsigned char* qL = X.lds; LAS unsigned char* kL = X.lds + 64 * QK_PITCH; LAS unsigned char* atL = X.lds + 128 * QK_PITCH;
    LAS unsigned char* vtL = X.lds;
    LAS float* gl = (LAS float*)(X.lds + 128 * QK_PITCH + 2 * 64 * 144);
    constexpr int AP = 144;
    const int ql = X.lane & 15, g = X.lane >> 4;
    for (int item = X.bid; item < NB * MLH * 132; item += X.G) {
        const int b = item / (MLH * 132), rem = item % (MLH * 132), h = rem / 132, tb = rem % 132, R0 = tb_row0(b, tb);
        __syncthreads();
        stage_qk_direct(X, XC, h, a.in(I_MLWQ), a.in(I_MLWK), qL, kL, [&](int tl) { return R0 + tl; });
        if (X.wave == 0) {
            const float* gp = GT + (size_t)(R0 + X.lane) * 16;
            const float i_f = gp[h], f_f = gp[4 + h], i_b = gp[8 + h], f_b = gp[12 + h];
            const float lf = fminf(f_f, 0.f) - log1pf(expf(-fabsf(f_f))), lb = fminf(f_b, 0.f) - log1pf(expf(-fabsf(f_b)));
            float cf = lf, cb = lb;
#pragma unroll
            for (int o = 1; o < 64; o <<= 1) { const float tf = __shfl_up(cf, o), tb2 = __shfl_down(cb, o); if (X.lane >= o) cf += tf; if (X.lane + o < 64) cb += tb2; }
            gl[X.lane] = cf; gl[64 + X.lane] = cb; gl[128 + X.lane] = i_f; gl[192 + X.lane] = i_b;
            const float cfT = __shfl(cf, 63), cbT = __shfl(cb, 0);
            float* gw = GW + ((size_t)(R0 + X.lane) * 8 + h) * 2;
            gw[0] = expf(cf); gw[1] = expf(cfT - cf + i_f); gw[8] = expf(cb); gw[9] = expf(cbT - cb + i_b);
        }
        __syncthreads();
        { const int tt = X.wave & 3, sh = X.wave >> 2;
          f32x4 s2[2] = {(f32x4){0.f, 0.f, 0.f, 0.f}, (f32x4){0.f, 0.f, 0.f, 0.f}};
          const LAS unsigned char* qa = qL + (16 * tt + ql) * QK_PITCH + 16 * g; const LAS unsigned char* ka = kL + (32 * sh + ql) * QK_PITCH + 16 * g;
#pragma unroll 4
          for (int ks = 0; ks < 16; ++ks) { const bf16x8 qf = *(const LAS bf16x8*)(qa + 64 * ks), k0 = *(const LAS bf16x8*)(ka + 64 * ks), k1 = *(const LAS bf16x8*)(ka + 16 * QK_PITCH + 64 * ks);
              s2[0] = __builtin_amdgcn_mfma_f32_16x16x32_bf16(k0, qf, s2[0], 0, 0, 0); s2[1] = __builtin_amdgcn_mfma_f32_16x16x32_bf16(k1, qf, s2[1], 0, 0, 0); }
          const int t = 16 * tt + ql; const float bft = gl[t], bbt = gl[64 + t];
#pragma unroll
          for (int i = 0; i < 2; ++i) { float af[4], ab[4];
#pragma unroll
              for (int rg = 0; rg < 4; ++rg) { const int s = 32 * sh + 16 * i + 4 * g + rg; const float v = s2[i][rg];
                  af[rg] = (s <= t) ? v * __expf(bft - gl[s] + gl[128 + s]) : 0.f; ab[rg] = (s >= t) ? v * __expf(bbt - gl[64 + s] + gl[192 + s]) : 0.f; }
              u32x2 wf, wb; wf.x = cvtpk(af[0], af[1]); wf.y = cvtpk(af[2], af[3]); wb.x = cvtpk(ab[0], ab[1]); wb.y = cvtpk(ab[2], ab[3]);
              *(LAS u32x2*)(atL + t * AP + (32 * sh + 16 * i + 4 * g) * 2) = wf; *(LAS u32x2*)(atL + 64 * AP + t * AP + (32 * sh + 16 * i + 4 * g) * 2) = wb; } }
        __syncthreads();
        { const int bc = X.tid & 127, sg = X.tid >> 7, nb = h * 128 + bc; const float* pv = a.in(I_MLWV) + nb * 16; float wvr[16];
#pragma unroll
          for (int i = 0; i < 16; ++i) wvr[i] = pv[i];
#pragma unroll
          for (int i = 0; i < 4; ++i) { const int s0 = 16 * i + 4 * sg; float vv[4][4];
#pragma unroll
              for (int r = 0; r < 4; ++r) { const u32x2 w = *(const u32x2*)(XM + (size_t)(R0 + s0 + r) * MLI + 4 * nb); const float x0 = bf_lo(w.x), x1 = bf_hi(w.x), x2 = bf_lo(w.y), x3 = bf_hi(w.y);
#pragma unroll
                  for (int dd = 0; dd < 4; ++dd) vv[r][dd] = x0 * wvr[dd] + x1 * wvr[4 + dd] + x2 * wvr[8 + dd] + x3 * wvr[12 + dd]; }
#pragma unroll
              for (int dd = 0; dd < 4; ++dd) { u32x2 o; o.x = cvtpk(vv[0][dd], vv[1][dd]); o.y = cvtpk(vv[2][dd], vv[3][dd]); *(LAS u32x2*)(vtL + (4 * bc + dd) * AP + s0 * 2) = o; } }
          if (X.tid < 128) { const int dir = X.tid >> 6, t = X.tid & 63; float s = 0.f;
#pragma unroll
              for (int c = 0; c < 8; ++c) { const u32x4 w = *(const LAS u32x4*)(atL + dir * 64 * AP + t * AP + 16 * c); s += (bf_lo(w.x) + bf_hi(w.x)) + (bf_lo(w.y) + bf_hi(w.y)) + (bf_lo(w.z) + bf_hi(w.z)) + (bf_lo(w.w) + bf_hi(w.w)); }
              DEN[((size_t)(R0 + t) * 2 + dir) * 4 + h] = s; } }
        __syncthreads();
        { bf16x8 vf[4][2];
#pragma unroll
          for (int dt = 0; dt < 4; ++dt)
#pragma unroll
              for (int ks = 0; ks < 2; ++ks) vf[dt][ks] = *(const LAS bf16x8*)(vtL + (64 * X.wave + 16 * dt + ql) * AP + 64 * ks + 16 * g);
#pragma unroll
          for (int dir = 0; dir < 2; ++dir) { bf16_t* HO = (bf16_t*)(ws + (dir ? WS_HB : WS_HF));
#pragma unroll
              for (int tt = 0; tt < 4; ++tt) { f32x4 acc[4];
#pragma unroll
                  for (int dt = 0; dt < 4; ++dt) acc[dt] = (f32x4){0.f, 0.f, 0.f, 0.f};
#pragma unroll
                  for (int ks = 0; ks < 2; ++ks) { const bf16x8 af = *(const LAS bf16x8*)(atL + dir * 64 * AP + (16 * tt + ql) * AP + 64 * ks + 16 * g);
#pragma unroll
                      for (int dt = 0; dt < 4; ++dt) acc[dt] = __builtin_amdgcn_mfma_f32_16x16x32_bf16(vf[dt][ks], af, acc[dt], 0, 0, 0); }
                  bf16_t* op = HO + (size_t)(R0 + 16 * tt + ql) * MLI + h * 512 + 64 * X.wave + 4 * g;
#pragma unroll
                  for (int dt = 0; dt < 4; ++dt) { u32x2 w; w.x = cvtpk(acc[dt][0], acc[dt][1]); w.y = cvtpk(acc[dt][2], acc[dt][3]); *(u32x2*)(op + 16 * dt) = w; } } } }
    }
}

__device__ __forceinline__ void scanB_phase(const Ctx& X0, const PArgs& a, bool dry = false) {
    const Ctx X = fresh_ctx(X0);
    unsigned char* ws = a.ws;
    const bf16_t* XM = (const bf16_t*)(ws + WS_XM); const bf16_t* XC = (const bf16_t*)(ws + WS_XC); const float* GW = (const float*)(ws + WS_GW); const float* DEN = (const float*)(ws + WS_DEN);
    constexpr int AP = 144;
    LAS unsigned char* qL = X.lds; LAS unsigned char* kL = X.lds + 64 * QK_PITCH; LAS unsigned char* vL = X.lds + 128 * QK_PITCH;
    LAS bf16_t* xL = (LAS bf16_t*)(X.lds + 128 * QK_PITCH + 64 * AP);
    LAS float* sm = (LAS float*)(X.lds + 128 * QK_PITCH + 64 * AP + 8192);
    LAS float* wL = sm; LAS float* wgL = sm + 128; LAS float* denL = sm + 256; LAS float* qnL = sm + 384; LAS float* nL = sm + 448;
    const int db = X.wave & 3, eh = X.wave >> 2;
    const float kscale = 0.044194173824159216f;
    for (int item = X.bid; item < 256; item += X.G) {
        int chain = item >> 3, sl = item & 7;
        if (X.G == 256) { const int k = item >> 3; chain = (k >> 3) * 8 + (item & 7); sl = k & 7; }
        const int b = chain >> 3, h = (chain >> 1) & 3, dir = chain & 1;
        bf16_t* HO = (bf16_t*)(ws + (dir ? WS_HB : WS_HF));
        f32x4 ct[16];
#pragma unroll
        for (int j = 0; j < 16; ++j) ct[j] = (f32x4){0.f, 0.f, 0.f, 0.f};
        float n_e = 0.f;
        const int vb = X.tid & 15, vr = X.tid >> 4;
        bf16x8 aq[2][2], ak[2][2];
        { const int ql0 = X.lane & 15, g0 = X.lane >> 4; const float* wq = a.in(I_MLWQ); const float* wk = a.in(I_MLWK);
#pragma unroll
          for (int i = 0; i < 2; ++i)
#pragma unroll
              for (int nt = 0; nt < 2; ++nt) { float fq[8], fk[8];
#pragma unroll
                  for (int j = 0; j < 8; ++j) { const int cl = 8 * g0 + j, nl = 16 * nt + ql0; const bool on = (cl >> 2) == (nl >> 2);
                      const int nb = h * 128 + ((64 * X.wave + 32 * i + cl) >> 2); const int wi = nb * 16 + (cl & 3) * 4 + (nl & 3);
                      fq[j] = on ? wq[wi] : 0.f; fk[j] = on ? wk[wi] * kscale : 0.f; }
                  u32x4 pq, pk; pq.x = cvtpk(fq[0], fq[1]); pq.y = cvtpk(fq[2], fq[3]); pq.z = cvtpk(fq[4], fq[5]); pq.w = cvtpk(fq[6], fq[7]);
                  pk.x = cvtpk(fk[0], fk[1]); pk.y = cvtpk(fk[2], fk[3]); pk.z = cvtpk(fk[4], fk[5]); pk.w = cvtpk(fk[6], fk[7]);
                  aq[i][nt] = __builtin_bit_cast(bf16x8, pq); ak[i][nt] = __builtin_bit_cast(bf16x8, pk); } }
        const float* wvp = a.in(I_MLWV) + (h * 128 + sl * 16) * 16;
        u32x4 pxc[2][4]; u32x2 pxm[2]; float pw = 0.f, pwg = 0.f, pden = 0.f;
        const int rstep = dir ? -1 : 1;
#define SCB_RB(ch_) (((ch_) < 4) ? (NLAT + b * CTXL + (dir ? CTXL - 1 - 64 * (ch_) : 64 * (ch_))) : (b * SEQ + (dir ? SEQ - 1 - 64 * ((ch_) - 4) : 64 * ((ch_) - 4))))
#define SCB_LOAD(ch_) do { const int rbn_ = SCB_RB(ch_); const int ltid_ = ltid; _Pragma("unroll") for (int i = 0; i < 2; ++i) _Pragma("unroll") for (int tt = 0; tt < 4; ++tt) pxc[i][tt] = *(const u32x4*)(XC + (size_t)(rbn_ + rstep * (16 * tt + pql)) * MLI + xcoff + 32 * i); \
            _Pragma("unroll") for (int i = 0; i < 2; ++i) pxm[i] = *(const u32x2*)(XM + (size_t)(rbn_ + rstep * (2 * vr + i)) * MLI + xmoff); \
            if (ltid_ < 64) { const int row_ = rbn_ + rstep * ltid_; const float* gw_ = GW + (((size_t)row_ * 2 + dir) * 4 + h) * 2; pw = gw_[0]; pwg = gw_[1]; pden = DEN[((size_t)row_ * 2 + dir) * 4 + h]; } } while (0)
        { const int ltid = X.tid, pql = X.lane & 15; const size_t xcoff = (size_t)h * 512 + 64 * X.wave + 8 * (X.lane >> 4), xmoff = (size_t)h * 512 + sl * 64 + 4 * vb; SCB_LOAD(0); }
        for (int ch = 0; ch < (CTXL + SEQ) / 64; ++ch) {
            const int buf = ch & 1;
            { const int t1 = launder_i(X.tid); const int vb = t1 & 15, vr = t1 >> 4, sql = t1 & 15, sg = (t1 >> 4) & 3;
            nL[t1] = n_e;
            f32x4 wv4[4];
#pragma unroll
            for (int i = 0; i < 4; ++i) wv4[i] = *(const f32x4*)(wvp + vb * 16 + 4 * i);
            { const f32x4 zero4 = (f32x4){0.f, 0.f, 0.f, 0.f};
#pragma unroll
              for (int i = 0; i < 2; ++i)
#pragma unroll
                  for (int tt = 0; tt < 4; ++tt) { const bf16x8 xb = __builtin_bit_cast(bf16x8, pxc[i][tt]);
#pragma unroll
                      for (int nt = 0; nt < 2; ++nt) { const f32x4 dq = __builtin_amdgcn_mfma_f32_16x16x32_bf16(aq[i][nt], xb, zero4, 0, 0, 0), dk = __builtin_amdgcn_mfma_f32_16x16x32_bf16(ak[i][nt], xb, zero4, 0, 0, 0);
                          u32x2 oq, ok; oq.x = cvtpk(dq[0], dq[1]); oq.y = cvtpk(dq[2], dq[3]); ok.x = cvtpk(dk[0], dk[1]); ok.y = cvtpk(dk[2], dk[3]);
                          const int off = (16 * tt + sql) * QK_PITCH + (64 * X.wave + 32 * i + 16 * nt + 4 * sg) * 2;
                          *(LAS u32x2*)(qL + off) = oq; *(LAS u32x2*)(kL + off) = ok; } } }
            { float vv[2][4];
#pragma unroll
              for (int i = 0; i < 2; ++i) { const u32x2 w = pxm[i]; const float x0 = bf_lo(w.x), x1 = bf_hi(w.x), x2 = bf_lo(w.y), x3 = bf_hi(w.y);
#pragma unroll
                  for (int dd = 0; dd < 4; ++dd) vv[i][dd] = x0 * wv4[0][dd] + x1 * wv4[1][dd] + x2 * wv4[2][dd] + x3 * wv4[3][dd]; }
#pragma unroll
              for (int dd = 0; dd < 4; ++dd) *(LAS unsigned*)(vL + (4 * vb + dd) * AP + (2 * vr) * 2) = cvtpk(vv[0][dd], vv[1][dd]); }
            if (t1 < 64) { wL[buf * 64 + t1] = pw; wgL[buf * 64 + t1] = pwg; denL[buf * 64 + t1] = pden; } }
            asm volatile("s_waitcnt lgkmcnt(0)\n\ts_barrier" ::: "memory");
            if (ch + 1 < (CTXL + SEQ) / 64) { const int ltid = launder_i(X.tid); const int vb = ltid & 15, vr = ltid >> 4, pql = ltid & 15;
                const size_t xcoff = (size_t)h * 512 + 64 * X.wave + 8 * ((ltid >> 4) & 3), xmoff = (size_t)h * 512 + sl * 64 + 4 * vb; SCB_LOAD(ch + 1); }
            const int rb0 = SCB_RB(ch);
            const int l2 = launder_i(X.lane); const int ql = l2 & 15, g = l2 >> 4; const size_t hooff = (size_t)h * 512 + sl * 64 + 16 * db + 4 * g;
            u32x2 ni[4];
            if (eh == 0) {
#pragma unroll
                for (int tt = 0; tt < 4; ++tt) ni[tt] = *(const u32x2*)(HO + (size_t)(rb0 + rstep * (16 * tt + ql)) * MLI + hooff);
            }
            f32x4 acc[4];
#pragma unroll
            for (int tt = 0; tt < 4; ++tt) acc[tt] = (f32x4){0.f, 0.f, 0.f, 0.f};
#pragma unroll
            for (int kp = 0; kp < 8; ++kp) {
                u32x4 cw; cw.x = cvtpk(ct[2 * kp][0], ct[2 * kp][1]); cw.y = cvtpk(ct[2 * kp][2], ct[2 * kp][3]); cw.z = cvtpk(ct[2 * kp + 1][0], ct[2 * kp + 1][1]); cw.w = cvtpk(ct[2 * kp + 1][2], ct[2 * kp + 1][3]);
                const bf16x8 cf = __builtin_bit_cast(bf16x8, cw);
#pragma unroll
                for (int tt = 0; tt < 4; ++tt) { const LAS unsigned char* qp = qL + (16 * tt + ql) * QK_PITCH + (eh * 256 + 32 * kp + 4 * g) * 2;
                    const u32x2 lo = *(const LAS u32x2*)qp, hi = *(const LAS u32x2*)(qp + 32); const u32x4 qa = {lo.x, lo.y, hi.x, hi.y};
                    acc[tt] = __builtin_amdgcn_mfma_f32_16x16x32_bf16(cf, __builtin_bit_cast(bf16x8, qa), acc[tt], 0, 0, 0); } }
            if (eh == 1) {
#pragma unroll
                for (int tt = 0; tt < 4; ++tt) { u32x2 w; w.x = cvtpk(acc[tt][0], acc[tt][1]); w.y = cvtpk(acc[tt][2], acc[tt][3]); *(LAS u32x2*)(xL + (db * 64 + 16 * tt + ql) * 16 + 4 * g) = w; }
            }
            { const int t3 = launder_i(X.tid); const int t = t3 >> 3, part = t3 & 7; float s = 0.f;
#pragma unroll
              for (int c = 0; c < 8; ++c) { const u32x4 w = *(const LAS u32x4*)(qL + t * QK_PITCH + (64 * part + 8 * c) * 2); const f32x4 n0 = *(const LAS f32x4*)(nL + 64 * part + 8 * c), n1 = *(const LAS f32x4*)(nL + 64 * part + 8 * c + 4);
                  s += bf_lo(w.x) * n0[0] + bf_hi(w.x) * n0[1] + bf_lo(w.y) * n0[2] + bf_hi(w.y) * n0[3] + bf_lo(w.z) * n1[0] + bf_hi(w.z) * n1[1] + bf_lo(w.w) * n1[2] + bf_hi(w.w) * n1[3]; }
              s += swz_xor(s, 1); s += swz_xor(s, 2); s += swz_xor(s, 4);
              if (part == 0) qnL[t] = s; }
            const float decay = wL[buf * 64 + 63];
            { float s = 0.f;
              const int t4 = launder_i(X.tid);
#pragma unroll 8
              for (int sidx = 0; sidx < 64; ++sidx) s += wgL[buf * 64 + sidx] * bf2f(*(const LAS bf16_t*)(kL + sidx * QK_PITCH + t4 * 2));
              n_e = decay * n_e + s; }
#pragma unroll
            for (int j = 0; j < 16; ++j) ct[j] = ct[j] * decay;
            { const int l3 = launder_i(X.lane); const int ql = l3 & 15, g = l3 >> 4;
#pragma unroll
            for (int ks = 0; ks < 2; ++ks) {
                const u32x4 vraw = *(const LAS u32x4*)(vL + (16 * db + ql) * AP + 64 * ks + 16 * g);
                const f32x4 w0 = *(const LAS f32x4*)(wgL + buf * 64 + 32 * ks + 8 * g), w1 = *(const LAS f32x4*)(wgL + buf * 64 + 32 * ks + 8 * g + 4);
                u32x4 vw; vw.x = cvtpk(bf_lo(vraw.x) * w0[0], bf_hi(vraw.x) * w0[1]); vw.y = cvtpk(bf_lo(vraw.y) * w0[2], bf_hi(vraw.y) * w0[3]);
                vw.z = cvtpk(bf_lo(vraw.z) * w1[0], bf_hi(vraw.z) * w1[1]); vw.w = cvtpk(bf_lo(vraw.w) * w1[2], bf_hi(vraw.w) * w1[3]);
                const bf16x8 vf = __builtin_bit_cast(bf16x8, vw);
#pragma unroll
                for (int j = 0; j < 16; ++j) { const LAS unsigned char* kp2 = kL + (32 * ks + 8 * g + (ql >> 2)) * QK_PITCH + (eh * 256 + 16 * j + 4 * (ql & 3)) * 2;
                    const s16x4 t0 = lds_tr16(kp2), t1 = lds_tr16(kp2 + 4 * QK_PITCH);
                    const bf16x8 kf = (bf16x8){t0[0], t0[1], t0[2], t0[3], t1[0], t1[1], t1[2], t1[3]};
                    ct[j] = __builtin_amdgcn_mfma_f32_16x16x32_bf16(kf, vf, ct[j], 0, 0, 0); } } }
            asm volatile("s_waitcnt lgkmcnt(0)\n\ts_barrier" ::: "memory");
            if (eh == 0) {
#pragma unroll
                for (int tt = 0; tt < 4; ++tt) { const int t = 16 * tt + ql; const float w = wL[buf * 64 + t]; const float den = denL[buf * 64 + t] + w * qnL[t];
                    const float sc = 1.0f / (fabsf(den) > 1.0f ? fabsf(den) : 1.0f); const u32x2 xw = *(const LAS u32x2*)(xL + (db * 64 + t) * 16 + 4 * g);
                    const float o0 = (bf_lo(ni[tt].x) + w * (acc[tt][0] + bf_lo(xw.x))) * sc, o1 = (bf_hi(ni[tt].x) + w * (acc[tt][1] + bf_hi(xw.x))) * sc;
                    const float o2 = (bf_lo(ni[tt].y) + w * (acc[tt][2] + bf_lo(xw.y))) * sc, o3 = (bf_hi(ni[tt].y) + w * (acc[tt][3] + bf_hi(xw.y))) * sc;
                    u32x2 ow; ow.x = cvtpk(o0, o1); ow.y = cvtpk(o2, o3); if (!dry) *(u32x2*)(HO + (size_t)(rb0 + rstep * t) * MLI + hooff) = ow; }
            }
        }
#undef SCB_RB
#undef SCB_LOAD
    }
}
constexpr size_t WS_GT8 = 946 * MiB;
constexpr size_t WS_QG = WS_R + 132 * MiB, WS_KG = WS_R + 264 * MiB, WS_Z2 = WS_QG, WS_OA2 = WS_KG, WS_WBD = WS_WGT + 131072;

__device__ __forceinline__ void feat2_phase(const Ctx& X0, const PArgs& a, bool fewld = false) {
    const Ctx X = fresh_ctx(X0);
    unsigned char* ws = a.ws;
    const bf16_t* XM = (const bf16_t*)(ws + WS_XM); bf16_t* QG = (bf16_t*)(ws + WS_QG); bf16_t* KG = (bf16_t*)(ws + WS_KG); float* GT = (float*)(ws + WS_GT8);
    const bf16_t* G1T = (const bf16_t*)(ws + WS_WGT); const bf16_t* G2T = G1T + 16 * MLI; const u32x4* WBD = (const u32x4*)(ws + WS_WBD);
    LAS float* cwl = (LAS float*)X.lds;
    { const float* cw = a.in(I_MLCONVW); const float* cb = a.in(I_MLCONVB);
      for (int i = X.tid; i < 4 * MLI; i += 512) cwl[i] = cw[i];
      for (int i = X.tid; i < MLI; i += 512) cwl[4 * MLI + i] = cb[i]; }
    __syncthreads();
    const int fr = X.lane & 15, fq = X.lane >> 4;
    for (int it8 = X.bid * 8 + X.wave; it8 < 8 * (MT / 16); it8 += X.G * 8) {
        const int item = it8 >> 3, part = it8 & 7;
        const int row = item * 16 + fr; int base, t, len; seq_of_row(row, base, t, len);
        f32x4 acc = (f32x4){0.f, 0.f, 0.f, 0.f}; const f32x4 zero4 = (f32x4){0.f, 0.f, 0.f, 0.f};
        const bool v0 = t >= 2, v1 = t >= 1, v3 = t + 1 < len;
        const bf16_t* xr = XM + (size_t)row * MLI + 8 * fq;
        u32x4 w[4], wf[4]; bf16x8 b1, b2; const u32x4 z4 = (u32x4){0u, 0u, 0u, 0u};
#define FT_W_LOADS(jj_) if (fewld) { w[2] = *(const u32x4*)(xr + 32 * (jj_)); w[0] = v0 ? w[2] : z4; w[1] = v1 ? w[2] : z4; w[3] = v3 ? w[2] : z4; } else { \
            w[0] = v0 ? *(const u32x4*)(xr + 32 * (jj_) - 2 * MLI) : z4; w[1] = v1 ? *(const u32x4*)(xr + 32 * (jj_) - MLI) : z4; w[2] = *(const u32x4*)(xr + 32 * (jj_)); w[3] = v3 ? *(const u32x4*)(xr + 32 * (jj_) + MLI) : z4; }
#define FT_LOAD(jj_) do { const int c0_ = 32 * (jj_) + 8 * fq; \
            FT_W_LOADS(jj_) \
            b1 = *(const bf16x8*)(G1T + (size_t)fr * MLI + c0_); b2 = *(const bf16x8*)(G2T + (size_t)fr * MLI + c0_); \
            _Pragma("unroll") for (int k_ = 0; k_ < 4; ++k_) wf[k_] = WBD[((jj_) * 4 + k_) * 64 + X.lane]; } while (0)
        FT_LOAD(8 * part);
        for (int jj = 8 * part; jj < 8 * part + 8; ++jj) {
            const int c0 = 32 * jj + 8 * fq;
            u32x4 cw4[4], cwf[4]; const bf16x8 cb1 = b1, cb2 = b2;
#pragma unroll
            for (int k = 0; k < 4; ++k) { cw4[k] = w[k]; cwf[k] = wf[k]; }
            if (jj + 1 < 8 * part + 8) FT_LOAD(jj + 1);
            float xc[8];
            { const f32x4 ba = *(const LAS f32x4*)(cwl + 4 * MLI + c0), bb = *(const LAS f32x4*)(cwl + 4 * MLI + c0 + 4);
              xc[0] = ba[0]; xc[1] = ba[1]; xc[2] = ba[2]; xc[3] = ba[3]; xc[4] = bb[0]; xc[5] = bb[1]; xc[6] = bb[2]; xc[7] = bb[3]; }
#pragma unroll
            for (int tap = 0; tap < 4; ++tap) { const f32x4 ca = *(const LAS f32x4*)(cwl + tap * MLI + c0), cc = *(const LAS f32x4*)(cwl + tap * MLI + c0 + 4);
                xc[0] += bf_lo(cw4[tap].x) * ca[0]; xc[1] += bf_hi(cw4[tap].x) * ca[1]; xc[2] += bf_lo(cw4[tap].y) * ca[2]; xc[3] += bf_hi(cw4[tap].y) * ca[3];
                xc[4] += bf_lo(cw4[tap].z) * cc[0]; xc[5] += bf_hi(cw4[tap].z) * cc[1]; xc[6] += bf_lo(cw4[tap].w) * cc[2]; xc[7] += bf_hi(cw4[tap].w) * cc[3]; }
#pragma unroll
            for (int i = 0; i < 8; ++i) xc[i] = silu_f(xc[i]);
            u32x4 o; o.x = cvtpk(xc[0], xc[1]); o.y = cvtpk(xc[2], xc[3]); o.z = cvtpk(xc[4], xc[5]); o.w = cvtpk(xc[6], xc[7]);
            const bf16x8 xf = __builtin_bit_cast(bf16x8, o);
            acc = __builtin_amdgcn_mfma_f32_16x16x32_bf16(xf, cb1, acc, 0, 0, 0);
            acc = __builtin_amdgcn_mfma_f32_16x16x32_bf16(__builtin_bit_cast(bf16x8, cw4[2]), cb2, acc, 0, 0, 0);
            { const f32x4 dq0 = __builtin_amdgcn_mfma_f32_16x16x32_bf16(__builtin_bit_cast(bf16x8, cwf[0]), xf, zero4, 0, 0, 0), dq1 = __builtin_amdgcn_mfma_f32_16x16x32_bf16(__builtin_bit_cast(bf16x8, cwf[1]), xf, zero4, 0, 0, 0);
              const f32x4 dk0 = __builtin_amdgcn_mfma_f32_16x16x32_bf16(__builtin_bit_cast(bf16x8, cwf[2]), xf, zero4, 0, 0, 0), dk1 = __builtin_amdgcn_mfma_f32_16x16x32_bf16(__builtin_bit_cast(bf16x8, cwf[3]), xf, zero4, 0, 0, 0);
              u32x4 oq, ok; oq.x = cvtpk(dq0[0], dq0[1]); oq.y = cvtpk(dq0[2], dq0[3]); oq.z = cvtpk(dq1[0], dq1[1]); oq.w = cvtpk(dq1[2], dq1[3]);
              ok.x = cvtpk(dk0[0], dk0[1]); ok.y = cvtpk(dk0[2], dk0[3]); ok.z = cvtpk(dk1[0], dk1[1]); ok.w = cvtpk(dk1[2], dk1[3]);
              *(u32x4*)(QG + (size_t)((item >> 2) * 64 + (item & 3) * 16 + (jj & 15)) * MLI + (jj >> 4) * 512 + X.lane * 8) = oq;
              *(u32x4*)(KG + (size_t)row * MLI + c0) = ok; }
        }
#undef FT_LOAD
#pragma unroll
        for (int r = 0; r < 4; ++r) GT[((size_t)part * MT + item * 16 + 4 * fq + r) * 16 + fr] = acc[r];
    }
}

__device__ __forceinline__ void scanA2_phase(const Ctx& X0, const PArgs& a) {
    const Ctx X = fresh_ctx(X0);
    unsigned char* ws = a.ws;
    const bf16_t* XM = (const bf16_t*)(ws + WS_XM); const bf16_t* QG = (const bf16_t*)(ws + WS_QG); bf16_t* KG = (bf16_t*)(ws + WS_KG); const float* GT = (const float*)(ws + WS_GT8);
    float* GW = (float*)(ws + WS_GW); float* DEN = (float*)(ws + WS_DEN);
    LAS unsigned char* qL = X.lds; LAS unsigned char* kL = X.lds + 64 * QK_PITCH; LAS unsigned char* atL = X.lds + 128 * QK_PITCH;
    LAS unsigned char* vtL = X.lds;
    LAS float* gl = (LAS float*)(X.lds + 128 * QK_PITCH + 2 * 64 * 144);
    constexpr int AP = 144;
    const int ql = X.lane & 15, g = X.lane >> 4;
    for (int item = X.bid; item < NB * MLH * 132; item += X.G) {
        const int b = item / (MLH * 132), rem = item % (MLH * 132), h = rem / 132, tb = rem % 132, R0 = tb_row0(b, tb);
        __syncthreads();
#pragma unroll
        for (int i = 0; i < 8; ++i) { const int id = X.tid + 512 * i, rw = id >> 6, pc = id & 63; const size_t go = (size_t)(R0 + rw) * MLI + h * 512 + pc * 8;
            *(LAS u32x4*)(qL + (16 * (rw >> 4) + (pc & 15)) * QK_PITCH + (4 * (rw & 15) + (pc >> 4)) * 16) = *(const u32x4*)(QG + go);
            *(LAS u32x4*)(kL + rw * QK_PITCH + pc * 16) = *(const u32x4*)(KG + go); }
        if (X.wave == 0) {
            const float* gp = GT + (size_t)(R0 + X.lane) * 16; const float* bgp = a.in(I_MLBG);
            float i_f = bgp[h], f_f = bgp[4 + h], i_b = bgp[8 + h], f_b = bgp[12 + h];
#pragma unroll
            for (int pp = 0; pp < 8; ++pp) { const float* g8 = gp + (size_t)pp * MT * 16; i_f += g8[h]; f_f += g8[4 + h]; i_b += g8[8 + h]; f_b += g8[12 + h]; }
            const float lf = fminf(f_f, 0.f) - log1pf(expf(-fabsf(f_f))), lb = fminf(f_b, 0.f) - log1pf(expf(-fabsf(f_b)));
            float cf = lf, cb = lb;
#pragma unroll
            for (int o = 1; o < 64; o <<= 1) { const float tf = __shfl_up(cf, o), tb2 = __shfl_down(cb, o); if (X.lane >= o) cf += tf; if (X.lane + o < 64) cb += tb2; }
            gl[X.lane] = cf; gl[64 + X.lane] = cb; gl[128 + X.lane] = i_f; gl[192 + X.lane] = i_b;
            const float cfT = __shfl(cf, 63), cbT = __shfl(cb, 0);
            float* gw = GW + ((size_t)(R0 + X.lane) * 8 + h) * 2;
            gw[0] = expf(cf); gw[1] = expf(cfT - cf + i_f); gw[8] = expf(cb); gw[9] = expf(cbT - cb + i_b);
        }
        __syncthreads();
        { const int tt = X.wave & 3, sh = X.wave >> 2;
          f32x4 s2[2] = {(f32x4){0.f, 0.f, 0.f, 0.f}, (f32x4){0.f, 0.f, 0.f, 0.f}};
          const LAS unsigned char* qa = qL + (16 * tt + ql) * QK_PITCH + 16 * g; const LAS unsigned char* ka = kL + (32 * sh + ql) * QK_PITCH + 8 * g;
#pragma unroll 4
          for (int ks = 0; ks < 16; ++ks) { const bf16x8 qf = *(const LAS bf16x8*)(qa + 64 * ks);
              const u32x2 a0 = *(const LAS u32x2*)(ka + 64 * ks), a1 = *(const LAS u32x2*)(ka + 64 * ks + 32), c0 = *(const LAS u32x2*)(ka + 16 * QK_PITCH + 64 * ks), c1 = *(const LAS u32x2*)(ka + 16 * QK_PITCH + 64 * ks + 32);
              const u32x4 k0 = {a0.x, a0.y, a1.x, a1.y}, k1 = {c0.x, c0.y, c1.x, c1.y};
              s2[0] = __builtin_amdgcn_mfma_f32_16x16x32_bf16(__builtin_bit_cast(bf16x8, k0), qf, s2[0], 0, 0, 0); s2[1] = __builtin_amdgcn_mfma_f32_16x16x32_bf16(__builtin_bit_cast(bf16x8, k1), qf, s2[1], 0, 0, 0); }
          const int t = 16 * tt + ql; const float bft = gl[t], bbt = gl[64 + t];
#pragma unroll
          for (int i = 0; i < 2; ++i) { float af[4], ab[4];
#pragma unroll
              for (int rg = 0; rg < 4; ++rg) { const int s = 32 * sh + 16 * i + 4 * g + rg; const float v = s2[i][rg];
                  af[rg] = (s <= t) ? v * __expf(bft - gl[s] + gl[128 + s]) : 0.f; ab[rg] = (s >= t) ? v * __expf(bbt - gl[64 + s] + gl[192 + s]) : 0.f; }
              u32x2 wf, wb; wf.x = cvtpk(af[0], af[1]); wf.y = cvtpk(af[2], af[3]); wb.x = cvtpk(ab[0], ab[1]); wb.y = cvtpk(ab[2], ab[3]);
              *(LAS u32x2*)(atL + t * AP + (32 * sh + 16 * i + 4 * g) * 2) = wf; *(LAS u32x2*)(atL + 64 * AP + t * AP + (32 * sh + 16 * i + 4 * g) * 2) = wb; } }
#pragma unroll
        for (int it = 0; it < 8; ++it) { const int ci = X.wave * 32 + it * 4 + g, eb = ci >> 3, oc = ci & 7;
            const LAS unsigned char* kp = kL + (8 * oc + (ql >> 2)) * QK_PITCH + (16 * eb + 4 * (ql & 3)) * 2;
            const s16x4 t0 = lds_tr16(kp), t1 = lds_tr16(kp + 4 * QK_PITCH); const int e = 16 * eb + ql;
            const bf16x8 kv = (bf16x8){t0[0], t0[1], t0[2], t0[3], t1[0], t1[1], t1[2], t1[3]};
            *(bf16x8*)(KG + (size_t)(R0 + 2 * eb + (oc >> 2)) * MLI + h * 512 + (16 * (oc & 3) + ql) * 8) = kv; }
        __syncthreads();
        { const int bc = X.tid & 127, sg = X.tid >> 7, nb = h * 128 + bc; const float* pv = a.in(I_MLWV) + nb * 16; float wvr[16];
#pragma unroll
          for (int i = 0; i < 16; ++i) wvr[i] = pv[i];
#pragma unroll
          for (int i = 0; i < 4; ++i) { const int s0 = 16 * i + 4 * sg; float vv[4][4];
#pragma unroll
              for (int r = 0; r < 4; ++r) { const u32x2 w = *(const u32x2*)(XM + (size_t)(R0 + s0 + r) * MLI + 4 * nb); const float x0 = bf_lo(w.x), x1 = bf_hi(w.x), x2 = bf_lo(w.y), x3 = bf_hi(w.y);
#pragma unroll
                  for (int dd = 0; dd < 4; ++dd) vv[r][dd] = x0 * wvr[dd] + x1 * wvr[4 + dd] + x2 * wvr[8 + dd] + x3 * wvr[12 + dd]; }
#pragma unroll
              for (int dd = 0; dd < 4; ++dd) { u32x2 o; o.x = cvtpk(vv[0][dd], vv[1][dd]); o.y = cvtpk(vv[2][dd], vv[3][dd]); *(LAS u32x2*)(vtL + (4 * bc + dd) * AP + s0 * 2) = o; } }
          if (X.tid < 128) { const int dir = X.tid >> 6, t = X.tid & 63; float s = 0.f;
#pragma unroll
              for (int c = 0; c < 8; ++c) { const u32x4 w = *(const LAS u32x4*)(atL + dir * 64 * AP + t * AP + 16 * c); s += (bf_lo(w.x) + bf_hi(w.x)) + (bf_lo(w.y) + bf_hi(w.y)) + (bf_lo(w.z) + bf_hi(w.z)) + (bf_lo(w.w) + bf_hi(w.w)); }
              DEN[((size_t)(R0 + t) * 2 + dir) * 4 + h] = s; } }
        __syncthreads();
        { bf16x8 vf[4][2];
#pragma unroll
          for (int dt = 0; dt < 4; ++dt)
#pragma unroll
              for (int ks = 0; ks < 2; ++ks) vf[dt][ks] = *(const LAS bf16x8*)(vtL + (64 * X.wave + 16 * dt + ql) * AP + 64 * ks + 16 * g);
#pragma unroll
          for (int dir = 0; dir < 2; ++dir) { bf16_t* HO = (bf16_t*)(ws + (dir ? WS_HB : WS_HF));
#pragma unroll
              for (int tt = 0; tt < 4; ++tt) { f32x4 acc[4];
#pragma unroll
                  for (int dt = 0; dt < 4; ++dt) acc[dt] = (f32x4){0.f, 0.f, 0.f, 0.f};
#pragma unroll
                  for (int ks = 0; ks < 2; ++ks) { const bf16x8 af = *(const LAS bf16x8*)(atL + dir * 64 * AP + (16 * tt + ql) * AP + 64 * ks + 16 * g);
#pragma unroll
                      for (int dt = 0; dt < 4; ++dt) acc[dt] = __builtin_amdgcn_mfma_f32_16x16x32_bf16(vf[dt][ks], af, acc[dt], 0, 0, 0); }
                  bf16_t* op = HO + (size_t)(R0 + 16 * tt + ql) * MLI + h * 512 + 64 * X.wave + 4 * g;
#pragma unroll
                  for (int dt = 0; dt < 4; ++dt) { u32x2 w; w.x = cvtpk(acc[dt][0], acc[dt][1]); w.y = cvtpk(acc[dt][2], acc[dt][3]); *(u32x2*)(op + 16 * dt) = w; } } } }
    }
}

#define SC2_BAR() asm volatile("s_waitcnt lgkmcnt(0)\n\ts_barrier" ::: "memory")
__device__ __forceinline__ void scanB2_phase(const Ctx& X0, const PArgs& a, bool dry = false, int variant = 0) {
    const Ctx X = fresh_ctx(X0);
    unsigned char* ws = a.ws;
    const bf16_t* XM = (const bf16_t*)(ws + WS_XM); const bf16_t* QG = (const bf16_t*)(ws + WS_QG); const bf16_t* KG = (const bf16_t*)(ws + WS_KG); const float* GW = (const float*)(ws + WS_GW); const float* DEN = (const float*)(ws + WS_DEN);
    constexpr int AP = 144;
    LAS unsigned char* qL = X.lds; LAS unsigned char* ktL = X.lds + 64 * QK_PITCH; LAS unsigned char* vL = ktL + 65536;
    LAS bf16_t* xL = (LAS bf16_t*)(vL + 64 * AP);
    LAS float* sm = (LAS float*)(vL + 64 * AP + 8192);
    LAS float* wL = sm; LAS float* wgL = sm + 128; LAS float* denL = sm + 256; LAS float* qnL = sm + 384; LAS float* nL = sm + 512; LAS float* wvL = sm + 1024;
    const int db = X.wave & 3, eh = X.wave >> 2;
    for (int item = X.bid; item < 256; item += X.G) {
        int chain = item >> 3, sl = item & 7;
        if (X.G == 256) { const int k = item >> 3, x = item & 7; chain = (x >> 1) * 8 + (k >> 3) * 2 + (x & 1); sl = k & 7; }
        const int b = chain >> 3, h = (chain >> 1) & 3, dir = chain & 1;
        bf16_t* HO = (bf16_t*)(ws + (dir ? WS_HB : WS_HF));
        f32x4 ct[16];
#pragma unroll
        for (int j = 0; j < 16; ++j) ct[j] = (f32x4){0.f, 0.f, 0.f, 0.f};
        f32x4 nacc[4];
#pragma unroll
        for (int j = 0; j < 4; ++j) nacc[j] = (f32x4){0.f, 0.f, 0.f, 0.f};
        __syncthreads();
        if (X.tid < 256) wvL[X.tid] = a.in(I_MLWV)[(h * 128 + sl * 16) * 16 + X.tid];
#define SC2_R0(ch_) tb_row0(b, dir ? ((ch_) < 4 ? 3 - (ch_) : 135 - (ch_)) : (ch_))
#define SC2_DMA_Q(ch_) do { const int r0_ = SC2_R0(ch_); _Pragma("unroll") for (int i_ = 0; i_ < 8; ++i_) { const int tl_ = X.wave * 8 + i_; \
            __builtin_amdgcn_global_load_lds((const unsigned*)(QG + (size_t)(r0_ + tl_) * MLI + h * 512 + X.lane * 8), (LAS unsigned*)(qL + tl_ * QK_PITCH), 16, 0, 0); } } while (0)
#define SC2_DMA_K(ch_) do { const int r0_ = SC2_R0(ch_); const int rr_ = X.lane >> 3, pp_ = X.lane & 7; _Pragma("unroll") for (int i_ = 0; i_ < 8; ++i_) { const int sg_ = X.wave * 8 + i_; \
            __builtin_amdgcn_global_load_lds((const unsigned*)(KG + (size_t)(r0_ + sg_) * MLI + h * 512 + rr_ * 64 + (pp_ ^ ((4 * (sg_ & 1) + (rr_ >> 1)) & 7)) * 8), (LAS unsigned*)(ktL + sg_ * 1024), 16, 0, 0); } } while (0)
        u32x2 pxm[2]; float pw = 0.f, pwg = 0.f, pden = 0.f;
#define SC2_REGS(ch_) do { const int r0_ = SC2_R0(ch_); const int vb_ = X.tid & 15, vr_ = X.tid >> 4; \
            _Pragma("unroll") for (int i_ = 0; i_ < 2; ++i_) pxm[i_] = *(const u32x2*)(XM + (size_t)(r0_ + 2 * vr_ + i_) * MLI + h * 512 + sl * 64 + 4 * vb_); \
            if (X.tid < 64) { const int row_ = r0_ + X.tid; const float* gw_ = GW + (((size_t)row_ * 2 + dir) * 4 + h) * 2; pw = gw_[0]; pwg = gw_[1]; pden = DEN[((size_t)row_ * 2 + dir) * 4 + h]; } } while (0)
        SC2_REGS(0); SC2_DMA_Q(0); SC2_DMA_K(0);
        for (int ch = 0; ch < (CTXL + SEQ) / 64; ++ch) {
            const int buf = ch & 1, r0 = SC2_R0(ch);
            { const int t1 = launder_i(X.tid); const int vb = t1 & 15, vr = t1 >> 4;
              if ((t1 & 15) == 0) { const int g1 = (t1 >> 4) & 3;
#pragma unroll
                  for (int jj = 0; jj < 4; ++jj) { const int tile = 4 * db + jj; *(LAS f32x4*)(nL + eh * 256 + 32 * (tile >> 1) + 8 * g1 + 4 * (tile & 1)) = nacc[jj]; } }
              float vv[2][4]; f32x4 wv4[4];
#pragma unroll
              for (int i = 0; i < 4; ++i) wv4[i] = *(const LAS f32x4*)(wvL + vb * 16 + 4 * i);
#pragma unroll
              for (int i = 0; i < 2; ++i) { const u32x2 w = pxm[i]; const float x0 = bf_lo(w.x), x1 = bf_hi(w.x), x2 = bf_lo(w.y), x3 = bf_hi(w.y);
#pragma unroll
                  for (int dd = 0; dd < 4; ++dd) vv[i][dd] = x0 * wv4[0][dd] + x1 * wv4[1][dd] + x2 * wv4[2][dd] + x3 * wv4[3][dd]; }
#pragma unroll
              for (int dd = 0; dd < 4; ++dd) *(LAS unsigned*)(vL + (4 * vb + dd) * AP + (2 * vr) * 2) = cvtpk(vv[0][dd], vv[1][dd]);
              if (t1 < 64) { wL[buf * 64 + t1] = pw; wgL[buf * 64 + t1] = pwg; denL[buf * 64 + t1] = pden; } }
            asm volatile("s_waitcnt vmcnt(8)" ::: "memory");
            SC2_BAR();
            const int l2 = launder_i(X.lane); const int ql = l2 & 15, g = l2 >> 4;
            f32x4 acc[4]; f32x4 qacc = (f32x4){0.f, 0.f, 0.f, 0.f};
#pragma unroll
            for (int tt = 0; tt < 4; ++tt) acc[tt] = (f32x4){0.f, 0.f, 0.f, 0.f};
            if (variant != 1) {
                const LAS unsigned char* qb = qL + ql * QK_PITCH + (eh * 256) * 2 + 16 * g; const LAS float* nb = nL + eh * 256 + 8 * g;
                bf16x8 qn_[5]; f32x4 nn0, nn1;
#define SC2_QLOAD(kq_) do { const int kp_ = (variant == 3) ? 0 : (kq_); _Pragma("unroll") for (int tt_ = 0; tt_ < 4; ++tt_) qn_[tt_] = *(const LAS bf16x8*)(qb + (variant == 3 ? 0 : tt_) * 16 * QK_PITCH + 64 * (kp_)); \
                    qn_[4] = *(const LAS bf16x8*)(qb + db * 16 * QK_PITCH + 64 * (kp_)); nn0 = *(const LAS f32x4*)(nb + 32 * (kp_)); nn1 = *(const LAS f32x4*)(nb + 32 * (kp_) + 4); } while (0)
                SC2_QLOAD(0);
#pragma unroll
                for (int kp = 0; kp < 8; ++kp) {
                    bf16x8 qa[5];
#pragma unroll
                    for (int i = 0; i < 5; ++i) qa[i] = qn_[i];
                    const f32x4 n0 = nn0, n1 = nn1;
                    if (kp + 1 < 8) SC2_QLOAD(kp + 1);
                    u32x4 cw; cw.x = cvtpk(ct[2 * kp][0], ct[2 * kp][1]); cw.y = cvtpk(ct[2 * kp][2], ct[2 * kp][3]); cw.z = cvtpk(ct[2 * kp + 1][0], ct[2 * kp + 1][1]); cw.w = cvtpk(ct[2 * kp + 1][2], ct[2 * kp + 1][3]);
                    const bf16x8 cf = __builtin_bit_cast(bf16x8, cw);
                    u32x4 nw; nw.x = cvtpk(n0[0], n0[1]); nw.y = cvtpk(n0[2], n0[3]); nw.z = cvtpk(n1[0], n1[1]); nw.w = cvtpk(n1[2], n1[3]);
                    if (ql != 0) nw = (u32x4){0u, 0u, 0u, 0u};
#pragma unroll
                    for (int tt = 0; tt < 4; ++tt) acc[tt] = __builtin_amdgcn_mfma_f32_16x16x32_bf16(cf, qa[tt], acc[tt], 0, 0, 0);
                    qacc = __builtin_amdgcn_mfma_f32_16x16x32_bf16(qa[4], __builtin_bit_cast(bf16x8, nw), qacc, 0, 0, 0); }
#undef SC2_QLOAD
            }
            if (eh == 1) {
#pragma unroll
                for (int tt = 0; tt < 4; ++tt) { u32x2 w; w.x = cvtpk(acc[tt][0], acc[tt][1]); w.y = cvtpk(acc[tt][2], acc[tt][3]); *(LAS u32x2*)(xL + (db * 64 + 16 * tt + ql) * 16 + 4 * g) = w; }
            }
            if (ql == 0) *(LAS f32x4*)(qnL + eh * 64 + 16 * db + 4 * g) = qacc;
            asm volatile("s_waitcnt vmcnt(0)" ::: "memory");
            SC2_BAR();
            u32x2 ni[4];
#pragma unroll
            for (int tt = 0; tt < 4; ++tt) ni[tt] = *(const u32x2*)(HO + (size_t)(r0 + 16 * tt + ql) * MLI + h * 512 + sl * 64 + 16 * db + 4 * g);
            if (ch + 1 < (CTXL + SEQ) / 64) { SC2_REGS(ch + 1); SC2_DMA_Q(ch + 1); }
            const float decay = wL[buf * 64 + (dir ? 0 : 63)];
#pragma unroll
            for (int j = 0; j < 16; ++j) ct[j] = ct[j] * decay;
#pragma unroll
            for (int j = 0; j < 4; ++j) nacc[j] = nacc[j] * decay;
            if (variant != 2)
#pragma unroll
            for (int ks = 0; ks < 2; ++ks) {
                const u32x4 vraw = *(const LAS u32x4*)(vL + (16 * db + ql) * AP + 64 * ks + 16 * g);
                const f32x4 w0 = *(const LAS f32x4*)(wgL + buf * 64 + 32 * ks + 8 * g), w1 = *(const LAS f32x4*)(wgL + buf * 64 + 32 * ks + 8 * g + 4);
                u32x4 vw; vw.x = cvtpk(bf_lo(vraw.x) * w0[0], bf_hi(vraw.x) * w0[1]); vw.y = cvtpk(bf_lo(vraw.y) * w0[2], bf_hi(vraw.y) * w0[3]);
                vw.z = cvtpk(bf_lo(vraw.z) * w1[0], bf_hi(vraw.z) * w1[1]); vw.w = cvtpk(bf_lo(vraw.w) * w1[2], bf_hi(vraw.w) * w1[3]);
                const bf16x8 vf = __builtin_bit_cast(bf16x8, vw);
                u32x4 gwv; gwv.x = cvtpk(w0[0], w0[1]); gwv.y = cvtpk(w0[2], w0[3]); gwv.z = cvtpk(w1[0], w1[1]); gwv.w = cvtpk(w1[2], w1[3]);
                if (ql != 0) gwv = (u32x4){0u, 0u, 0u, 0u};
                const bf16x8 gwf = __builtin_bit_cast(bf16x8, gwv);
                const LAS unsigned char* kb = ktL + (eh * 256 + ql) * 128 + (((4 * ks + g) ^ ((ql >> 1) & 7)) << 4);
                bf16x8 kn_[4];
#pragma unroll
                for (int jj = 0; jj < 4; ++jj) kn_[jj] = *(const LAS bf16x8*)(kb + 16 * (variant == 4 ? 0 : jj) * 128);
#pragma unroll
                for (int j4 = 0; j4 < 4; ++j4) { bf16x8 kf[4];
#pragma unroll
                    for (int jj = 0; jj < 4; ++jj) kf[jj] = kn_[jj];
                    if (j4 + 1 < 4) {
#pragma unroll
                        for (int jj = 0; jj < 4; ++jj) kn_[jj] = *(const LAS bf16x8*)(kb + 16 * (variant == 4 ? 0 : 4 * (j4 + 1) + jj) * 128); }
#pragma unroll
                    for (int jj = 0; jj < 4; ++jj) ct[4 * j4 + jj] = __builtin_amdgcn_mfma_f32_16x16x32_bf16(kf[jj], vf, ct[4 * j4 + jj], 0, 0, 0);
                    if (j4 == db) {
#pragma unroll
                        for (int jj = 0; jj < 4; ++jj) nacc[jj] = __builtin_amdgcn_mfma_f32_16x16x32_bf16(kf[jj], gwf, nacc[jj], 0, 0, 0); } } }
            SC2_BAR();
            if (ch + 1 < (CTXL + SEQ) / 64) SC2_DMA_K(ch + 1);
            if (eh == 0) {
#pragma unroll
                for (int tt = 0; tt < 4; ++tt) { const int t = 16 * tt + ql; const float w = wL[buf * 64 + t]; const float den = denL[buf * 64 + t] + w * (qnL[t] + qnL[64 + t]);
                    const float sc = 1.0f / (fabsf(den) > 1.0f ? fabsf(den) : 1.0f); const u32x2 xw = *(const LAS u32x2*)(xL + (db * 64 + t) * 16 + 4 * g);
                    const float o0 = (bf_lo(ni[tt].x) + w * (acc[tt][0] + bf_lo(xw.x))) * sc, o1 = (bf_hi(ni[tt].x) + w * (acc[tt][1] + bf_hi(xw.x))) * sc;
                    const float o2 = (bf_lo(ni[tt].y) + w * (acc[tt][2] + bf_lo(xw.y))) * sc, o3 = (bf_hi(ni[tt].y) + w * (acc[tt][3] + bf_hi(xw.y))) * sc;
                    u32x2 ow; ow.x = cvtpk(o0, o1); ow.y = cvtpk(o2, o3); if (!dry) *(u32x2*)(HO + (size_t)(r0 + t) * MLI + h * 512 + sl * 64 + 16 * db + 4 * g) = ow; }
            }
        }
        asm volatile("s_waitcnt vmcnt(0)" ::: "memory");
#undef SC2_R0
#undef SC2_DMA_Q
#undef SC2_DMA_K
#undef SC2_REGS
    }
}

template <int B0, int B1>
__device__ __forceinline__ void attn_tile3p(const LAS unsigned char* kt0, const LAS unsigned char* vt0, const LAS float* blr0, const bf16x8 (&qf)[2], float& m, float& lsum, f32x4 (&o)[4], const int (&kq)[2], const int (&vq)[4], int g, int qc, int c0) {
    constexpr int TILEB = 16384;
    f32x4 s[2][2];
#pragma unroll
    for (int ts = 0; ts < 2; ++ts)
#pragma unroll
        for (int i = 0; i < 2; ++i) { const int cb = i ? B1 : B0; s[ts][i] = (f32x4){0.f, 0.f, 0.f, 0.f};
#pragma unroll
            for (int ss = 0; ss < 2; ++ss) { const bf16x8 kf = *(const LAS bf16x8*)(kt0 + ts * TILEB + cb * 4096 + kq[ss]);
                s[ts][i] = __builtin_amdgcn_mfma_f32_16x16x32_bf16(kf, qf[ss], s[ts][i], 0, 0, 0); } }
    float mx = -1.0e30f;
#pragma unroll
    for (int ts = 0; ts < 2; ++ts)
#pragma unroll
        for (int i = 0; i < 2; ++i)
#pragma unroll
            for (int rg = 0; rg < 4; ++rg) { float v = s[ts][i][rg] * 0.18033688011112042f;
                const int kc = 16 * (i ? B1 : B0) + 4 * g + rg; int dc = kc - qc; dc = dc < -15 ? -15 : (dc > 15 ? 15 : dc);
                v += blr0[ts * 32 + dc + 15]; v = (kc >= c0 && kc < c0 + 16) ? v : -1.0e30f;
                s[ts][i][rg] = v; mx = fmaxf(mx, v); }
    mx = fmaxf(mx, __shfl_xor(mx, 16)); mx = fmaxf(mx, __shfl_xor(mx, 32));
    const float mn = fmaxf(m, mx), alpha = __builtin_amdgcn_exp2f(m - mn); m = mn;
    float ps = 0.f;
#pragma unroll
    for (int ts = 0; ts < 2; ++ts)
#pragma unroll
        for (int i = 0; i < 2; ++i)
#pragma unroll
            for (int rg = 0; rg < 4; ++rg) { const float p = __builtin_amdgcn_exp2f(s[ts][i][rg] - mn); s[ts][i][rg] = p; ps += p; }
    lsum = lsum * alpha + ps;
#pragma unroll
    for (int db = 0; db < 4; ++db) o[db] = o[db] * alpha;
#pragma unroll
    for (int ts = 0; ts < 2; ++ts) {
        const f32x4 s0 = s[ts][0], s1 = s[ts][1];
        u32x4 pw; pw.x = cvtpk(s0[0], s0[1]); pw.y = cvtpk(s0[2], s0[3]); pw.z = cvtpk(s1[0], s1[1]); pw.w = cvtpk(s1[2], s1[3]);
        const bf16x8 pf = __builtin_bit_cast(bf16x8, pw);
#pragma unroll
        for (int db = 0; db < 4; ++db) {
            const LAS unsigned char* vp = vt0 + ts * TILEB + vq[db];
            const s16x4 t0 = lds_tr16(vp + B0 * 4096), t1 = lds_tr16(vp + B1 * 4096);
            const bf16x8 vf = (bf16x8){t0[0], t0[1], t0[2], t0[3], t1[0], t1[1], t1[2], t1[3]};
            o[db] = __builtin_amdgcn_mfma_f32_16x16x32_bf16(vf, pf, o[db], 0, 0, 0); } }
}
__device__ __forceinline__ void attn_tile3c(const LAS unsigned char* kt0, const LAS unsigned char* vt0, const bf16x8 (&qf)[2], float& m, float& lsum, f32x4 (&o)[4], const int (&kq)[2], const int (&vq)[4]) {
    constexpr int TILEB = 16384;
    f32x4 s[2][4];
#pragma unroll
    for (int ts = 0; ts < 2; ++ts)
#pragma unroll
        for (int cb = 0; cb < 4; ++cb) { s[ts][cb] = (f32x4){0.f, 0.f, 0.f, 0.f};
#pragma unroll
            for (int ss = 0; ss < 2; ++ss) { const bf16x8 kf = *(const LAS bf16x8*)(kt0 + ts * TILEB + cb * 4096 + kq[ss]);
                s[ts][cb] = __builtin_amdgcn_mfma_f32_16x16x32_bf16(kf, qf[ss], s[ts][cb], 0, 0, 0); } }
    float mx = -1.0e30f;
#pragma unroll
    for (int ts = 0; ts < 2; ++ts)
#pragma unroll
        for (int cb = 0; cb < 4; ++cb)
#pragma unroll
            for (int rg = 0; rg < 4; ++rg) { const float v = s[ts][cb][rg] * 0.18033688011112042f; s[ts][cb][rg] = v; mx = fmaxf(mx, v); }
    mx = fmaxf(mx, __shfl_xor(mx, 16)); mx = fmaxf(mx, __shfl_xor(mx, 32));
    const float mn = fmaxf(m, mx), alpha = __builtin_amdgcn_exp2f(m - mn); m = mn;
    float ps = 0.f;
#pragma unroll
    for (int ts = 0; ts < 2; ++ts)
#pragma unroll
        for (int cb = 0; cb < 4; ++cb)
#pragma unroll
            for (int rg = 0; rg < 4; ++rg) { const float p = __builtin_amdgcn_exp2f(s[ts][cb][rg] - mn); s[ts][cb][rg] = p; ps += p; }
    lsum = lsum * alpha + ps;
#pragma unroll
    for (int db = 0; db < 4; ++db) o[db] = o[db] * alpha;
#pragma unroll
    for (int ts = 0; ts < 2; ++ts)
#pragma unroll
        for (int pr = 0; pr < 2; ++pr) {
            const f32x4 s0 = s[ts][2 * pr], s1 = s[ts][2 * pr + 1];
            u32x4 pw; pw.x = cvtpk(s0[0], s0[1]); pw.y = cvtpk(s0[2], s0[3]); pw.z = cvtpk(s1[0], s1[1]); pw.w = cvtpk(s1[2], s1[3]);
            const bf16x8 pf = __builtin_bit_cast(bf16x8, pw);
#pragma unroll
            for (int db = 0; db < 4; ++db) {
                const LAS unsigned char* vp = vt0 + ts * TILEB + (2 * pr) * 4096 + vq[db];
                const s16x4 t0 = lds_tr16(vp), t1 = lds_tr16(vp + 4096);
                const bf16x8 vf = (bf16x8){t0[0], t0[1], t0[2], t0[3], t1[0], t1[1], t1[2], t1[3]};
                o[db] = __builtin_amdgcn_mfma_f32_16x16x32_bf16(vf, pf, o[db], 0, 0, 0); } }
}
#pragma clang diagnostic push
#pragma clang diagnostic ignored "-Winline-asm"
__device__ __forceinline__ void attn3_phase(const Ctx& X0, const PArgs& a, int j_na, bool with_ctx) {
    const Ctx X = fresh_ctx(X0);
    unsigned char* ws = a.ws;
    const bf16_t* Q = (const bf16_t*)(ws + WS_Q); const bf16_t* K = (const bf16_t*)(ws + WS_K); const bf16_t* V = (const bf16_t*)(ws + WS_V); bf16_t* O = (bf16_t*)(ws + WS_O);
    const float* rpb = a.in(I_NARPB) + (size_t)j_na * NAH * 15 * 31;
    constexpr int TILEB = 16384;
    LAS unsigned char* Kb = X.lds; LAS unsigned char* Vb = X.lds + 4 * TILEB; LAS float* bl = (LAS float*)(X.lds + 8 * TILEB);
    const int hsel = X.wave >> 2, jb = X.wave & 3, ql = X.lane & 15, g = X.lane >> 4;
    const int nlat = NB * GROWS * 8, nunits = nlat + (with_ctx ? NB * 8 * 4 : 0);
    const int qc = jb == 0 ? (ql < 8 ? ql : 48 + ql) : 16 * jb - 8 + ql, c0 = qc - 8 < 0 ? 0 : (qc - 8 > 48 ? 48 : qc - 8);
    int kq[2], vq[4];
#pragma unroll
    for (int ss = 0; ss < 2; ++ss) kq[ss] = ql * 256 + (((8 * hsel + 4 * ss + g) ^ ql) << 4);
    { const int xv = 4 * g + (ql >> 2);
#pragma unroll
      for (int db = 0; db < 4; ++db) vq[db] = xv * 256 + (((8 * hsel + 2 * db + ((ql >> 1) & 1)) ^ xv) << 4) + 8 * (ql & 1); }
    const int dkv = X.wave >> 2, dts = (X.wave >> 1) & 1, dgrp0 = 8 * (X.wave & 1), drin = X.lane >> 4, dpp = X.lane & 15;
    const int nper = (X.G % 8 == 0 && nlat % 8 == 0) ? nlat / 8 : 0, wpx = X.G / 8;
    for (int k = 0; ; ++k) {
        int u;
        if (nper) { const int iu = (X.bid >> 3) + wpx * k; u = iu < nper ? (X.bid & 7) * nper + iu : nlat + (iu - nper) * 8 + (X.bid & 7); }
        else u = X.bid + X.G * k;
        if (u >= nunits) break;
        const bool lat = u < nlat; int b, h0, r = 0, r0 = 0, qrow0, nst;
        if (lat) { b = u / (GROWS * 8); const int rem = u % (GROWS * 8); h0 = (rem >> 7) * 2; r = rem & 127; r0 = r - 4; r0 = r0 < 0 ? 0 : (r0 > GROWS - 8 ? GROWS - 8 : r0); qrow0 = b * SEQ + r * GRIDW; nst = 6; }
        else { const int v = u - nlat; b = v >> 5; h0 = ((v >> 2) & 7) * 2; qrow0 = NLAT + b * CTXL + (v & 3) * 64; nst = 2; }
        const int h = h0 + hsel;
        bf16x8 qf[2];
        { const bf16_t* qp = Q + (size_t)(qrow0 + qc) * D + h * 64 + 8 * g; qf[0] = *(const bf16x8*)qp; qf[1] = *(const bf16x8*)(qp + 32); }
        __syncthreads();
        if (lat) { const int idx = X.tid; const int hh = idx >> 8, i = (idx >> 5) & 7, dc = idx & 31; bl[idx] = dc < 31 ? rpb[((h0 + hh) * 15 + (r0 + i - r + 7)) * 31 + dc] * 1.4426950408889634f : 0.f; }
        float m = -1.0e30f, lsum = 0.f; f32x4 o[4];
#pragma unroll
        for (int i = 0; i < 4; ++i) o[i] = (f32x4){0.f, 0.f, 0.f, 0.f};
#define AT_KROW(tl_) ((lat && (tl_) < 8) ? b * SEQ + (r0 + (tl_)) * GRIDW : NLAT + b * CTXL + (lat ? (tl_) - 8 : (tl_)) * 64)
#define AT_DMA(st_) do { const bf16_t* sb_ = (dkv ? V : K) + (size_t)(AT_KROW(2 * (st_) + dts) + drin) * D + h0 * 64; LAS unsigned char* db_ = (dkv ? Vb : Kb) + (((st_) & 1) * 2 + dts) * TILEB; \
            _Pragma("unroll") for (int i_ = 0; i_ < 8; ++i_) { const int grp_ = dgrp0 + i_; const bf16_t* gp_ = sb_ + (size_t)(4 * grp_) * D + ((dpp ^ ((4 * (grp_ & 3) + drin) & 15)) << 3); \
                const unsigned la_ = __builtin_amdgcn_readfirstlane((unsigned)(size_t)(db_ + grp_ * 1024)); \
                asm volatile("s_mov_b32 m0, %1\n\ts_nop 0\n\tglobal_load_lds_dwordx4 %0, off" :: "v"(gp_), "s"(la_) : "memory", "m0"); } } while (0)
        AT_DMA(0);
        for (int st = 0; st < nst; ++st) {
            const int buf = st & 1;
            asm volatile("s_waitcnt vmcnt(0)" ::: "memory");
            __syncthreads();
            if (st + 1 < nst) AT_DMA(st + 1);
            const bool local = lat && st < 4;
            const LAS unsigned char* kt0 = Kb + (buf * 2) * TILEB; const LAS unsigned char* vt0 = Vb + (buf * 2) * TILEB; const LAS float* blr0 = bl + hsel * 256 + (2 * st) * 32;
            if (!local) attn_tile3c(kt0, vt0, qf, m, lsum, o, kq, vq);
            else if (jb == 0) attn_tile3p<0, 3>(kt0, vt0, blr0, qf, m, lsum, o, kq, vq, g, qc, c0);
            else if (jb == 1) attn_tile3p<0, 1>(kt0, vt0, blr0, qf, m, lsum, o, kq, vq, g, qc, c0);
            else if (jb == 2) attn_tile3p<1, 2>(kt0, vt0, blr0, qf, m, lsum, o, kq, vq, g, qc, c0);
            else attn_tile3p<2, 3>(kt0, vt0, blr0, qf, m, lsum, o, kq, vq, g, qc, c0);
        }
#undef AT_KROW
#undef AT_DMA
        lsum += __shfl_xor(lsum, 16); lsum += __shfl_xor(lsum, 32);
        const float inv = 1.0f / lsum;
        bf16_t* op = O + (size_t)(qrow0 + qc) * D + h * 64 + 4 * g;
#pragma unroll
        for (int db = 0; db < 4; ++db) { u32x2 w; w.x = cvtpk(o[db][0] * inv, o[db][1] * inv); w.y = cvtpk(o[db][2] * inv, o[db][3] * inv); *(u32x2*)(op + 16 * db) = w; }
    }
}
#pragma clang diagnostic pop
#pragma clang diagnostic push
#pragma clang diagnostic ignored "-Winline-asm"
__device__ __forceinline__ void scanB3_phase(const Ctx& X0, const PArgs& a, bool dry = false) {
    const Ctx X = fresh_ctx(X0);
    unsigned char* ws = a.ws;
    const bf16_t* XM = (const bf16_t*)(ws + WS_XM); const bf16_t* QG = (const bf16_t*)(ws + WS_QG); const bf16_t* KG = (const bf16_t*)(ws + WS_KG); const float* GW = (const float*)(ws + WS_GW); const float* DEN = (const float*)(ws + WS_DEN);
    constexpr int AP = 144;
    LAS unsigned char* qL = X.lds; LAS unsigned char* ktL = X.lds + 64 * QK_PITCH; LAS unsigned char* vL = ktL + 65536;
    LAS unsigned char* xbL = vL + 64 * AP;
    LAS float* sm = (LAS float*)(xbL + 16384);
    LAS float* wL = sm; LAS float* wgL = sm + 128; LAS float* denL = sm + 256; LAS float* qnL = sm + 384; LAS float* wvL = sm + 640;
    const int dh = X.wave >> 2, eq = X.wave & 3, e2 = eq & 1; const bool fin = (eq >> 1) == dh;
    for (int item = X.bid; item < 256; item += X.G) {
        int chain = item >> 3, sl = item & 7;
        if (X.G == 256) { const int k = item >> 3, x = item & 7; chain = (x >> 1) * 8 + (k >> 3) * 2 + (x & 1); sl = k & 7; }
        const int b = chain >> 3, h = (chain >> 1) & 3, dir = chain & 1;
        bf16_t* HO = (bf16_t*)(ws + (dir ? WS_HB : WS_HF));
        f32x4 ct[16];
#pragma unroll
        for (int j = 0; j < 16; ++j) ct[j] = (f32x4){0.f, 0.f, 0.f, 0.f};
        f32x4 nacc[8];
#pragma unroll
        for (int j = 0; j < 8; ++j) nacc[j] = (f32x4){0.f, 0.f, 0.f, 0.f};
        __syncthreads();
        if (X.tid < 256) wvL[X.tid] = a.in(I_MLWV)[(h * 128 + sl * 16) * 16 + X.tid];
#define SC2_R0(ch_) tb_row0(b, dir ? ((ch_) < 4 ? 3 - (ch_) : 135 - (ch_)) : (ch_))
#define SC3_DMA16(gp_, lp_) do { const unsigned la_ = __builtin_amdgcn_readfirstlane((unsigned)(size_t)(lp_)); asm volatile("s_mov_b32 m0, %1\n\ts_nop 0\n\tglobal_load_lds_dwordx4 %0, off" :: "v"(gp_), "s"(la_) : "memory", "m0"); } while (0)
#define SC2_DMA_Q(ch_) do { const int r0_ = SC2_R0(ch_); _Pragma("unroll") for (int i_ = 0; i_ < 8; ++i_) { const int tl_ = X.wave * 8 + i_; \
            SC3_DMA16(QG + (size_t)(r0_ + tl_) * MLI + h * 512 + X.lane * 8, qL + tl_ * QK_PITCH); } } while (0)
#define SC2_DMA_K(ch_) do { const int r0_ = SC2_R0(ch_); const int rr_ = X.lane >> 3, pp_ = X.lane & 7; _Pragma("unroll") for (int i_ = 0; i_ < 8; ++i_) { const int sg_ = X.wave * 8 + i_; \
            SC3_DMA16(KG + (size_t)(r0_ + sg_) * MLI + h * 512 + rr_ * 64 + (pp_ ^ ((4 * (sg_ & 1) + (rr_ >> 1)) & 7)) * 8, ktL + sg_ * 1024); } } while (0)
#define SC3_GLD2(dst_, ptr_) asm volatile("global_load_dwordx2 %0, %1, off" : "=v"(dst_) : "v"(ptr_) : "memory")
#define SC3_GLD1(dst_, ptr_) asm volatile("global_load_dword %0, %1, off" : "=v"(dst_) : "v"(ptr_) : "memory")
        u32x2 pxm[2] = {(u32x2){0u, 0u}, (u32x2){0u, 0u}}; float pg[2] = {0.f, 0.f}; float pw = 0.f, pwg = 0.f, pden = 0.f;
#define SC2_REGS(ch_) do { const int r0_ = SC2_R0(ch_); const int vb_ = X.tid & 15, vr_ = X.tid >> 4; \
            _Pragma("unroll") for (int i_ = 0; i_ < 2; ++i_) SC3_GLD2(pxm[i_], XM + (size_t)(r0_ + 2 * vr_ + i_) * MLI + h * 512 + sl * 64 + 4 * vb_); \
            _Pragma("unroll") for (int i_ = 0; i_ < 2; ++i_) SC3_GLD1(pg[i_], GW + (((size_t)(r0_ + 2 * vr_ + i_) * 2 + dir) * 4 + h) * 2 + 1); \
            if (X.wave == 0) { const int row_ = r0_ + X.tid; const float* gw_ = GW + (((size_t)row_ * 2 + dir) * 4 + h) * 2; SC3_GLD1(pw, gw_); SC3_GLD1(pwg, gw_ + 1); SC3_GLD1(pden, DEN + ((size_t)row_ * 2 + dir) * 4 + h); } } while (0)
        SC2_REGS(0); SC2_DMA_Q(0); SC2_DMA_K(0);
        for (int ch = 0; ch < (CTXL + SEQ) / 64; ++ch) {
            const int buf = ch & 1, r0 = SC2_R0(ch);
            asm volatile("s_waitcnt vmcnt(16)" : "+v"(pxm[0]), "+v"(pxm[1]), "+v"(pg[0]), "+v"(pg[1]), "+v"(pw), "+v"(pwg), "+v"(pden) :: "memory");
            { const int t1 = launder_i(X.tid); const int vb = t1 & 15, vr = t1 >> 4;
              float vv[2][4]; f32x4 wv4[4];
#pragma unroll
              for (int i = 0; i < 4; ++i) wv4[i] = *(const LAS f32x4*)(wvL + vb * 16 + 4 * i);
#pragma unroll
              for (int i = 0; i < 2; ++i) { const u32x2 w = pxm[i]; const float x0 = bf_lo(w.x), x1 = bf_hi(w.x), x2 = bf_lo(w.y), x3 = bf_hi(w.y);
#pragma unroll
                  for (int dd = 0; dd < 4; ++dd) vv[i][dd] = (x0 * wv4[0][dd] + x1 * wv4[1][dd] + x2 * wv4[2][dd] + x3 * wv4[3][dd]) * pg[i]; }
#pragma unroll
              for (int dd = 0; dd < 4; ++dd) *(LAS unsigned*)(vL + (4 * vb + dd) * AP + (2 * vr) * 2) = cvtpk(vv[0][dd], vv[1][dd]);
              if (t1 < 64) { wL[buf * 64 + t1] = pw; wgL[buf * 64 + t1] = pwg; denL[buf * 64 + t1] = pden; } }
            if (ch == 0 || !fin || dry) asm volatile("s_waitcnt vmcnt(8)" ::: "memory"); else asm volatile("s_waitcnt vmcnt(12)" ::: "memory");
            SC2_BAR();
            const int l2 = launder_i(X.lane); const int ql = l2 & 15, g = l2 >> 4;
            f32x4 acc[8]; f32x4 qacc[4];
#pragma unroll
            for (int i = 0; i < 8; ++i) acc[i] = (f32x4){0.f, 0.f, 0.f, 0.f};
#pragma unroll
            for (int i = 0; i < 4; ++i) qacc[i] = (f32x4){0.f, 0.f, 0.f, 0.f};
            { const LAS unsigned char* qb = qL + ql * QK_PITCH + eq * 256 + 16 * g;
              bf16x8 qn_[4];
#pragma unroll
              for (int tt = 0; tt < 4; ++tt) qn_[tt] = *(const LAS bf16x8*)(qb + tt * 16 * QK_PITCH);
#pragma unroll
              for (int kp = 0; kp < 4; ++kp) {
                  bf16x8 qa[4];
#pragma unroll
                  for (int tt = 0; tt < 4; ++tt) qa[tt] = qn_[tt];
                  if (kp + 1 < 4) {
#pragma unroll
                      for (int tt = 0; tt < 4; ++tt) qn_[tt] = *(const LAS bf16x8*)(qb + tt * 16 * QK_PITCH + 64 * (kp + 1)); }
                  u32x4 c0, c1;
                  c0.x = cvtpk(ct[2 * kp][0], ct[2 * kp][1]); c0.y = cvtpk(ct[2 * kp][2], ct[2 * kp][3]); c0.z = cvtpk(ct[2 * kp + 1][0], ct[2 * kp + 1][1]); c0.w = cvtpk(ct[2 * kp + 1][2], ct[2 * kp + 1][3]);
                  c1.x = cvtpk(ct[8 + 2 * kp][0], ct[8 + 2 * kp][1]); c1.y = cvtpk(ct[8 + 2 * kp][2], ct[8 + 2 * kp][3]); c1.z = cvtpk(ct[9 + 2 * kp][0], ct[9 + 2 * kp][1]); c1.w = cvtpk(ct[9 + 2 * kp][2], ct[9 + 2 * kp][3]);
                  const bf16x8 cf0 = __builtin_bit_cast(bf16x8, c0), cf1 = __builtin_bit_cast(bf16x8, c1);
#pragma unroll
                  for (int tt = 0; tt < 4; ++tt) { acc[tt] = __builtin_amdgcn_mfma_f32_16x16x32_bf16(cf0, qa[tt], acc[tt], 0, 0, 0); acc[4 + tt] = __builtin_amdgcn_mfma_f32_16x16x32_bf16(cf1, qa[tt], acc[4 + tt], 0, 0, 0); }
                  if (dh == 0) {
                      u32x4 nw; nw.x = cvtpk(nacc[2 * kp][0], nacc[2 * kp][1]); nw.y = cvtpk(nacc[2 * kp][2], nacc[2 * kp][3]); nw.z = cvtpk(nacc[2 * kp + 1][0], nacc[2 * kp + 1][1]); nw.w = cvtpk(nacc[2 * kp + 1][2], nacc[2 * kp + 1][3]);
                      const bf16x8 nf = __builtin_bit_cast(bf16x8, nw);
#pragma unroll
                      for (int tt = 0; tt < 4; ++tt) qacc[tt] = __builtin_amdgcn_mfma_f32_16x16x32_bf16(qa[tt], nf, qacc[tt], 0, 0, 0); } } }
            if (dh == 0 && ql == 0) {
#pragma unroll
                for (int tt = 0; tt < 4; ++tt) *(LAS f32x4*)(qnL + eq * 64 + 16 * tt + 4 * g) = qacc[tt]; }
            LAS unsigned char* xmy = xbL + ((dh * 2 + e2) * 8) * 512 + l2 * 8;
            if (!fin) {
#pragma unroll
                for (int i = 0; i < 8; ++i) { u32x2 w; w.x = cvtpk(acc[i][0], acc[i][1]); w.y = cvtpk(acc[i][2], acc[i][3]); *(LAS u32x2*)(xmy + i * 512) = w; } }
            asm volatile("s_waitcnt vmcnt(0)" ::: "memory");
            SC2_BAR();
            u32x2 ni[4];
#pragma unroll
            for (int i = 0; i < 4; ++i) ni[i] = (u32x2){0u, 0u};
            u32x2 xr[8];
#pragma unroll
            for (int i = 0; i < 8; ++i) xr[i] = (u32x2){0u, 0u};
            if (fin) {
#pragma unroll
                for (int i = 0; i < 8; ++i) xr[i] = *(const LAS u32x2*)(xmy + i * 512);
#pragma unroll
                for (int i = 0; i < 4; ++i) SC3_GLD2(ni[i], HO + (size_t)(r0 + 16 * (2 * e2 + (i & 1)) + ql) * MLI + h * 512 + sl * 64 + 32 * dh + 16 * (i >> 1) + 4 * g); }
            const int chn = ch + 1 < (CTXL + SEQ) / 64 ? ch + 1 : ch;
            SC2_REGS(chn); SC2_DMA_Q(chn);
            if (fin) {
#pragma unroll
                for (int i = 0; i < 8; ++i) { const u32x2 w = xr[i]; acc[i][0] += bf_lo(w.x); acc[i][1] += bf_hi(w.x); acc[i][2] += bf_lo(w.y); acc[i][3] += bf_hi(w.y); }
                if (e2 == 0) {
#pragma unroll
                    for (int i = 0; i < 4; ++i) { const int ti = 4 * (i >> 1) + 2 + (i & 1); u32x2 w; w.x = cvtpk(acc[ti][0], acc[ti][1]); w.y = cvtpk(acc[ti][2], acc[ti][3]); *(LAS u32x2*)(xmy + ti * 512) = w; }
                } else {
#pragma unroll
                    for (int i = 0; i < 4; ++i) { const int ti = 4 * (i >> 1) + (i & 1); u32x2 w; w.x = cvtpk(acc[ti][0], acc[ti][1]); w.y = cvtpk(acc[ti][2], acc[ti][3]); *(LAS u32x2*)(xmy + ti * 512) = w; } } }
            const float decay = wL[buf * 64 + (dir ? 0 : 63)];
#pragma unroll
            for (int j = 0; j < 16; ++j) ct[j] = ct[j] * decay;
            if (dh == 0) {
#pragma unroll
                for (int j = 0; j < 8; ++j) nacc[j] = nacc[j] * decay; }
#pragma unroll
            for (int ks = 0; ks < 2; ++ks) {
                bf16x8 vf[2];
#pragma unroll
                for (int dblk = 0; dblk < 2; ++dblk) vf[dblk] = *(const LAS bf16x8*)(vL + (32 * dh + 16 * dblk + ql) * AP + 64 * ks + 16 * g);
                bf16x8 gwf = vf[0];
                if (dh == 0) { const f32x4 w0 = *(const LAS f32x4*)(wgL + buf * 64 + 32 * ks + 8 * g), w1 = *(const LAS f32x4*)(wgL + buf * 64 + 32 * ks + 8 * g + 4);
                    u32x4 gwv; gwv.x = cvtpk(w0[0], w0[1]); gwv.y = cvtpk(w0[2], w0[3]); gwv.z = cvtpk(w1[0], w1[1]); gwv.w = cvtpk(w1[2], w1[3]);
                    if (ql != 0) gwv = (u32x4){0u, 0u, 0u, 0u};
                    gwf = __builtin_bit_cast(bf16x8, gwv); }
                const LAS unsigned char* kb = ktL + (eq * 128 + ql) * 128 + (((4 * ks + g) ^ ((ql >> 1) & 7)) << 4);
                bf16x8 kn_[4];
#pragma unroll
                for (int jj = 0; jj < 4; ++jj) kn_[jj] = *(const LAS bf16x8*)(kb + 16 * jj * 128);
#pragma unroll
                for (int j4 = 0; j4 < 2; ++j4) { bf16x8 kf[4];
#pragma unroll
                    for (int jj = 0; jj < 4; ++jj) kf[jj] = kn_[jj];
                    if (j4 + 1 < 2) {
#pragma unroll
                        for (int jj = 0; jj < 4; ++jj) kn_[jj] = *(const LAS bf16x8*)(kb + 16 * (4 * (j4 + 1) + jj) * 128); }
#pragma unroll
                    for (int jj = 0; jj < 4; ++jj) { ct[4 * j4 + jj] = __builtin_amdgcn_mfma_f32_16x16x32_bf16(kf[jj], vf[0], ct[4 * j4 + jj], 0, 0, 0); ct[8 + 4 * j4 + jj] = __builtin_amdgcn_mfma_f32_16x16x32_bf16(kf[jj], vf[1], ct[8 + 4 * j4 + jj], 0, 0, 0); }
                    if (dh == 0) {
#pragma unroll
                        for (int jj = 0; jj < 4; ++jj) nacc[4 * j4 + jj] = __builtin_amdgcn_mfma_f32_16x16x32_bf16(kf[jj], gwf, nacc[4 * j4 + jj], 0, 0, 0); } } }
            SC2_BAR();
            SC2_DMA_K(chn);
            if (fin) {
                asm volatile("s_waitcnt vmcnt(20)" : "+v"(ni[0]), "+v"(ni[1]), "+v"(ni[2]), "+v"(ni[3]) :: "memory");
                const LAS unsigned char* xot = xbL + ((dh * 2 + (e2 ^ 1)) * 8) * 512 + l2 * 8;
#define SC3_FIN(TT_, AI_, NI_) do { const int t = 16 * (TT_) + ql; const float w = wL[buf * 64 + t]; const float den = denL[buf * 64 + t] + w * ((qnL[t] + qnL[64 + t]) + (qnL[128 + t] + qnL[192 + t])); \
                    const float sc = 1.0f / (fabsf(den) > 1.0f ? fabsf(den) : 1.0f); const u32x2 xw = *(const LAS u32x2*)(xot + (AI_) * 512); \
                    const float o0 = (bf_lo(ni[NI_].x) + w * (acc[AI_][0] + bf_lo(xw.x))) * sc, o1 = (bf_hi(ni[NI_].x) + w * (acc[AI_][1] + bf_hi(xw.x))) * sc; \
                    const float o2 = (bf_lo(ni[NI_].y) + w * (acc[AI_][2] + bf_lo(xw.y))) * sc, o3 = (bf_hi(ni[NI_].y) + w * (acc[AI_][3] + bf_hi(xw.y))) * sc; \
                    u32x2 ow; ow.x = cvtpk(o0, o1); ow.y = cvtpk(o2, o3); if (!dry) *(u32x2*)(HO + (size_t)(r0 + t) * MLI + h * 512 + sl * 64 + 32 * dh + 16 * ((AI_) >> 2) + 4 * g) = ow; } while (0)
                if (e2 == 0) { SC3_FIN(0, 0, 0); SC3_FIN(1, 1, 1); SC3_FIN(0, 4, 2); SC3_FIN(1, 5, 3); }
                else         { SC3_FIN(2, 2, 0); SC3_FIN(3, 3, 1); SC3_FIN(2, 6, 2); SC3_FIN(3, 7, 3); }
#undef SC3_FIN
            }
        }
        asm volatile("s_waitcnt vmcnt(0)" ::: "memory");
#undef SC2_R0
#undef SC2_DMA_Q
#undef SC2_DMA_K
#undef SC2_REGS
#undef SC3_GLD1
#undef SC3_GLD2
#undef SC3_DMA16
    }
}

__device__ __forceinline__ void scanB4_phase(const Ctx& X0, const PArgs& a, bool dry = false, int variant = 0) {
    const Ctx X = fresh_ctx(X0);
    unsigned char* ws = a.ws;
    const bf16_t* XM = (const bf16_t*)(ws + WS_XM); const bf16_t* QG = (const bf16_t*)(ws + WS_QG); const bf16_t* KG = (const bf16_t*)(ws + WS_KG); const float* GW = (const float*)(ws + WS_GW); const float* DEN = (const float*)(ws + WS_DEN);
    constexpr int AP = 144, NCH = (CTXL + SEQ) / 64;
    LAS unsigned char* xbL = X.lds;
    LAS unsigned char* vL = X.lds + 131072;
    LAS float* sm = (LAS float*)(vL + 2 * 64 * AP);
    LAS float* wL = sm; LAS float* wgL = sm + 128; LAS float* denL = sm + 256; LAS float* qnL = sm + 384; LAS float* wvL = sm + 1408;
    const int w = X.wave;
    for (int item = X.bid; item < 256; item += X.G) {
        int chain = item >> 3, sl = item & 7;
        if (X.G == 256) { const int k = item >> 3, x = item & 7; chain = (x >> 1) * 8 + (k >> 3) * 2 + (x & 1); sl = k & 7; }
        const int b = chain >> 3, h = (chain >> 1) & 3, dir = chain & 1;
        bf16_t* HO = (bf16_t*)(ws + (dir ? WS_HB : WS_HF));
        f32x4 ct[16];
#pragma unroll
        for (int j = 0; j < 16; ++j) ct[j] = (f32x4){0.f, 0.f, 0.f, 0.f};
        f32x4 nacc[4];
#pragma unroll
        for (int j = 0; j < 4; ++j) nacc[j] = (f32x4){0.f, 0.f, 0.f, 0.f};
        __syncthreads();
        if (X.tid < 256) wvL[X.tid] = a.in(I_MLWV)[(h * 128 + sl * 16) * 16 + X.tid];
        __syncthreads();
#define SC4_R0(ch_) tb_row0(b, dir ? ((ch_) < 4 ? 3 - (ch_) : 135 - (ch_)) : (ch_))
#define SC4_GLD4(dst_, ptr_) asm volatile("global_load_dwordx4 %0, %1, off" : "=v"(dst_) : "v"(ptr_) : "memory")
#define SC4_GLD4O(dst_, ptr_) asm volatile("global_load_dwordx4 %0, %1, off offset:64" : "=v"(dst_) : "v"(ptr_) : "memory")
#define SC4_GLD2(dst_, ptr_) asm volatile("global_load_dwordx2 %0, %1, off" : "=v"(dst_) : "v"(ptr_) : "memory")
#define SC4_GLD1(dst_, ptr_) asm volatile("global_load_dword %0, %1, off" : "=v"(dst_) : "v"(ptr_) : "memory")
        u32x4 qf[8], kf[8];
        u32x2 pxm[2] = {(u32x2){0u, 0u}, (u32x2){0u, 0u}}; float pg[2] = {0.f, 0.f}; float pw = 0.f, pwg = 0.f, pden = 0.f; u32x2 ni[2];
        const int l0 = launder_i(X.lane); const int ql0 = l0 & 15, g0 = l0 >> 4;
#define SC4_LOADQ(ch_) do { const bf16_t* qp_ = QG + (size_t)(SC4_R0(ch_) + 2 * w) * MLI + h * 512 + 8 * l0; \
            _Pragma("unroll") for (int tt_ = 0; tt_ < 4; ++tt_) _Pragma("unroll") for (int kp_ = 0; kp_ < 2; ++kp_) SC4_GLD4(qf[2 * tt_ + kp_], qp_ + (size_t)(16 * tt_ + kp_) * MLI); } while (0)
#define SC4_LOADK(ch_) do { const bf16_t* kp0_ = KG + (size_t)(SC4_R0(ch_) + 8 * w) * MLI + h * 512 + 8 * l0; \
            _Pragma("unroll") for (int j_ = 0; j_ < 4; ++j_) _Pragma("unroll") for (int ks_ = 0; ks_ < 2; ++ks_) SC4_GLD4(kf[2 * j_ + ks_], kp0_ + (size_t)(2 * j_ + ks_) * MLI); } while (0)
#define SC4_REGS(ch_) do { const int r0_ = SC4_R0(ch_); const int vb_ = X.tid & 15, vr_ = X.tid >> 4; \
            _Pragma("unroll") for (int i_ = 0; i_ < 2; ++i_) SC4_GLD2(pxm[i_], XM + (size_t)(r0_ + 2 * vr_ + i_) * MLI + h * 512 + sl * 64 + 4 * vb_); \
            _Pragma("unroll") for (int i_ = 0; i_ < 2; ++i_) SC4_GLD1(pg[i_], GW + (((size_t)(r0_ + 2 * vr_ + i_) * 2 + dir) * 4 + h) * 2 + 1); \
            if (w == 0) { const int row_ = r0_ + X.tid; const float* gw_ = GW + (((size_t)row_ * 2 + dir) * 4 + h) * 2; SC4_GLD1(pw, gw_); SC4_GLD1(pwg, gw_ + 1); SC4_GLD1(pden, DEN + ((size_t)row_ * 2 + dir) * 4 + h); } } while (0)
#define SC4_LOADNI(ch_) do { _Pragma("unroll") for (int k_ = 0; k_ < 2; ++k_) SC4_GLD2(ni[k_], HO + (size_t)(SC4_R0(ch_) + 16 * (2 * (w & 1) + k_) + ql0) * MLI + h * 512 + sl * 64 + 16 * (w >> 1) + 4 * g0); } while (0)
#define SC4_STAGE(bf_) do { const int t1 = launder_i(X.tid); const int vb = t1 & 15, vr = t1 >> 4; float vv[2][4]; f32x4 wv4[4]; \
            _Pragma("unroll") for (int i = 0; i < 4; ++i) wv4[i] = *(const LAS f32x4*)(wvL + vb * 16 + 4 * i); \
            _Pragma("unroll") for (int i = 0; i < 2; ++i) { const u32x2 xw_ = pxm[i]; const float x0 = bf_lo(xw_.x), x1 = bf_hi(xw_.x), x2 = bf_lo(xw_.y), x3 = bf_hi(xw_.y); \
                _Pragma("unroll") for (int dd = 0; dd < 4; ++dd) vv[i][dd] = (x0 * wv4[0][dd] + x1 * wv4[1][dd] + x2 * wv4[2][dd] + x3 * wv4[3][dd]) * pg[i]; } \
            _Pragma("unroll") for (int dd = 0; dd < 4; ++dd) *(LAS unsigned*)(vL + (bf_) * 64 * AP + (4 * vb + dd) * AP + (2 * vr) * 2) = cvtpk(vv[0][dd], vv[1][dd]); \
            if (t1 < 64) { wL[(bf_) * 64 + t1] = pw; wgL[(bf_) * 64 + t1] = pwg; denL[(bf_) * 64 + t1] = pden; } } while (0)
        SC4_REGS(0); SC4_LOADQ(0); SC4_LOADK(0); SC4_LOADNI(0);
        asm volatile("s_waitcnt vmcnt(0)" : "+v"(pxm[0]), "+v"(pxm[1]), "+v"(pg[0]), "+v"(pg[1]), "+v"(pw), "+v"(pwg), "+v"(pden) :: "memory");
        SC4_STAGE(0);
        for (int ch = 0; ch < NCH; ++ch) {
            const int buf = ch & 1, r0 = SC4_R0(ch), chn = ch + 1 < NCH ? ch + 1 : ch;
            SC4_REGS(chn);
            const int l2 = l0, ql = ql0, g = g0;
            if (dry) asm volatile("s_waitcnt vmcnt(14)" : "+v"(qf[0]), "+v"(qf[1]), "+v"(qf[2]), "+v"(qf[3]), "+v"(qf[4]), "+v"(qf[5]), "+v"(qf[6]), "+v"(qf[7]) :: "memory");
            else     asm volatile("s_waitcnt vmcnt(16)" : "+v"(qf[0]), "+v"(qf[1]), "+v"(qf[2]), "+v"(qf[3]), "+v"(qf[4]), "+v"(qf[5]), "+v"(qf[6]), "+v"(qf[7]) :: "memory");
            LAS unsigned char* xw0 = xbL + buf * 65536 + (w * 2) * 512 + l2 * 8;
if (variant != 1)
#pragma unroll
            for (int th = 0; th < 2; ++th) {
                f32x4 qacc[2];
#pragma unroll
                for (int i = 0; i < 2; ++i) qacc[i] = (f32x4){0.f, 0.f, 0.f, 0.f};
#pragma unroll
                for (int dp = 0; dp < 2; ++dp) {
                    f32x4 acc[4];
#pragma unroll
                    for (int i = 0; i < 4; ++i) acc[i] = (f32x4){0.f, 0.f, 0.f, 0.f};
#pragma unroll
                    for (int kp = 0; kp < 2; ++kp) {
#pragma unroll
                        for (int dd = 0; dd < 2; ++dd) { const int dblk = 2 * dp + dd;
                            const f32x4 ca = ct[(2 * kp) * 4 + dblk], cb = ct[(2 * kp + 1) * 4 + dblk];
                            u32x4 cw; cw.x = cvtpk(ca[0], ca[1]); cw.y = cvtpk(ca[2], ca[3]); cw.z = cvtpk(cb[0], cb[1]); cw.w = cvtpk(cb[2], cb[3]);
                            const bf16x8 cf = __builtin_bit_cast(bf16x8, cw);
#pragma unroll
                            for (int i = 0; i < 2; ++i) acc[2 * dd + i] = __builtin_amdgcn_mfma_f32_16x16x32_bf16(cf, __builtin_bit_cast(bf16x8, qf[2 * (2 * th + i) + kp]), acc[2 * dd + i], 0, 0, 0); }
                        if (dp == 0) {
                            u32x4 nw; nw.x = cvtpk(nacc[2 * kp][0], nacc[2 * kp][1]); nw.y = cvtpk(nacc[2 * kp][2], nacc[2 * kp][3]); nw.z = cvtpk(nacc[2 * kp + 1][0], nacc[2 * kp + 1][1]); nw.w = cvtpk(nacc[2 * kp + 1][2], nacc[2 * kp + 1][3]);
                            const bf16x8 nf = __builtin_bit_cast(bf16x8, nw);
#pragma unroll
                            for (int i = 0; i < 2; ++i) qacc[i] = __builtin_amdgcn_mfma_f32_16x16x32_bf16(__builtin_bit_cast(bf16x8, qf[2 * (2 * th + i) + kp]), nf, qacc[i], 0, 0, 0); } }
#pragma unroll
                    for (int dd = 0; dd < 2; ++dd)
#pragma unroll
                        for (int i = 0; i < 2; ++i) { u32x2 o; o.x = cvtpk(acc[2 * dd + i][0], acc[2 * dd + i][1]); o.y = cvtpk(acc[2 * dd + i][2], acc[2 * dd + i][3]); *(LAS u32x2*)(xw0 + ((2 * dp + dd) * 2 + th) * 8192 + i * 512) = o; }
                    __builtin_amdgcn_sched_barrier(0);
                }
                if (ql == 0) {
#pragma unroll
                    for (int i = 0; i < 2; ++i)
#pragma unroll
                        for (int r = 0; r < 4; ++r) qnL[buf * 512 + (16 * (2 * th + i) + 4 * g + r) * 8 + w] = qacc[i][r]; }
            }
            if (variant != 5) SC4_LOADQ(chn);
            SC2_BAR();
            if (dry) asm volatile("s_waitcnt vmcnt(14)" : "+v"(kf[0]), "+v"(kf[1]), "+v"(kf[2]), "+v"(kf[3]), "+v"(kf[4]), "+v"(kf[5]), "+v"(kf[6]), "+v"(kf[7]) :: "memory");
            else     asm volatile("s_waitcnt vmcnt(16)" : "+v"(kf[0]), "+v"(kf[1]), "+v"(kf[2]), "+v"(kf[3]), "+v"(kf[4]), "+v"(kf[5]), "+v"(kf[6]), "+v"(kf[7]) :: "memory");
            const float decay = wL[buf * 64 + (dir ? 0 : 63)];
            if (variant != 2) {
#pragma unroll
            for (int j = 0; j < 16; ++j) ct[j] = ct[j] * decay;
#pragma unroll
            for (int j = 0; j < 4; ++j) nacc[j] = nacc[j] * decay;
#pragma unroll
            for (int ks = 0; ks < 2; ++ks) {
                bf16x8 vf[4];
#pragma unroll
                for (int dblk = 0; dblk < 4; ++dblk) vf[dblk] = *(const LAS bf16x8*)(vL + buf * 64 * AP + (16 * dblk + ql) * AP + 64 * ks + 16 * g);
                const f32x4 w0 = *(const LAS f32x4*)(wgL + buf * 64 + 32 * ks + 8 * g), w1 = *(const LAS f32x4*)(wgL + buf * 64 + 32 * ks + 8 * g + 4);
                u32x4 gwv; gwv.x = cvtpk(w0[0], w0[1]); gwv.y = cvtpk(w0[2], w0[3]); gwv.z = cvtpk(w1[0], w1[1]); gwv.w = cvtpk(w1[2], w1[3]);
                if (ql != 0) gwv = (u32x4){0u, 0u, 0u, 0u};
                const bf16x8 gwf = __builtin_bit_cast(bf16x8, gwv);
#pragma unroll
                for (int j = 0; j < 4; ++j) { const bf16x8 kfr = __builtin_bit_cast(bf16x8, kf[2 * j + ks]);
#pragma unroll
                    for (int dblk = 0; dblk < 4; ++dblk) ct[4 * j + dblk] = __builtin_amdgcn_mfma_f32_16x16x32_bf16(kfr, vf[dblk], ct[4 * j + dblk], 0, 0, 0);
                    nacc[j] = __builtin_amdgcn_mfma_f32_16x16x32_bf16(kfr, gwf, nacc[j], 0, 0, 0); } } }
            if (variant != 5) SC4_LOADK(chn);
            asm volatile("s_waitcnt vmcnt(20)" : "+v"(ni[0]), "+v"(ni[1]) :: "memory");
            if (variant != 3) { const LAS unsigned char* xr1 = xbL + buf * 65536 + w * 8192 + (g >> 1) * 1024 + (32 * (g & 1) + ql) * 8;
              bf16x8 selA;
              { const int lq = launder_i(l0); const unsigned one_lo = 0x3F80u, one_hi = 0x3F800000u; const int jd = (lq & 15) - 8 * ((lq >> 4) & 1); u32x4 sw;
          sw.x = jd == 0 ? one_lo : (jd == 1 ? one_hi : 0u); sw.y = jd == 2 ? one_lo : (jd == 3 ? one_hi : 0u); sw.z = jd == 4 ? one_lo : (jd == 5 ? one_hi : 0u); sw.w = jd == 6 ? one_lo : (jd == 7 ? one_hi : 0u);
          selA = __builtin_bit_cast(bf16x8, sw); }
#pragma unroll
              for (int k = 0; k < 2; ++k) { f32x4 sum = (f32x4){0.f, 0.f, 0.f, 0.f};
#pragma unroll
                  for (int m = 0; m < 4; ++m) { const LAS unsigned char* xp = xr1 + (2 * (2 * m) + k) * 512;
                      const u32x2 lo = *(const LAS u32x2*)(xp), hi = *(const LAS u32x2*)(xp + 128);
                      sum = __builtin_amdgcn_mfma_f32_16x16x32_bf16(selA, __builtin_bit_cast(bf16x8, (u32x4){lo.x, lo.y, hi.x, hi.y}), sum, 0, 0, 0); }
                  const int t = 16 * (2 * (w & 1) + k) + ql; const float wt = wL[buf * 64 + t];
                  const f32x4 qa = *(const LAS f32x4*)(qnL + buf * 512 + t * 8), qb = *(const LAS f32x4*)(qnL + buf * 512 + t * 8 + 4);
                  const float den = denL[buf * 64 + t] + wt * (((qa[0] + qa[1]) + (qa[2] + qa[3])) + ((qb[0] + qb[1]) + (qb[2] + qb[3])));
                  const float sc = 1.0f / (fabsf(den) > 1.0f ? fabsf(den) : 1.0f);
                  const float o0 = (bf_lo(ni[k].x) + wt * sum[0]) * sc, o1 = (bf_hi(ni[k].x) + wt * sum[1]) * sc, o2 = (bf_lo(ni[k].y) + wt * sum[2]) * sc, o3 = (bf_hi(ni[k].y) + wt * sum[3]) * sc;
                  u32x2 ow; ow.x = cvtpk(o0, o1); ow.y = cvtpk(o2, o3); if (!dry) *(u32x2*)(HO + (size_t)(r0 + t) * MLI + h * 512 + sl * 64 + 16 * (w >> 1) + 4 * g) = ow; } }
            if (dry) asm volatile("s_waitcnt vmcnt(16)" : "+v"(pxm[0]), "+v"(pxm[1]), "+v"(pg[0]), "+v"(pg[1]), "+v"(pw), "+v"(pwg), "+v"(pden) :: "memory");
            else     asm volatile("s_waitcnt vmcnt(18)" : "+v"(pxm[0]), "+v"(pxm[1]), "+v"(pg[0]), "+v"(pg[1]), "+v"(pw), "+v"(pwg), "+v"(pden) :: "memory");
            if (variant != 4) SC4_STAGE(buf ^ 1);
            SC4_LOADNI(chn);
        }
        asm volatile("s_waitcnt vmcnt(0)" : "+v"(qf[0]), "+v"(qf[1]), "+v"(qf[2]), "+v"(qf[3]), "+v"(qf[4]), "+v"(qf[5]), "+v"(qf[6]), "+v"(qf[7]), "+v"(kf[0]), "+v"(kf[1]), "+v"(kf[2]), "+v"(kf[3]), "+v"(kf[4]), "+v"(kf[5]), "+v"(kf[6]), "+v"(kf[7]), "+v"(ni[0]), "+v"(ni[1]) :: "memory");
#undef SC4_R0
#undef SC4_GLD4
#undef SC4_GLD4O
#undef SC4_GLD2
#undef SC4_GLD1
#undef SC4_LOADQ
#undef SC4_LOADK
#undef SC4_REGS
#undef SC4_LOADNI
#undef SC4_STAGE
    }
}

#pragma clang diagnostic pop
__device__ __forceinline__ void outprep2_phase(const Ctx& X0, const PArgs& a) {
    const Ctx X = fresh_ctx(X0);
    unsigned char* ws = a.ws;
    const bf16_t* __restrict__ HF = (const bf16_t*)(ws + WS_HF); const bf16_t* __restrict__ HB = (const bf16_t*)(ws + WS_HB); const bf16_t* __restrict__ XM = (const bf16_t*)(ws + WS_XM); const bf16_t* __restrict__ Z = (const bf16_t*)(ws + WS_Z2);
    bf16_t* __restrict__ OA = (bf16_t*)(ws + WS_OA2); const float* __restrict__ gn = a.in(I_MLGN); const float* __restrict__ sk = a.in(I_MLSKIP);
    LAS float* cwl = (LAS float*)X.lds;
    { const float* cw = a.in(I_MLCONVW); const float* cb = a.in(I_MLCONVB);
      for (int i = X.tid; i < 4 * MLI; i += 512) cwl[i] = cw[i];
      for (int i = X.tid; i < MLI; i += 512) cwl[4 * MLI + i] = cb[i]; }
    __syncthreads();
    for (int row = X.bid * 8 + X.wave; row < MT; row += X.G * 8) {
        int base, t, len; seq_of_row(row, base, t, len); const bool v0 = t >= 2, v1 = t >= 1, v3 = t + 1 < len;
#pragma unroll
        for (int hh = 0; hh < 4; ++hh) { const int c = hh * 512 + 8 * X.lane; const size_t o = (size_t)row * MLI + c;
            const u32x4 wf = *(const u32x4*)(HF + o), wb = *(const u32x4*)(HB + o), wz = *(const u32x4*)(Z + o); const u32x4 z4 = (u32x4){0u, 0u, 0u, 0u};
            u32x4 w[4]; w[0] = v0 ? *(const u32x4*)(XM + o - 2 * MLI) : z4; w[1] = v1 ? *(const u32x4*)(XM + o - MLI) : z4; w[2] = *(const u32x4*)(XM + o); w[3] = v3 ? *(const u32x4*)(XM + o + MLI) : z4;
            float xcv[8];
            { const f32x4 ba = *(const LAS f32x4*)(cwl + 4 * MLI + c), bb = *(const LAS f32x4*)(cwl + 4 * MLI + c + 4);
              xcv[0] = ba[0]; xcv[1] = ba[1]; xcv[2] = ba[2]; xcv[3] = ba[3]; xcv[4] = bb[0]; xcv[5] = bb[1]; xcv[6] = bb[2]; xcv[7] = bb[3]; }
#pragma unroll
            for (int tap = 0; tap < 4; ++tap) { const f32x4 ca = *(const LAS f32x4*)(cwl + tap * MLI + c), cc = *(const LAS f32x4*)(cwl + tap * MLI + c + 4);
                xcv[0] += bf_lo(w[tap].x) * ca[0]; xcv[1] += bf_hi(w[tap].x) * ca[1]; xcv[2] += bf_lo(w[tap].y) * ca[2]; xcv[3] += bf_hi(w[tap].y) * ca[3];
                xcv[4] += bf_lo(w[tap].z) * cc[0]; xcv[5] += bf_hi(w[tap].z) * cc[1]; xcv[6] += bf_lo(w[tap].w) * cc[2]; xcv[7] += bf_hi(w[tap].w) * cc[3]; }
#pragma unroll
            for (int i = 0; i < 8; ++i) xcv[i] = bf2f(f2bf(silu_f(xcv[i])));
            float hs[8] = {bf_lo(wf.x) + bf_lo(wb.x), bf_hi(wf.x) + bf_hi(wb.x), bf_lo(wf.y) + bf_lo(wb.y), bf_hi(wf.y) + bf_hi(wb.y), bf_lo(wf.z) + bf_lo(wb.z), bf_hi(wf.z) + bf_hi(wb.z), bf_lo(wf.w) + bf_lo(wb.w), bf_hi(wf.w) + bf_hi(wb.w)};
            const float zv[8] = {bf_lo(wz.x), bf_hi(wz.x), bf_lo(wz.y), bf_hi(wz.y), bf_lo(wz.z), bf_hi(wz.z), bf_lo(wz.w), bf_hi(wz.w)};
            float s = 0.f;
#pragma unroll
            for (int i = 0; i < 8; ++i) s += hs[i];
            const float mu = wave_sum(s) * (1.0f / 512.0f); float q = 0.f;
#pragma unroll
            for (int i = 0; i < 8; ++i) { hs[i] -= mu; q += hs[i] * hs[i]; }
            const float rstd = 1.0f / sqrtf(wave_sum(q) * (1.0f / 512.0f) + NORM_EPS);
            float ov[8];
#pragma unroll
            for (int i = 0; i < 8; ++i) ov[i] = (hs[i] * rstd * gn[c + i] + sk[c + i] * xcv[i]) * silu_f(zv[i]);
            u32x4 wo; wo.x = cvtpk(ov[0], ov[1]); wo.y = cvtpk(ov[2], ov[3]); wo.z = cvtpk(ov[4], ov[5]); wo.w = cvtpk(ov[6], ov[7]);
            *(u32x4*)(OA + o) = wo; }
    }
}

template <int CBLO, int CBHI, bool LOCAL>
__device__ __forceinline__ void attn_tile2(const LAS unsigned char* kt0, const LAS unsigned char* vt0, const LAS float* blr0, const bf16x8 (&qf)[2], float& m, float& lsum, f32x4 (&o)[4], int ql, int g, int qc, int c0) {
    constexpr int PITCH = 272, TILEB = 64 * PITCH;
    f32x4 s[2][4];
#pragma unroll
    for (int ts = 0; ts < 2; ++ts)
#pragma unroll
        for (int cb = CBLO; cb <= CBHI; ++cb) { s[ts][cb] = (f32x4){0.f, 0.f, 0.f, 0.f};
#pragma unroll
            for (int ss = 0; ss < 2; ++ss) { const bf16x8 kf = *(const LAS bf16x8*)(kt0 + ts * TILEB + (16 * cb + ql) * PITCH + ss * 64 + g * 16);
                s[ts][cb] = __builtin_amdgcn_mfma_f32_16x16x32_bf16(kf, qf[ss], s[ts][cb], 0, 0, 0); } }
    float mx = -1.0e30f;
#pragma unroll
    for (int ts = 0; ts < 2; ++ts)
#pragma unroll
        for (int cb = CBLO; cb <= CBHI; ++cb)
#pragma unroll
            for (int rg = 0; rg < 4; ++rg) { float v = s[ts][cb][rg] * 0.18033688011112042f;
                if (LOCAL) { const int kc = 16 * cb + 4 * g + rg; int dc = kc - qc; dc = dc < -15 ? -15 : (dc > 15 ? 15 : dc);
                    v += blr0[ts * 32 + dc + 15]; v = (kc >= c0 && kc < c0 + 16) ? v : -1.0e30f; }
                s[ts][cb][rg] = v; mx = fmaxf(mx, v); }
    mx = fmaxf(mx, __shfl_xor(mx, 16)); mx = fmaxf(mx, __shfl_xor(mx, 32));
    const float mn = fmaxf(m, mx), alpha = __builtin_amdgcn_exp2f(m - mn); m = mn;
    float ps = 0.f;
#pragma unroll
    for (int ts = 0; ts < 2; ++ts)
#pragma unroll
        for (int cb = CBLO; cb <= CBHI; ++cb)
#pragma unroll
            for (int rg = 0; rg < 4; ++rg) { const float p = __builtin_amdgcn_exp2f(s[ts][cb][rg] - mn); s[ts][cb][rg] = p; ps += p; }
    lsum = lsum * alpha + ps;
#pragma unroll
    for (int db = 0; db < 4; ++db) o[db] = o[db] * alpha;
#pragma unroll
    for (int ts = 0; ts < 2; ++ts)
#pragma unroll
        for (int pr = 0; pr < 2; ++pr) {
            if (2 * pr + 1 < CBLO || 2 * pr > CBHI) continue;
            const f32x4 z = (f32x4){0.f, 0.f, 0.f, 0.f};
            const f32x4 s0 = (2 * pr >= CBLO && 2 * pr <= CBHI) ? s[ts][2 * pr] : z, s1 = (2 * pr + 1 >= CBLO && 2 * pr + 1 <= CBHI) ? s[ts][2 * pr + 1] : z;
            u32x4 pw; pw.x = cvtpk(s0[0], s0[1]); pw.y = cvtpk(s0[2], s0[3]); pw.z = cvtpk(s1[0], s1[1]); pw.w = cvtpk(s1[2], s1[3]);
            const bf16x8 pf = __builtin_bit_cast(bf16x8, pw);
#pragma unroll
            for (int db = 0; db < 4; ++db) {
                const LAS unsigned char* vp = vt0 + ts * TILEB + (32 * pr + 4 * g + (ql >> 2)) * PITCH + (16 * db + 4 * (ql & 3)) * 2;
                const s16x4 t0 = lds_tr16(vp), t1 = lds_tr16(vp + 16 * PITCH);
                const bf16x8 vf = (bf16x8){t0[0], t0[1], t0[2], t0[3], t1[0], t1[1], t1[2], t1[3]};
                o[db] = __builtin_amdgcn_mfma_f32_16x16x32_bf16(vf, pf, o[db], 0, 0, 0); } }
}
template <int B0, int B1>
__device__ __forceinline__ void attn_tile2p(const LAS unsigned char* kt0, const LAS unsigned char* vt0, const LAS float* blr0, const bf16x8 (&qf)[2], float& m, float& lsum, f32x4 (&o)[4], int ql, int g, int qc, int c0) {
    constexpr int PITCH = 272, TILEB = 64 * PITCH;
    f32x4 s[2][2];
#pragma unroll
    for (int ts = 0; ts < 2; ++ts)
#pragma unroll
        for (int i = 0; i < 2; ++i) { const int cb = i ? B1 : B0; s[ts][i] = (f32x4){0.f, 0.f, 0.f, 0.f};
#pragma unroll
            for (int ss = 0; ss < 2; ++ss) { const bf16x8 kf = *(const LAS bf16x8*)(kt0 + ts * TILEB + (16 * cb + ql) * PITCH + ss * 64 + g * 16);
                s[ts][i] = __builtin_amdgcn_mfma_f32_16x16x32_bf16(kf, qf[ss], s[ts][i], 0, 0, 0); } }
    float mx = -1.0e30f;
#pragma unroll
    for (int ts = 0; ts < 2; ++ts)
#pragma unroll
        for (int i = 0; i < 2; ++i)
#pragma unroll
            for (int rg = 0; rg < 4; ++rg) { float v = s[ts][i][rg] * 0.18033688011112042f;
                const int kc = 16 * (i ? B1 : B0) + 4 * g + rg; int dc = kc - qc; dc = dc < -15 ? -15 : (dc > 15 ? 15 : dc);
                v += blr0[ts * 32 + dc + 15]; v = (kc >= c0 && kc < c0 + 16) ? v : -1.0e30f;
                s[ts][i][rg] = v; mx = fmaxf(mx, v); }
    mx = fmaxf(mx, __shfl_xor(mx, 16)); mx = fmaxf(mx, __shfl_xor(mx, 32));
    const float mn = fmaxf(m, mx), alpha = __builtin_amdgcn_exp2f(m - mn); m = mn;
    float ps = 0.f;
#pragma unroll
    for (int ts = 0; ts < 2; ++ts)
#pragma unroll
        for (int i = 0; i < 2; ++i)
#pragma unroll
            for (int rg = 0; rg < 4; ++rg) { const float p = __builtin_amdgcn_exp2f(s[ts][i][rg] - mn); s[ts][i][rg] = p; ps += p; }
    lsum = lsum * alpha + ps;
#pragma unroll
    for (int db = 0; db < 4; ++db) o[db] = o[db] * alpha;
#pragma unroll
    for (int ts = 0; ts < 2; ++ts) {
        const f32x4 s0 = s[ts][0], s1 = s[ts][1];
        u32x4 pw; pw.x = cvtpk(s0[0], s0[1]); pw.y = cvtpk(s0[2], s0[3]); pw.z = cvtpk(s1[0], s1[1]); pw.w = cvtpk(s1[2], s1[3]);
        const bf16x8 pf = __builtin_bit_cast(bf16x8, pw);
#pragma unroll
        for (int db = 0; db < 4; ++db) {
            const LAS unsigned char* vp = vt0 + ts * TILEB + (4 * g + (ql >> 2)) * PITCH + (16 * db + 4 * (ql & 3)) * 2;
            const s16x4 t0 = lds_tr16(vp + 16 * B0 * PITCH), t1 = lds_tr16(vp + 16 * B1 * PITCH);
            const bf16x8 vf = (bf16x8){t0[0], t0[1], t0[2], t0[3], t1[0], t1[1], t1[2], t1[3]};
            o[db] = __builtin_amdgcn_mfma_f32_16x16x32_bf16(vf, pf, o[db], 0, 0, 0); } }
}
__device__ __forceinline__ void attn2_phase(const Ctx& X0, const PArgs& a, int j_na, bool with_ctx) {
    const Ctx X = fresh_ctx(X0);
    unsigned char* ws = a.ws;
    const bf16_t* Q = (const bf16_t*)(ws + WS_Q); const bf16_t* K = (const bf16_t*)(ws + WS_K); const bf16_t* V = (const bf16_t*)(ws + WS_V); bf16_t* O = (bf16_t*)(ws + WS_O);
    const float* rpb = a.in(I_NARPB) + (size_t)j_na * NAH * 15 * 31;
    constexpr int PITCH = 272, TILEB = 64 * PITCH;
    LAS unsigned char* Kb = X.lds; LAS unsigned char* Vb = X.lds + 4 * TILEB; LAS float* bl = (LAS float*)(X.lds + 8 * TILEB);
    const int hsel = X.wave >> 2, jb = X.wave & 3, ql = X.lane & 15, g = X.lane >> 4;
    const int nlat = NB * GROWS * 8, nunits = nlat + (with_ctx ? NB * 8 * 4 : 0);
    const int skey = X.tid >> 3, sch = (X.tid & 7) * 16;
    const int qc = jb == 0 ? (ql < 8 ? ql : 48 + ql) : 16 * jb - 8 + ql, c0 = qc - 8 < 0 ? 0 : (qc - 8 > 48 ? 48 : qc - 8);
    const int nper = (X.G % 8 == 0 && nlat % 8 == 0) ? nlat / 8 : 0, wpx = X.G / 8;
    for (int k = 0; ; ++k) {
        int u;
        if (nper) { const int iu = (X.bid >> 3) + wpx * k; u = iu < nper ? (X.bid & 7) * nper + iu : nlat + (iu - nper) * 8 + (X.bid & 7); }
        else u = X.bid + X.G * k;
        if (u >= nunits) break;
        const bool lat = u < nlat; int b, h0, r = 0, r0 = 0, qrow0, nst;
        if (lat) { b = u / (GROWS * 8); const int rem = u % (GROWS * 8); h0 = (rem >> 7) * 2; r = rem & 127; r0 = r - 4; r0 = r0 < 0 ? 0 : (r0 > GROWS - 8 ? GROWS - 8 : r0); qrow0 = b * SEQ + r * GRIDW; nst = 6; }
        else { const int v = u - nlat; b = v >> 5; h0 = ((v >> 2) & 7) * 2; qrow0 = NLAT + b * CTXL + (v & 3) * 64; nst = 2; }
        const int h = h0 + hsel;
        bf16x8 qf[2];
        { const bf16_t* qp = Q + (size_t)(qrow0 + qc) * D + h * 64 + 8 * g; qf[0] = *(const bf16x8*)qp; qf[1] = *(const bf16x8*)(qp + 32); }
        __syncthreads();
        if (lat) { const int idx = X.tid; const int hh = idx >> 8, i = (idx >> 5) & 7, dc = idx & 31; bl[idx] = dc < 31 ? rpb[((h0 + hh) * 15 + (r0 + i - r + 7)) * 31 + dc] * 1.4426950408889634f : 0.f; }
        float m = -1.0e30f, lsum = 0.f; f32x4 o[4];
#pragma unroll
        for (int i = 0; i < 4; ++i) o[i] = (f32x4){0.f, 0.f, 0.f, 0.f};
        u32x4 kr[2][2], vr[2][2];
#define AT_KROW(tl_) ((lat && (tl_) < 8) ? b * SEQ + (r0 + (tl_)) * GRIDW : NLAT + b * CTXL + (lat ? (tl_) - 8 : (tl_)) * 64)
#define AT_LOAD(st_) do { _Pragma("unroll") for (int ts_ = 0; ts_ < 2; ++ts_) { const size_t go_ = (size_t)(AT_KROW(2 * (st_) + ts_) + skey) * D + h0 * 64 + sch; \
            kr[ts_][0] = *(const u32x4*)(K + go_); kr[ts_][1] = *(const u32x4*)(K + go_ + 8); vr[ts_][0] = *(const u32x4*)(V + go_); vr[ts_][1] = *(const u32x4*)(V + go_ + 8); } } while (0)
        AT_LOAD(0);
        for (int st = 0; st < nst; ++st) {
            const int buf = st & 1;
#pragma unroll
            for (int ts = 0; ts < 2; ++ts) { LAS unsigned char* kd = Kb + (buf * 2 + ts) * TILEB + skey * PITCH + sch * 2; LAS unsigned char* vd = Vb + (buf * 2 + ts) * TILEB + skey * PITCH + sch * 2;
                *(LAS u32x4*)kd = kr[ts][0]; *(LAS u32x4*)(kd + 16) = kr[ts][1]; *(LAS u32x4*)vd = vr[ts][0]; *(LAS u32x4*)(vd + 16) = vr[ts][1]; }
            __syncthreads();
            if (st + 1 < nst) AT_LOAD(st + 1);
            const bool local = lat && st < 4;
            const LAS unsigned char* kt0 = Kb + (buf * 2) * TILEB + hsel * 128; const LAS unsigned char* vt0 = Vb + (buf * 2) * TILEB + hsel * 128; const LAS float* blr0 = bl + hsel * 256 + (2 * st) * 32;
            if (!local) attn_tile2<0, 3, false>(kt0, vt0, blr0, qf, m, lsum, o, ql, g, qc, c0);
            else if (jb == 0) attn_tile2p<0, 3>(kt0, vt0, blr0, qf, m, lsum, o, ql, g, qc, c0);
            else if (jb == 1) attn_tile2p<0, 1>(kt0, vt0, blr0, qf, m, lsum, o, ql, g, qc, c0);
            else if (jb == 2) attn_tile2p<1, 2>(kt0, vt0, blr0, qf, m, lsum, o, ql, g, qc, c0);
            else attn_tile2p<2, 3>(kt0, vt0, blr0, qf, m, lsum, o, ql, g, qc, c0);
        }
#undef AT_KROW
#undef AT_LOAD
        lsum += __shfl_xor(lsum, 16); lsum += __shfl_xor(lsum, 32);
        const float inv = 1.0f / lsum;
        bf16_t* op = O + (size_t)(qrow0 + qc) * D + h * 64 + 4 * g;
#pragma unroll
        for (int db = 0; db < 4; ++db) { u32x2 w; w.x = cvtpk(o[db][0] * inv, o[db][1] * inv); w.y = cvtpk(o[db][2] * inv, o[db][3] * inv); *(u32x2*)(op + 16 * db) = w; }
    }
}
struct MoeOrder {
    const LAS int* tab;
    int chunk, G, c, nN, kind;
    const bf16_t* A; const bf16_t* W; const int* LIST;
    __device__ __forceinline__ bool next(int i, pg8::Unit& u) const {
#define RFL(x) __builtin_amdgcn_readfirstlane(x)
        const int nM = RFL(tab[8]); if (nM <= 0) return false;
        int pm, pn; if (!pg8::tile_order(i, G, c, nM, nN, pm, pn)) return false;
        const int gt = pm; int e = 0;
        for (int j = 1; j < 8; ++j) e += (gt >= RFL(tab[j])) ? 1 : 0;
        const int tse = RFL(tab[e]), cne = RFL(tab[16 + e]);
#undef RFL
        const int slot0 = (gt - tse) * 256; int nr = cne - slot0; nr = nr > 256 ? 256 : nr;
        if (kind == 1) { u.a = (const char*)A + (size_t)gt * 256 * D; u.rows = nullptr; u.nrows = nr; u.b = (const char*)W + ((size_t)e * 2 * FFE + (size_t)pn * 256) * D; u.orow = gt * 256; u.ocol = pn * 128; }
        else { u.a = (const char*)A + (size_t)gt * 256 * FFE; u.rows = nullptr; u.nrows = 256; u.b = (const char*)W + ((size_t)e * D + (size_t)pn * 256) * FFE; u.orow = gt * 256; u.ocol = pn * 256; }
        u.aux = 0; return true;
    }
};
__device__ __forceinline__ void moe_table(const Ctx& X, const unsigned* cntw, LAS int* tab) {
    __syncthreads();
    if (X.tid == 0) { int acc = 0; for (int e = 0; e < 8; ++e) { const int c = (int)__hip_atomic_load(cntw + 64 * e, RLX_AGENT); tab[16 + e] = c; tab[e] = acc; acc += (c + 255) >> 8; } tab[8] = acc; }
    __syncthreads();
}

__device__ __forceinline__ void moe_gather_phase(const Ctx& X0, const PArgs& a, const unsigned* cntw, LAS int* tab) {
    const Ctx X = fresh_ctx(X0);
    moe_table(X, cntw, tab);
    const bf16_t* __restrict__ A = (const bf16_t*)(a.ws + WS_A); unsigned char* __restrict__ AG = (unsigned char*)(a.ws + WS_AG); const int* __restrict__ LIST = (const int*)(a.ws + WS_LIST);
    const int ntile = tab[8]; const int step = X.G * 8, nrow = ntile * 256;
#define GA_SRC(cr_) ({ int src_ = -1; if ((cr_) < nrow) { const int gt_ = (cr_) >> 8; int e_ = 0; for (int j_ = 1; j_ < 8; ++j_) e_ += (gt_ >= tab[j_]) ? 1 : 0; const int slot_ = (cr_) - tab[e_] * 256; \
        if (slot_ < tab[16 + e_]) src_ = LIST[(size_t)e_ * MT + slot_]; } src_; })
#define GA_DATA(src_, d0_, d1_) do { d0_ = (u32x4){0u, 0u, 0u, 0u}; d1_ = d0_; if ((src_) >= 0) { const u32x4* sp_ = (const u32x4*)(A + (size_t)(src_) * D) + 2 * X.lane; d0_ = sp_[0]; d1_ = sp_[1]; } } while (0)
    const int cr0 = X.bid * 8 + X.wave;
    int srcA = GA_SRC(cr0), srcB = GA_SRC(cr0 + step);
    u32x4 nd0, nd1; GA_DATA(srcA, nd0, nd1);
    for (int cr = cr0; cr < nrow; cr += step) {
        const u32x4 v0 = nd0, v1 = nd1;
        srcA = srcB; srcB = GA_SRC(cr + 2 * step);
        GA_DATA(srcA, nd0, nd1);
        u32x4 o;
#define F8C(x_) __builtin_fminf(__builtin_fmaxf((x_), -448.f), 448.f)
        { int p = __builtin_amdgcn_cvt_pk_fp8_f32(F8C(bf_lo(v0.x)), F8C(bf_hi(v0.x)), 0, false); p = __builtin_amdgcn_cvt_pk_fp8_f32(F8C(bf_lo(v0.y)), F8C(bf_hi(v0.y)), p, true); o.x = (unsigned)p;
          p = __builtin_amdgcn_cvt_pk_fp8_f32(F8C(bf_lo(v0.z)), F8C(bf_hi(v0.z)), 0, false); p = __builtin_amdgcn_cvt_pk_fp8_f32(F8C(bf_lo(v0.w)), F8C(bf_hi(v0.w)), p, true); o.y = (unsigned)p;
          p = __builtin_amdgcn_cvt_pk_fp8_f32(F8C(bf_lo(v1.x)), F8C(bf_hi(v1.x)), 0, false); p = __builtin_amdgcn_cvt_pk_fp8_f32(F8C(bf_lo(v1.y)), F8C(bf_hi(v1.y)), p, true); o.z = (unsigned)p;
          p = __builtin_amdgcn_cvt_pk_fp8_f32(F8C(bf_lo(v1.z)), F8C(bf_hi(v1.z)), 0, false); p = __builtin_amdgcn_cvt_pk_fp8_f32(F8C(bf_lo(v1.w)), F8C(bf_hi(v1.w)), p, true); o.w = (unsigned)p; }

#undef F8C
        *((u32x4*)(AG + (size_t)cr * D) + X.lane) = o;
    }
#undef GA_SRC
#undef GA_DATA
}

#ifdef PROBE_PRO
#define RP_PRO 1
#else
#define RP_PRO 0
#endif
#ifdef PROBE_NORM
#define RP_NORM 1
#else
#define RP_NORM 0
#endif
#ifdef PROBE_GEMM_A
#define RP_GA 1
#else
#define RP_GA 0
#endif
#ifdef PROBE_GEMM_B
#define RP_GB 1
#else
#define RP_GB 0
#endif
#ifdef PROBE_MOE
#define RP_MOE 1
#else
#define RP_MOE 0
#endif
#ifdef PROBE_ATTN
#define RP_ATTN 1
#else
#define RP_ATTN 0
#endif
#ifdef PROBE_ML
#define RP_ML 1
#else
#define RP_ML 0
#endif
#ifdef PROBE_FEAT
#define RP_FEAT 1
#else
#define RP_FEAT RP_ML
#endif
#ifdef PROBE_SCANA
#define RP_SCANA 1
#else
#define RP_SCANA RP_ML
#endif
#ifdef PROBE_SCANB
#define RP_SCANB 1
#else
#define RP_SCANB RP_ML
#endif
#ifdef PROBE_OUTPREP
#define RP_OUTPREP 1
#else
#define RP_OUTPREP RP_ML
#endif
constexpr int NSEG = 40;
__global__ void __launch_bounds__(512, 2) trunk_fwd(Args args) {
    extern __shared__ __attribute__((aligned(16))) unsigned char lds_raw[];
    Ctx X; X.lds = (LAS unsigned char*)lds_raw; X.tid = threadIdx.x; X.lane = X.tid & 63; X.wave = __builtin_amdgcn_readfirstlane(X.tid >> 6); X.G = gridDim.x; X.bid = blockIdx.x;
    unsigned char* ws = args.ws; unsigned* ctl = (unsigned*)(ws + WS_CTL);
    volatile LAS unsigned* MISC = (volatile LAS unsigned*)(X.lds + MISC_OFF);
    if (X.tid < 64) MISC[X.tid] = 0u;
    __syncthreads();
    LAS unsigned long long* ATAB = (LAS unsigned long long*)(X.lds + MISC_OFF - 640);
    { unsigned long long v = 0ull;
#pragma unroll
      for (int i = 0; i < 33; ++i) v = (X.tid == i) ? (unsigned long long)args.in[i] : v;
      if (X.tid < 33) ATAB[X.tid] = v; }
    __syncthreads();
    PArgs PA; PA.tab = ATAB; PA.out = args.out; PA.ws = args.ws;
    const int lo = args.lo, hi = args.hi;
    XcdBarrier bar; bar.bar = ctl + CW_BAR; bar.x = 0; bar.st = MISC + 8;
    if (hi - lo > 1) bar = xcd_barrier_post(ctl + CW_BAR, MISC + 8);
    int seg = 0;
#define SEG_BEGIN if (seg >= lo && seg < hi) {
#define SEG_END } if (seg >= lo && seg + 1 < hi) xcd_barrier(bar); ++seg;
    const float* MOD = (const float*)(ws + WS_MOD);
    bf16_t* Abuf = (bf16_t*)(ws + WS_A); bf16_t* H = (bf16_t*)(ws + WS_H);
    LAS int* MTAB = (LAS int*)(X.lds + MISC_OFF - 256);

    SEG_BEGIN
#ifndef NO_PRO
 for (int rp = 0; rp <= RP_PRO; ++rp) prologue_phase(X, PA);
#endif
 SEG_END

#define NORM_SPLIT(Lq, whichq, routeq, rsetq, dryq) do { \
        if (X.bid >= 16) norm_phase(X, PA, Lq, whichq, 0, NLAT, X.G - 16, X.bid - 16, false, 0, 0, routeq, rsetq, false, dryq); } while (0)
    SEG_BEGIN
#ifndef NO_NORM
        if (RP_NORM) norm_phase(X, PA, 0, 0, 0, MT, X.G, X.bid, false, 0, 0, false, 0, false, true);
        norm_phase(X, PA, 0, 0, 0, MT, X.G, X.bid, false, 0, 0, false, 0, false);
#endif
    SEG_END
    for (int L = 0; L < DEPTH; ++L) {
        const int kind = L % 3, jk = L / 3, moe = L & 1, ek = L >> 1; const bool last = (L == DEPTH - 1);
        if (L > 0 && ((L - 1) & 1)) {
            SEG_BEGIN
#ifndef NO_NORM
                if (RP_NORM) norm_phase(X, PA, L, 0, 0, MT, X.G, X.bid, true, L - 1, (L - 1) >> 1, false, 0, false, true);
                norm_phase(X, PA, L, 0, 0, MT, X.G, X.bid, true, L - 1, (L - 1) >> 1, false, 0, false);
#endif
            SEG_END
        }
        if (kind != 1) {
            SEG_BEGIN
                pg8::PlainOrder S; pg8::EpiBf16 E;
                if (kind == 0) { S = pg8::PlainOrder{Abuf, (const bf16_t*)(ws + WS_WQKV) + (size_t)jk * 3 * D * D, D, D, MT / 256, 12, X.G, X.bid, 0, 256, 0};
                                 E = pg8::EpiBf16{(bf16_t*)(ws + WS_Q), D, PA.in(I_NABQKV) + jk * 3 * D, D, (size_t)MT * D}; }
                else           { S = pg8::PlainOrder{Abuf, (const bf16_t*)(ws + WS_WUP), D, D, MT / 256, 8, X.G, X.bid, 0, 256, 0};
                                 E = pg8::EpiBf16{(bf16_t*)(ws + WS_XM), MLI, nullptr, 0, 0}; }
#ifndef NO_G1
                for (int rp = 0; rp <= RP_GA; ++rp) pg8::gemm_phase<pg8::EpiBf16, pg8::PlainOrder, false>(X.lds, D, D, D, S, E);
#endif
            SEG_END
        }
        if (kind == 0) { SEG_BEGIN
#ifndef NO_ATTN
            for (int rp = 0; rp <= RP_ATTN; ++rp) attn3_phase(X, PA, jk, !last);
#endif
        SEG_END }
        if (kind == 2) {
            SEG_BEGIN
#ifndef NO_FEAT
#ifdef PROBE_FEATLD
                feat2_phase(X, PA, true);
#endif
                for (int rp = 0; rp <= RP_FEAT; ++rp) feat2_phase(X, PA);
#endif
            SEG_END
            SEG_BEGIN
#ifndef NO_SCANA
                scanA2_phase(X, PA);
#endif
            SEG_END
            SEG_BEGIN
#ifndef NO_SCANB
#ifdef PROBE_SCANB1
                scanB2_phase(X, PA, true, 1);
#endif
#ifdef PROBE_SCANB2
                scanB2_phase(X, PA, true, 2);
#endif
#ifdef PROBE_SCANB3
                scanB2_phase(X, PA, true, 3);
#endif
#ifdef PROBE_SCANB4
                scanB2_phase(X, PA, true, 4);
#endif
#ifdef PROBE_SB4V
                scanB4_phase(X, PA, true, PROBE_SB4V);
#endif
                if (RP_SCANB) scanB4_phase(X, PA, true);
                scanB4_phase(X, PA);
#endif
            SEG_END
            SEG_BEGIN
                pg8::PlainOrder S{Abuf, (const bf16_t*)(ws + WS_WUP) + (size_t)MLI * D, D, D, MT / 256, 8, X.G, X.bid, 0, 256, 0};
                pg8::EpiBf16 E{(bf16_t*)(ws + WS_Z2), MLI, nullptr, 0, 0};
                for (int rp = 0; rp <= RP_GA; ++rp) pg8::gemm_phase<pg8::EpiBf16, pg8::PlainOrder, false>(X.lds, D, D, D, S, E);
            SEG_END
            SEG_BEGIN
#ifndef NO_OUTPREP
                for (int rp = 0; rp <= RP_OUTPREP; ++rp) outprep2_phase(X, PA);
#endif
            SEG_END
        }
        if (kind == 1) { SEG_BEGIN
#ifndef NO_POOLPREP
            for (int rp = 0; rp <= RP_ML; ++rp) poolprep_phase(X, PA, MT);
#endif
        SEG_END }
        {
            pg8::PlainOrder S; int lda, ldb, K;
            if (kind == 0)      { S = pg8::PlainOrder{(const bf16_t*)(ws + WS_O), (const bf16_t*)(ws + WS_WOUT) + (size_t)jk * D * D, D, D, NLAT / 256, 4, X.G, X.bid, 0, 256, 0}; lda = D; ldb = D; K = D; }
            else if (kind == 1) { S = pg8::PlainOrder{(const bf16_t*)(ws + WS_PL), (const bf16_t*)(ws + WS_WPOOL), D, 256, NLAT / 256, 4, X.G, X.bid, 256, 256, 0}; lda = D; ldb = 256; K = 256; }
            else                { S = pg8::PlainOrder{(const bf16_t*)(ws + WS_OA2), (const bf16_t*)(ws + WS_WDOWN), MLI, MLI, NLAT / 256, 4, X.G, X.bid, 0, 256, 0}; lda = MLI; ldb = MLI; K = MLI; }
            pg8::EpiRes E{H, MOD + (size_t)(L * 5 * NMODV + 6) * D, MOD + (size_t)(L * 5 * NMODV + 7) * D, NMODV * D, 0, L == 0 ? PA.in(I_X) : nullptr, L == 0 ? PA.in(I_CTX) : nullptr};
            SEG_BEGIN
#ifndef NO_G2
                if (RP_GB) { pg8::EpiRes Ed = E; Ed.dry = 1; pg8::gemm_phase<pg8::EpiRes, pg8::PlainOrder, false>(X.lds, lda, ldb, K, S, Ed); }
                pg8::gemm_phase<pg8::EpiRes, pg8::PlainOrder, false>(X.lds, lda, ldb, K, S, E);
#endif
            SEG_END
            if (last) {
                SEG_BEGIN
#ifndef NO_NORM2
                    if (RP_NORM) norm_phase(X, PA, L, 1, 0, NLAT, X.G, X.bid, false, 0, 0, moe != 0, ek, false, true);
                    norm_phase(X, PA, L, 1, 0, NLAT, X.G, X.bid, false, 0, 0, moe != 0, ek, false);
#endif
                SEG_END
            } else {
                SEG_BEGIN
                    if (X.bid < 16 && X.G > 16) { pg8::PlainOrder Sc = S; Sc.nM = NCTX / 256; Sc.pm0 = NLAT / 256; Sc.G = 16; Sc.c = X.bid;
                        pg8::gemm_phase<pg8::EpiRes, pg8::PlainOrder, false>(X.lds, lda, ldb, K, Sc, E); }
                    else if (X.G > 16) { if (RP_NORM) NORM_SPLIT(L, 1, moe != 0, ek, true); NORM_SPLIT(L, 1, moe != 0, ek, false); }
                SEG_END
                SEG_BEGIN
                    if (X.G > 16) { if (RP_NORM) norm_phase(X, PA, L, 1, NLAT, MT, X.G, X.bid, false, 0, 0, moe != 0, ek, false, true);
                                    norm_phase(X, PA, L, 1, NLAT, MT, X.G, X.bid, false, 0, 0, moe != 0, ek, false); }
                SEG_END
            }
        }
        const int nr2 = last ? NLAT : MT;
        if (!moe) {
            SEG_BEGIN
                const bool csplit = X.G >= CONV_SPLIT * 2; const int gg = csplit ? X.G - CONV_SPLIT : X.G, gc = csplit ? X.bid - CONV_SPLIT : X.bid;
                pg8::PlainOrder S{Abuf, (const bf16_t*)(ws + WS_WF13) + (size_t)ek * 2 * FFD * D, D, D, nr2 / 256, 22, gg, gc, 0, 128, 0};
                pg8::EpiSwigluF8 E{(unsigned char*)(ws + WS_T), FFD, 1.0f, F8_ST, 0};
#ifndef NO_G3
                if (csplit && X.bid < CONV_SPLIT) conv_weights(X, PA, L >> 1, CONV_SPLIT, X.bid);
                else for (int rp = 0; rp <= RP_GA; ++rp) pg8::gemm_phase<pg8::EpiSwigluF8, pg8::PlainOrder, false>(X.lds, D, D, D, S, E);
#endif
            SEG_END
            pg8::PlainOrder S{(const bf16_t*)(ws + WS_T), (const bf16_t*)(ws + WS_WF2 + (size_t)ek * D * FFD), FFD / 2, FFD / 2, NLAT / 256, 4, X.G, X.bid, 0, 256, 0};
            pg8::EpiRes E{H, MOD + (size_t)(L * 5 * NMODV + 5) * D, nullptr, NMODV * D, 0, nullptr, nullptr, 1.0f / (F8_ST * F8_SWD)};
            SEG_BEGIN
#ifndef NO_G4
                if (RP_GB) { pg8::EpiRes Ed = E; Ed.dry = 1; pg8::gemm_phase<pg8::EpiRes, pg8::PlainOrder, false, true>(X.lds, FFD / 2, FFD / 2, FFD / 2, S, Ed); }
                pg8::gemm_phase<pg8::EpiRes, pg8::PlainOrder, false, true>(X.lds, FFD / 2, FFD / 2, FFD / 2, S, E);
#endif
            SEG_END
            SEG_BEGIN
                if (X.bid < 16 && X.G > 16) { pg8::PlainOrder Sc = S; Sc.nM = NCTX / 256; Sc.pm0 = NLAT / 256; Sc.G = 16; Sc.c = X.bid;
                    pg8::gemm_phase<pg8::EpiRes, pg8::PlainOrder, false, true>(X.lds, FFD / 2, FFD / 2, FFD / 2, Sc, E); }
                else if (X.G > 16) { if (RP_NORM) NORM_SPLIT(L + 1, 0, false, 0, true); NORM_SPLIT(L + 1, 0, false, 0, false); }
            SEG_END
            SEG_BEGIN
                if (X.G > 16) { if (RP_NORM) norm_phase(X, PA, L + 1, 0, NLAT, MT, X.G, X.bid, false, 0, 0, false, 0, false, true);
                                norm_phase(X, PA, L + 1, 0, NLAT, MT, X.G, X.bid, false, 0, 0, false, 0, false); }
                if (L + 1 == 3 && X.G < CONV_SPLIT * 2) conv_weights(X, PA, 1);
            SEG_END
        } else {
            SEG_BEGIN
#ifndef NO_GATHER
                for (int rp = 0; rp <= RP_MOE; ++rp) moe_gather_phase(X, PA, ctl + CW_CNT + 64 * 8 * ek, MTAB);
#endif
            SEG_END
            {
                SEG_BEGIN
                    MoeOrder S; moe_table(X, ctl + CW_CNT + 64 * 8 * ek, MTAB); S.tab = MTAB; S.chunk = 0; S.G = X.G; S.c = X.bid; S.nN = 28; S.kind = 1;
                    S.A = (const bf16_t*)(ws + WS_AG); S.W = (const bf16_t*)(ws + WS_WM13); S.LIST = nullptr;
                    pg8::EpiSwigluF8 E{(unsigned char*)(ws + WS_MT), FFE, 1.0f / F8_SW1, F8_ST, 0};
#ifndef NO_G5
#ifdef PROBE_MOE1DRY
                    { pg8::EpiSwigluF8 Ed = E; Ed.dry = 1; pg8::gemm_phase<pg8::EpiSwigluF8, MoeOrder, false, true>(X.lds, D / 2, D / 2, D / 2, S, Ed); }
#endif
#ifdef PROBE_MOE1
                    pg8::gemm_phase<pg8::EpiSwigluF8, MoeOrder, false, true>(X.lds, D / 2, D / 2, D / 2, S, E);
#endif
                    for (int rp = 0; rp <= RP_MOE; ++rp) pg8::gemm_phase<pg8::EpiSwigluF8, MoeOrder, false, true>(X.lds, D / 2, D / 2, D / 2, S, E);
#endif
                SEG_END
                SEG_BEGIN
                    MoeOrder S; moe_table(X, ctl + CW_CNT + 64 * 8 * ek, MTAB); S.tab = MTAB; S.chunk = 0; S.G = X.G; S.c = X.bid; S.nN = 4; S.kind = 2;
                    S.A = (const bf16_t*)(ws + WS_MT); S.W = (const bf16_t*)(ws + WS_WM2); S.LIST = nullptr;
                    pg8::EpiBf16S E{(bf16_t*)(ws + WS_MY), D, 1.0f / (F8_ST * F8_SW2)};
#ifndef NO_G6
                    for (int rp = 0; rp <= RP_MOE; ++rp) pg8::gemm_phase<pg8::EpiBf16S, MoeOrder, false, true>(X.lds, FFE / 2, FFE / 2, FFE / 2, S, E);
#endif
                SEG_END
            }
        }
    }
    SEG_BEGIN
#ifndef NO_FINAL
        if (RP_NORM) norm_phase(X, PA, 0, 0, 0, NLAT, X.G, X.bid, true, 3, 1, false, 0, true, true);
        norm_phase(X, PA, 0, 0, 0, NLAT, X.G, X.bid, true, 3, 1, false, 0, true);
#endif
    SEG_END
#undef NORM_SPLIT
#undef SEG_BEGIN
#undef SEG_END
}

#ifndef ONE_LAUNCH
#define ONE_LAUNCH 1
#endif
extern "C" void kernel_launch(void* const* d_in, const int* in_sizes, int n_in, void* d_out, int out_size, void* d_ws, size_t ws_size, hipStream_t stream) {
    static int grid = 0;
    if (grid == 0) {
        if (n_in != 33 || out_size != NLAT * D || ws_size < WS_END) { fprintf(stderr, "kernel_launch: unexpected problem: n_in %d out %d ws %zu (need %zu)\n", n_in, out_size, ws_size, (size_t)WS_END); grid = -1; return; }
        int dev = 0, cus = 0, per_cu = 0;
        if (hipGetDevice(&dev) != hipSuccess || hipDeviceGetAttribute(&cus, hipDeviceAttributeMultiprocessorCount, dev) != hipSuccess) { grid = -1; return; }
        if (hipFuncSetAttribute((const void*)trunk_fwd, hipFuncAttributeMaxDynamicSharedMemorySize, LDS_BYTES) != hipSuccess) { fprintf(stderr, "kernel_launch: hipFuncSetAttribute failed\n"); grid = -1; return; }
        if (hipOccupancyMaxActiveBlocksPerMultiprocessor(&per_cu, (const void*)trunk_fwd, 512, LDS_BYTES) != hipSuccess || per_cu < 1) fprintf(stderr, "kernel_launch: occupancy query says %d\n", per_cu);
        (void)hipGetLastError();
        grid = cus;
    }
    if (grid < 0) return;
    if (hipMemsetAsync((char*)d_ws + WS_CTL, 0, CTL_ZERO_BYTES, stream) != hipSuccess) return;
    Args a{};
    for (int i = 0; i < 33; ++i) a.in[i] = (const float*)d_in[i];
    a.out = (float*)d_out; a.ws = (unsigned char*)d_ws; a.pad0 = 0; a.pad1 = 0;
#if ONE_LAUNCH
    a.lo = 0; a.hi = NSEG;
    hipLaunchKernelGGL(trunk_fwd, dim3(grid), dim3(512), LDS_BYTES, stream, a);
#else
    for (int s = 0; s < NSEG; ++s) { a.lo = s; a.hi = s + 1; hipLaunchKernelGGL(trunk_fwd, dim3(grid), dim3(512), LDS_BYTES, stream, a); }
#endif
}
```

```cpp
#include <hip/hip_runtime.h>
#include <cstdio>
#include <cstdint>

#define LAS __attribute__((address_space(3)))
#define GAS __attribute__((address_space(1)))
typedef unsigned short bf16_t;
typedef short bf16x8 __attribute__((ext_vector_type(8)));
typedef float f32x4 __attribute__((ext_vector_type(4)));
typedef float f32x2 __attribute__((ext_vector_type(2)));
typedef unsigned u32x4 __attribute__((ext_vector_type(4)));
typedef unsigned u32x2 __attribute__((ext_vector_type(2)));

constexpr int D = 1024, NB = 4, SEQ = 8192, CTXL = 256, DEPTH = 4;
constexpr int NLAT = NB * SEQ, NCTX = NB * CTXL, MT = NLAT + NCTX;
constexpr int GRIDW = 64, GROWS = SEQ / GRIDW;
constexpr int NAH = 16, NAHD = 64;
constexpr int MLI = 2048, MLH = 4, MLHD = 512, MLCH = 64;
constexpr int FFD = 2816, NEXP = 8, FFE = 3584;
constexpr float NORM_EPS = 1e-6f;
constexpr int NMODV = 8;

__device__ __forceinline__ float bf_lo(unsigned w) { return __uint_as_float(w << 16); }
__device__ __forceinline__ float bf_hi(unsigned w) { return __uint_as_float(w & 0xffff0000u); }
__device__ __forceinline__ float bf2f(bf16_t b) { return __uint_as_float(((unsigned)b) << 16); }
__device__ __forceinline__ unsigned cvt_pk_bf16(float lo, float hi) { unsigned r; asm volatile("v_cvt_pk_bf16_f32 %0, %1, %2" : "=v"(r) : "v"(lo), "v"(hi)); return r; }
__device__ __forceinline__ bf16_t f2bf(float f) { return (bf16_t)(cvt_pk_bf16(f, 0.f) & 0xffffu); }
__device__ __forceinline__ float fast_rcp(float x) { return __builtin_amdgcn_rcpf(x); }
__device__ __forceinline__ float silu_f(float x) { return x * fast_rcp(1.0f + __expf(-x)); }
template <int CTRL, int RMASK> __device__ __forceinline__ float dpp_get(float src) { return __builtin_bit_cast(float, __builtin_amdgcn_update_dpp(0, __builtin_bit_cast(int, src), CTRL, RMASK, 0xF, false)); }
__device__ __forceinline__ float wave_sum(float v) {
    v += dpp_get<0xB1, 0xF>(v);
    v += dpp_get<0x4E, 0xF>(v);
    v += dpp_get<0x141, 0xF>(v);
    v += dpp_get<0x140, 0xF>(v);
    v += dpp_get<0x142, 0xA>(v);
    v += dpp_get<0x143, 0xC>(v);
    return __builtin_bit_cast(float, __builtin_amdgcn_readlane(__builtin_bit_cast(int, v), 63));
}
__device__ __forceinline__ int row_cond(int row) { return row < NLAT ? (row >> 13) : 4; }

namespace pg8 {
constexpr int BM = 256, BK = 64, HALF = 128, HTB = HALF * BK * 2, STAGE_BYTES = 8 * HTB, NXCD = 8, WGM = 8;
__host__ __device__ __forceinline__ int lds_byte(int r, int c) { const int st = (r >> 4) * 2 + (c >> 5), rr = r & 15, cc = c & 31, ob = rr * 64 + cc * 2; return st * 1024 + (ob ^ (((ob >> 9) & 1) << 5)); }
__host__ __device__ __forceinline__ void stage_rc(int b, int& R, int& C) { const int st = b / 1024, sb = b % 1024, swz = sb ^ (((sb >> 9) & 1) << 5); R = (st >> 1) * 16 + swz / 64; C = (st & 1) * 32 + (swz % 64) / 2; }
__host__ __device__ __forceinline__ int perm32(int rho) { const int n = rho >> 4, i = rho & 15; return 8 * (i >> 2) + 4 * n + (i & 3); }

struct Unit {
    const char* a;
    const char* b;
    const int* rows;
    int nrows;
    int orow, ocol;
    int aux;
};
__device__ __forceinline__ bool tile_order(int i, int G, int c, int nM, int nN, int& pm, int& pn) {
    const int nwg = nM * nN; const long L = (long)i * G + c; if (L >= nwg) return false;
    int wgid = (int)L; { const int q = nwg / NXCD, r = nwg % NXCD, xcd = wgid % NXCD, off = wgid / NXCD; wgid = (xcd < r ? xcd * (q + 1) : r * (q + 1) + (xcd - r) * q) + off; }
    const int nig = WGM * nN, gid = wgid / nig, fm = gid * WGM, gsz = (nM - fm) < WGM ? (nM - fm) : WGM;
    pm = fm + ((wgid % nig) % gsz); pn = (wgid % nig) / gsz; return true;
}
struct PlainOrder {
    const bf16_t* A; const bf16_t* Bt; int lda, ldb, nM, nN, G, c, a_pn, ocol_step, pm0;
    __device__ __forceinline__ bool next(int i, Unit& u) const {
        int pm, pn; if (!tile_order(i, G, c, nM, nN, pm, pn)) return false;
        pm += pm0;
        u.a = (const char*)(A + (size_t)pm * BM * lda + (size_t)pn * a_pn); u.b = (const char*)(Bt + (size_t)pn * BM * ldb);
        u.rows = nullptr; u.nrows = 256; u.orow = pm * BM; u.ocol = pn * ocol_step; u.aux = row_cond(pm * BM); return true;
    }
};

struct EpiBf16 {
    static constexpr bool PERM = true;
    bf16_t* O; int ldc; const float* bias; int split_cols; size_t split_stride;
    __device__ __forceinline__ void operator()(const f32x4 (&acc)[2][2][4][2], const Unit& u, int wr, int wc, int fr, int fq) const {
        const int row0 = u.orow + wr * 64 + fr; int colt = u.ocol; bf16_t* base = O;
        if (split_cols) { const int t = colt / split_cols; base += (size_t)t * split_stride; colt -= t * split_cols; }
        const int col0 = colt + wc * 32 + 8 * fq, bcol0 = u.ocol + wc * 32 + 8 * fq;
        f32x4 bv[2][2];
#pragma unroll
        for (int bj = 0; bj < 2; ++bj)
#pragma unroll
            for (int n = 0; n < 2; ++n) bv[bj][n] = bias ? *(const f32x4*)(bias + bcol0 + bj * HALF + 4 * n) : (f32x4){0.f, 0.f, 0.f, 0.f};
#pragma unroll
        for (int ai = 0; ai < 2; ++ai)
#pragma unroll
            for (int m = 0; m < 4; ++m) { bf16_t* rowp = base + (size_t)(row0 + ai * HALF + m * 16) * ldc + col0;
#pragma unroll
                for (int bj = 0; bj < 2; ++bj) { const f32x4 v0 = acc[ai][bj][m][0] + bv[bj][0], v1 = acc[ai][bj][m][1] + bv[bj][1];
                    u32x4 w; w.x = cvt_pk_bf16(v0[0], v0[1]); w.y = cvt_pk_bf16(v0[2], v0[3]); w.z = cvt_pk_bf16(v1[0], v1[1]); w.w = cvt_pk_bf16(v1[2], v1[3]);
                    *(u32x4*)(rowp + bj * HALF) = w; } }
    }
};
struct EpiSwiglu {
    static constexpr bool PERM = true;
    bf16_t* T; int ldc;
    __device__ __forceinline__ void operator()(const f32x4 (&acc)[2][2][4][2], const Unit& u, int wr, int wc, int fr, int fq) const {
        const int row0 = u.orow + wr * 64 + fr, col0 = u.ocol + wc * 32 + 8 * fq;
#pragma unroll
        for (int ai = 0; ai < 2; ++ai)
#pragma unroll
            for (int m = 0; m < 4; ++m) { bf16_t* rowp = T + (size_t)(row0 + ai * HALF + m * 16) * ldc + col0;
                float t[8];
#pragma unroll
                for (int n = 0; n < 2; ++n)
#pragma unroll
                    for (int j = 0; j < 4; ++j) t[n * 4 + j] = silu_f(acc[ai][0][m][n][j]) * acc[ai][1][m][n][j];
                u32x4 w; w.x = cvt_pk_bf16(t[0], t[1]); w.y = cvt_pk_bf16(t[2], t[3]); w.z = cvt_pk_bf16(t[4], t[5]); w.w = cvt_pk_bf16(t[6], t[7]);
                *(u32x4*)rowp = w; }
    }
};
typedef int v8i32 __attribute__((ext_vector_type(8)));
struct EpiSwigluF8 {
    static constexpr bool PERM = true;
    unsigned char* T; int ldc; float ascale, oscale; int dry;
    __device__ __forceinline__ void operator()(const f32x4 (&acc)[2][2][4][2], const Unit& u, int wr, int wc, int fr, int fq) const {
        if (dry) { float k = 0.f;
#pragma unroll
            for (int ai = 0; ai < 2; ++ai)
#pragma unroll
                for (int bj = 0; bj < 2; ++bj)
#pragma unroll
                    for (int m = 0; m < 4; ++m)
#pragma unroll
                        for (int n = 0; n < 2; ++n) k += acc[ai][bj][m][n][0];
            if (k == 1.2345e30f) T[0] = 1; return; }
        const int row0 = u.orow + wr * 64 + fr, col0 = u.ocol + wc * 32 + 8 * fq;
#pragma unroll
        for (int ai = 0; ai < 2; ++ai)
#pragma unroll
            for (int m = 0; m < 4; ++m) { unsigned char* rowp = T + (size_t)(row0 + ai * HALF + m * 16) * ldc + col0;
                float t[8];
                const float kexp = -1.4426950408889634f * ascale, knum = ascale * ascale * oscale;
#pragma unroll
                for (int n = 0; n < 2; ++n)
#pragma unroll
                    for (int jp = 0; jp < 2; ++jp) { const f32x2 u2 = (f32x2){acc[ai][0][m][n][2 * jp], acc[ai][0][m][n][2 * jp + 1]}, v2 = (f32x2){acc[ai][1][m][n][2 * jp], acc[ai][1][m][n][2 * jp + 1]};
                        const f32x2 ea = u2 * kexp; f32x2 d2 = (f32x2){__builtin_amdgcn_exp2f(ea[0]), __builtin_amdgcn_exp2f(ea[1])}; d2 = d2 + 1.0f;
                        const f32x2 r2 = (f32x2){fast_rcp(d2[0]), fast_rcp(d2[1])}; const f32x2 t2 = ((u2 * v2) * knum) * r2;
                        t[n * 4 + 2 * jp] = __builtin_amdgcn_fmed3f(t2[0], -448.f, 448.f); t[n * 4 + 2 * jp + 1] = __builtin_amdgcn_fmed3f(t2[1], -448.f, 448.f); }
                u32x2 w; int p0 = __builtin_amdgcn_cvt_pk_fp8_f32(t[0], t[1], 0, false); p0 = __builtin_amdgcn_cvt_pk_fp8_f32(t[2], t[3], p0, true);
                int p1 = __builtin_amdgcn_cvt_pk_fp8_f32(t[4], t[5], 0, false); p1 = __builtin_amdgcn_cvt_pk_fp8_f32(t[6], t[7], p1, true);
                w.x = (unsigned)p0; w.y = (unsigned)p1; *(u32x2*)rowp = w; }
    }
};
struct EpiBf16S {
    static constexpr bool PERM = true;
    bf16_t* O; int ldc; float ascale;
    __device__ __forceinline__ void operator()(const f32x4 (&acc)[2][2][4][2], const Unit& u, int wr, int wc, int fr, int fq) const {
        const int row0 = u.orow + wr * 64 + fr, col0 = u.ocol + wc * 32 + 8 * fq;
#pragma unroll
        for (int ai = 0; ai < 2; ++ai)
#pragma unroll
            for (int m = 0; m < 4; ++m) { bf16_t* rowp = O + (size_t)(row0 + ai * HALF + m * 16) * ldc + col0;
#pragma unroll
                for (int bj = 0; bj < 2; ++bj) { const f32x4 v0 = acc[ai][bj][m][0] * ascale, v1 = acc[ai][bj][m][1] * ascale;
                    u32x4 w; w.x = cvt_pk_bf16(v0[0], v0[1]); w.y = cvt_pk_bf16(v0[2], v0[3]); w.z = cvt_pk_bf16(v1[0], v1[1]); w.w = cvt_pk_bf16(v1[2], v1[3]);
                    *(u32x4*)(rowp + bj * HALF) = w; } }
    }
};
struct EpiRes {
    static constexpr bool PERM = false;
    bf16_t* H; const float* gs; const float* gb; int cstride; int dry; const float* in_lat; const float* in_ctx; float sc = 1.0f;
    __device__ __forceinline__ void operator()(const f32x4 (&acc)[2][2][4][2], const Unit& u, int wr, int wc, int fr, int fq) const {
        const int row0 = u.orow + wr * 64 + fr, col0 = u.ocol + wc * 32 + 4 * fq;
        const float* gsc = gs + (size_t)u.aux * cstride + col0; const float* gbc = gb ? gb + (size_t)u.aux * cstride + col0 : nullptr;
        f32x4 gv[2][2], bv[2][2]; const float dscale = dry ? 0.f : 1.f;
#pragma unroll
        for (int bj = 0; bj < 2; ++bj)
#pragma unroll
            for (int n = 0; n < 2; ++n) { gv[bj][n] = *(const f32x4*)(gsc + bj * HALF + n * 16) * sc; bv[bj][n] = gbc ? *(const f32x4*)(gbc + bj * HALF + n * 16) : (f32x4){0.f, 0.f, 0.f, 0.f}; }
        if (in_lat) {
#pragma unroll
            for (int am = 0; am < 4; ++am) { const int ai = am >> 1, m0 = 2 * (am & 1); f32x4 hv[2][2][2];
#pragma unroll
                for (int mm = 0; mm < 2; ++mm) { const int row = row0 + ai * HALF + (m0 + mm) * 16; const float* srcp = u.orow < NLAT ? in_lat + (size_t)row * D + col0 : in_ctx + (size_t)(row - NLAT) * D + col0;
#pragma unroll
                    for (int bj = 0; bj < 2; ++bj)
#pragma unroll
                        for (int n = 0; n < 2; ++n) hv[mm][bj][n] = *(const f32x4*)(srcp + bj * HALF + n * 16); }
#pragma unroll
                for (int mm = 0; mm < 2; ++mm) { bf16_t* rowp = H + (size_t)(row0 + ai * HALF + (m0 + mm) * 16) * D + col0;
#pragma unroll
                    for (int bj = 0; bj < 2; ++bj)
#pragma unroll
                        for (int n = 0; n < 2; ++n) { const f32x4 h = hv[mm][bj][n] + (gv[bj][n] * acc[ai][bj][m0 + mm][n] + bv[bj][n]) * dscale;
                            u32x2 ow; ow.x = cvt_pk_bf16(h[0], h[1]); ow.y = cvt_pk_bf16(h[2], h[3]); *(u32x2*)(rowp + bj * HALF + n * 16) = ow; } }
                asm volatile("" ::: "memory"); }
        } else {
#pragma unroll
            for (int ai = 0; ai < 2; ++ai) { u32x2 hw[4][2][2];
#pragma unroll
                for (int m = 0; m < 4; ++m) { const bf16_t* rowp = H + (size_t)(row0 + ai * HALF + m * 16) * D + col0;
#pragma unroll
                    for (int bj = 0; bj < 2; ++bj)
#pragma unroll
                        for (int n = 0; n < 2; ++n) hw[m][bj][n] = *(const u32x2*)(rowp + bj * HALF + n * 16); }
#pragma unroll
                for (int m = 0; m < 4; ++m) { bf16_t* rowp = H + (size_t)(row0 + ai * HALF + m * 16) * D + col0;
#pragma unroll
                    for (int bj = 0; bj < 2; ++bj)
#pragma unroll
                        for (int n = 0; n < 2; ++n) { const u32x2 w_ = hw[m][bj][n]; f32x4 h = (f32x4){bf_lo(w_.x), bf_hi(w_.x), bf_lo(w_.y), bf_hi(w_.y)}; h = h + (gv[bj][n] * acc[ai][bj][m][n] + bv[bj][n]) * dscale;
                            u32x2 ow; ow.x = cvt_pk_bf16(h[0], h[1]); ow.y = cvt_pk_bf16(h[2], h[3]); *(u32x2*)(rowp + bj * HALF + n * 16) = ow; } }
                asm volatile("" ::: "memory"); }
        }
    }
};

template <class Epi, class Sched, bool GATHER, bool FP8 = false>
__device__ __forceinline__ void gemm_phase(LAS unsigned char* lds, const int wave_in, const int lda, const int ldb, const int K, const Sched& S, const Epi& E) {
    int tid = wave_in * 64 + (int)__builtin_amdgcn_mbcnt_hi(~0u, __builtin_amdgcn_mbcnt_lo(~0u, 0u)); asm volatile("" : "+v"(tid));
    const int wid = __builtin_amdgcn_readfirstlane(tid >> 6), lane = tid & 63, wr = wid >> 2, wc = wid & 3, fr = lane & 15, fq = lane >> 4;
    const int nt = K / BK;
    unsigned voffA[2], voffB[2];
#pragma unroll
    for (int i = 0; i < 2; ++i) { int R, C; stage_rc(tid * 16 + i * 8192, R, C); const int Rb = Epi::PERM ? ((R & ~31) + perm32(R & 31)) : R;
        voffA[i] = (unsigned)(R * lda + C) * 2u; voffB[i] = (unsigned)(Rb * ldb + C) * 2u; }
    const size_t kstep = (size_t)(BK * 2);
    const size_t hstepA = GATHER ? (size_t)0 : (size_t)HALF * lda * 2, hstepB = (size_t)HALF * ldb * 2;
    const unsigned ldsw = (unsigned)wid * 1024u;
    const int aoff = lds_byte(wr * 64 + fr, fq * 8), boff = lds_byte(wc * 32 + fr, fq * 8);
#define PG8_SA(b, h) (((b) * 2 + (h)) * HTB)
#define PG8_SB(b, h) ((4 + (b) * 2 + (h)) * HTB)
#define PG8_STAGE(bufoff, gbase, voff) do { _Pragma("unroll") for (int _i = 0; _i < 2; ++_i) \
        __builtin_amdgcn_global_load_lds((const unsigned*)((const char*)(gbase) + (voff)[_i]), (LAS unsigned*)(lds + (bufoff) + ldsw + _i * 8192), 16, 0, 0); } while (0)
#define PG8_LD8(p_) ({ const u32x4 lo_ = *(const LAS u32x4*)(p_), hi_ = *(const LAS u32x4*)((p_) + 1024); (v8i32){(int)lo_.x, (int)lo_.y, (int)lo_.z, (int)lo_.w, (int)hi_.x, (int)hi_.y, (int)hi_.z, (int)hi_.w}; })
#define PG8_LDA(dst, b, h) do { if constexpr (FP8) { _Pragma("unroll") for (int m = 0; m < 4; ++m) dst##8[m] = PG8_LD8(lds + PG8_SA(b, h) + aoff + m * 2048); } \
        else { _Pragma("unroll") for (int m = 0; m < 4; ++m) _Pragma("unroll") for (int k = 0; k < 2; ++k) dst[m][k] = *(const LAS bf16x8*)(lds + PG8_SA(b, h) + aoff + m * 2048 + k * 1024); } } while (0)
#define PG8_LDB(dst, b, h) do { if constexpr (FP8) { _Pragma("unroll") for (int n = 0; n < 2; ++n) dst##8[n] = PG8_LD8(lds + PG8_SB(b, h) + boff + n * 2048); } \
        else { _Pragma("unroll") for (int n = 0; n < 2; ++n) _Pragma("unroll") for (int k = 0; k < 2; ++k) dst[n][k] = *(const LAS bf16x8*)(lds + PG8_SB(b, h) + boff + n * 2048 + k * 1024); } } while (0)
#define PG8_MMA(ai, bj, At, Bt) do { __builtin_amdgcn_s_setprio(1); _Pragma("unroll") for (int m = 0; m < 4; ++m) _Pragma("unroll") for (int n = 0; n < 2; ++n) { \
        if constexpr (FP8) asm volatile("s_nop 1\n\tv_mfma_scale_f32_16x16x128_f8f6f4 %0, %1, %2, %0, %3, %3 op_sel_hi:[0,0,0]" : "+v"(acc[ai][bj][m][n]) : "v"(Bt##8[n]), "v"(At##8[m]), "v"(f8one)); \
        else { _Pragma("unroll") for (int k = 0; k < 2; ++k) acc[ai][bj][m][n] = __builtin_amdgcn_mfma_f32_16x16x32_bf16(Bt[n][k], At[m][k], acc[ai][bj][m][n], 0, 0, 0); } } \
        __builtin_amdgcn_s_setprio(0); } while (0)
#define PG8_WAIT_V(n) asm volatile("s_waitcnt vmcnt(" #n ")" ::: "memory")
#define PG8_WAIT_L(n) asm volatile("s_waitcnt lgkmcnt(" #n ")" ::: "memory")
#define PG8_BAR __builtin_amdgcn_s_barrier()
#define PG8_SCHED __builtin_amdgcn_sched_barrier(0)
#define PG8_GOFF(dst, un) do { _Pragma("unroll") for (int _h = 0; _h < 2; ++_h) _Pragma("unroll") for (int _i = 0; _i < 2; ++_i) { int _R, _C; stage_rc(tid * 16 + _i * 8192, _R, _C); const int _s = _h * HALF + _R; \
        const int _r = (_s < (un).nrows) ? (un).rows[_s] : 0; dst[_h][_i] = (unsigned)_r * (unsigned)(lda * 2) + (unsigned)_C * 2u; } \
        asm volatile("" : "+v"(dst[0][0]), "+v"(dst[0][1]), "+v"(dst[1][0]), "+v"(dst[1][1])); } while (0)
    Unit cur, nxt; int ui = 0;
    if (!S.next(0, cur)) return;
#ifdef GEMM_STAGGER
    { const int sg = (blockIdx.x >> 3) & 3; for (int i = 0; i < sg; ++i) __builtin_amdgcn_s_sleep(GEMM_STAGGER); }
#endif
    f32x4 acc[2][2][4][2];
#pragma unroll
    for (int a = 0; a < 2; ++a)
#pragma unroll
        for (int b = 0; b < 2; ++b)
#pragma unroll
            for (int m = 0; m < 4; ++m)
#pragma unroll
                for (int n = 0; n < 2; ++n) acc[a][b][m][n] = (f32x4){0.f, 0.f, 0.f, 0.f};
    bf16x8 At[4][2], B0[2][2], B1[2][2]; v8i32 At8[4], B08[2], B18[2];
    const int f8one = 0x7f7f7f7f;
    unsigned oC[2][2];
    LAS u32x4* oNl = (LAS u32x4*)(lds + STAGE_BYTES) + tid;
    if constexpr (GATHER) { PG8_GOFF(oC, cur); }
    else {
#pragma unroll
        for (int h = 0; h < 2; ++h)
#pragma unroll
            for (int i = 0; i < 2; ++i) oC[h][i] = voffA[i];
    }
    const char* cA = cur.a; const char* cB = cur.b;
    PG8_STAGE(PG8_SB(0, 0), cB, voffB); PG8_STAGE(PG8_SB(0, 1), cB + hstepB, voffB); PG8_STAGE(PG8_SA(0, 0), cA, oC[0]); PG8_STAGE(PG8_SA(0, 1), cA + hstepA, oC[1]);
    if (wr == 1) PG8_BAR;
    PG8_WAIT_V(2); PG8_BAR;
    PG8_STAGE(PG8_SB(1, 0), cB + kstep, voffB); PG8_STAGE(PG8_SA(1, 0), cA + kstep, oC[0]); PG8_STAGE(PG8_SB(1, 1), cB + hstepB + kstep, voffB);
    PG8_WAIT_V(6); PG8_BAR;
    for (;;) {
        const bool has_next = S.next(ui + 1, nxt);
        if constexpr (GATHER) { unsigned oN[2][2]; if (has_next) { PG8_GOFF(oN, nxt); } else {
#pragma unroll
            for (int h = 0; h < 2; ++h)
#pragma unroll
                for (int i = 0; i < 2; ++i) oN[h][i] = oC[h][i]; }
            *oNl = (u32x4){oN[0][0], oN[0][1], oN[1][0], oN[1][1]}; }
        const char* nA = has_next ? nxt.a : cA; const char* nB = has_next ? nxt.b : cB;
        for (int t = 0; t < nt; t += 2) {
            const bool last = (t == nt - 2);
            const char* a1 = cA + (size_t)(t + 1) * kstep;
            const char* a2 = last ? nA : cA + (size_t)(t + 2) * kstep; const char* b2 = last ? nB : cB + (size_t)(t + 2) * kstep;
            const char* a3 = a2 + kstep; const char* b3 = b2 + kstep;
            PG8_LDB(B0, 0, 0); PG8_LDB(B1, 0, 1); PG8_SCHED; PG8_LDA(At, 0, 0); PG8_STAGE(PG8_SA(1, 1), a1 + hstepA, oC[1]);
            if constexpr (GATHER) { if (last) { const u32x4 t4 = *oNl; oC[0][0] = t4.x; oC[0][1] = t4.y; oC[1][0] = t4.z; oC[1][1] = t4.w; } }
            PG8_WAIT_V(8); PG8_WAIT_L(0); PG8_BAR; PG8_MMA(0, 0, At, B0); PG8_MMA(0, 1, At, B1); PG8_BAR; PG8_SCHED;
            PG8_LDA(At, 0, 1); PG8_STAGE(PG8_SB(0, 0), b2, voffB); PG8_STAGE(PG8_SB(0, 1), b2 + hstepB, voffB); PG8_STAGE(PG8_SA(0, 0), a2, oC[0]);
            PG8_WAIT_V(8); PG8_WAIT_L(0); PG8_BAR; PG8_MMA(1, 0, At, B0); PG8_MMA(1, 1, At, B1); PG8_BAR; PG8_SCHED;
            PG8_LDB(B0, 1, 0); PG8_LDB(B1, 1, 1); PG8_SCHED; PG8_LDA(At, 1, 0); PG8_STAGE(PG8_SA(0, 1), a2 + hstepA, oC[1]);
            PG8_WAIT_V(8); PG8_WAIT_L(0); PG8_BAR; PG8_MMA(0, 0, At, B0); PG8_MMA(0, 1, At, B1); PG8_BAR; PG8_SCHED;
            PG8_LDA(At, 1, 1); PG8_STAGE(PG8_SB(1, 0), b3, voffB); PG8_STAGE(PG8_SB(1, 1), b3 + hstepB, voffB); PG8_STAGE(PG8_SA(1, 0), a3, oC[0]);
            PG8_WAIT_V(8); PG8_WAIT_L(0); PG8_BAR; PG8_MMA(1, 0, At, B0); PG8_MMA(1, 1, At, B1); PG8_BAR; PG8_SCHED;
        }
#ifndef GEMM_NOALIGN
        if (wr == 0) PG8_BAR;
#endif
        E(acc, cur, wr, wc, fr, fq);
        if (!has_next) break;
#pragma unroll
        for (int a = 0; a < 2; ++a)
#pragma unroll
            for (int b = 0; b < 2; ++b)
#pragma unroll
                for (int m = 0; m < 4; ++m)
#pragma unroll
                    for (int n = 0; n < 2; ++n) acc[a][b][m][n] = (f32x4){0.f, 0.f, 0.f, 0.f};
        cur = nxt; cA = nA; cB = nB; ++ui;
#ifndef GEMM_NOALIGN
        if (wr == 1) PG8_BAR;
#endif
    }
    PG8_WAIT_V(0);
#ifdef GEMM_NOALIGN
    if (wr == 0) PG8_BAR;
#endif
    PG8_BAR;
#undef PG8_SA
#undef PG8_SB
#undef PG8_STAGE
#undef PG8_LDA
#undef PG8_LDB
#undef PG8_MMA
#undef PG8_LD8
#undef PG8_WAIT_V
#undef PG8_WAIT_L
#undef PG8_BAR
#undef PG8_SCHED
#undef PG8_GOFF
}
}
constexpr size_t MiB = (size_t)1 << 20;
constexpr size_t WS_CTL = 0, CTL_ZERO_BYTES = 1 * MiB;
constexpr size_t WS_MOD = 1 * MiB;
constexpr size_t WS_WGT = 2 * MiB;
constexpr size_t WS_LIST = 3 * MiB;
constexpr size_t WS_POS = 5 * MiB;
constexpr size_t WS_GATE = 6 * MiB;
constexpr size_t WS_H = 8 * MiB;
constexpr size_t WS_WQKV = 140 * MiB, WS_WOUT = 152 * MiB, WS_WPOOL = 156 * MiB, WS_WUP = 157 * MiB, WS_WDOWN = 165 * MiB, WS_WF13 = 169 * MiB, WS_WF2 = 191 * MiB;
constexpr size_t WS_A = 202 * MiB;
constexpr size_t WS_R = 268 * MiB;
constexpr size_t WS_Q = WS_R, WS_K = WS_R + 66 * MiB, WS_V = WS_R + 132 * MiB, WS_O = WS_R + 198 * MiB;
constexpr size_t WS_T = WS_R;
constexpr size_t WS_PL = WS_R;
constexpr size_t WS_XM = WS_R, WS_Z = WS_R + 132 * MiB, WS_XC = WS_R + 264 * MiB, WS_GT = WS_R + 396 * MiB, WS_HF = WS_R + 399 * MiB, WS_HB = WS_R + 531 * MiB, WS_OA = WS_XM;
constexpr size_t WS_MT = WS_R, WS_MY = WS_R + 238 * MiB, WS_AG = WS_R + 374 * MiB, WS_WM13 = 778 * MiB, WS_WM2 = 890 * MiB;
constexpr size_t WS_END = 964 * MiB;
constexpr int MOE_CH = 136;
static_assert(WS_HB + 132 * MiB <= WS_END && WS_WM2 + 56 * MiB <= WS_END && WS_MY + 136 * MiB <= WS_AG && WS_AG + 136 * MiB <= WS_WM13, "ws map");
constexpr int CW_BAR = 4096;
constexpr int CW_CNT = 1024;

constexpr int LDS_BYTES = 163840;
constexpr int MISC_OFF = LDS_BYTES - 256;

#define RLX_AGENT __ATOMIC_RELAXED, __HIP_MEMORY_SCOPE_AGENT
#define LDS_WAIT() asm volatile("s_waitcnt lgkmcnt(0)" ::: "memory")
#define VM_WAIT() asm volatile("s_waitcnt vmcnt(0)" ::: "memory")

#define XB_TMO      128
#define XB_XCNT(j)  (256  + 64 * (j))
#define XB_XSUB(j)  (1280 + 64 * (j))
#define XB_XGEN(j)  (2304 + 64 * (j))
#define XB_TOP      3328
#define XB_TOPGEN   3392
#define XCD_BAR_WORDS 3456
#define XB_SPIN_CAP (1u << 20)
__device__ __forceinline__ unsigned xb_ld(unsigned* p)              { return __hip_atomic_load(p, __ATOMIC_RELAXED, __HIP_MEMORY_SCOPE_AGENT); }
__device__ __forceinline__ unsigned xb_add(unsigned* p, unsigned v) { return __hip_atomic_fetch_add(p, v, __ATOMIC_RELAXED, __HIP_MEMORY_SCOPE_AGENT); }
__device__ __forceinline__ unsigned xb_xcc_id() { return (unsigned)__builtin_amdgcn_s_getreg((3 << 11) | 20) & 0xFu; }
#define XB_SPIN(cond, bar) do { unsigned _sp = 0; while (cond) { __builtin_amdgcn_s_sleep(1); \
    if ((++_sp & 255u) == 0u) { if (xb_ld(&(bar)[XB_TMO])) break; if (_sp > XB_SPIN_CAP) { atomicAdd(&(bar)[XB_TMO], 1u); break; } } } } while (0)
struct XcdBarrier { unsigned* bar; unsigned x; volatile LAS unsigned* st; int wave; };
__device__ __forceinline__ int xb_lane() { return (int)__builtin_amdgcn_mbcnt_hi(~0u, __builtin_amdgcn_mbcnt_lo(~0u, 0u)); }
__device__ __forceinline__ XcdBarrier xcd_barrier_post(unsigned* bar, volatile LAS unsigned* st) {
    XcdBarrier b; b.bar = bar; b.x = xb_xcc_id(); b.st = st; b.wave = __builtin_amdgcn_readfirstlane((int)(threadIdx.x >> 6));
    if (threadIdx.x == 0) (void)xb_add(&bar[XB_XCNT(b.x)], 1u);
    return b;
}
__device__ __forceinline__ void xcd_barrier_complete(unsigned* bar, unsigned x, unsigned& nloc, unsigned& nx) {
    const unsigned G = gridDim.x * gridDim.y * gridDim.z;
    unsigned sum, cnt, mine, sp = 0u;
    for (;;) {
        sum = 0u; cnt = 0u; mine = 0u;
#pragma unroll
        for (unsigned j = 0; j < 16; ++j) { const unsigned c = xb_ld(&bar[XB_XCNT(j)]); sum += c; cnt += (c > 0u) ? 1u : 0u; mine = (j == x) ? c : mine; }
        if (sum == G) break;
        __builtin_amdgcn_s_sleep(1);
        if ((++sp & 255u) == 0u) { if (xb_ld(&bar[XB_TMO])) break; if (sp > XB_SPIN_CAP) { atomicAdd(&bar[XB_TMO], 1u); break; } }
    }
    nloc = mine > 0u ? mine : 1u; nx = cnt > 0u ? cnt : 1u;
}
__device__ __forceinline__ void xcd_barrier(const XcdBarrier& b) {
    asm volatile("s_waitcnt vmcnt(0)" ::: "memory");
    __syncthreads();
    if (b.wave == 0 && xb_lane() == 0) {
        unsigned* bar = b.bar;
        __builtin_amdgcn_s_waitcnt(0);
        unsigned nloc = b.st[0], nx = b.st[1];
        if (nloc == 0u) { xcd_barrier_complete(bar, b.x, nloc, nx); b.st[0] = nloc; b.st[1] = nx; }
        const unsigned old = xb_add(&bar[XB_XSUB(b.x)], 1u);
        const unsigned gen = old / nloc;
        if (old + 1u == (gen + 1u) * nloc) {
            __builtin_amdgcn_fence(__ATOMIC_RELEASE, "agent");
            asm volatile("s_waitcnt vmcnt(0)" ::: "memory");
            const unsigned og = xb_add(&bar[XB_TOP], 1u);
            const unsigned tg = og / nx;
            if (og + 1u == (tg + 1u) * nx) xb_add(&bar[XB_TOPGEN], 1u);
            else XB_SPIN(xb_ld(&bar[XB_TOPGEN]) == tg, bar);
            __builtin_amdgcn_fence(__ATOMIC_ACQUIRE, "agent");
            xb_add(&bar[XB_XGEN(b.x)], 1u);
            asm volatile("s_waitcnt vmcnt(0)" ::: "memory");
        } else {
            XB_SPIN(xb_ld(&bar[XB_XGEN(b.x)]) == gen, bar);
            __builtin_amdgcn_fence(__ATOMIC_ACQUIRE, "agent");
            asm volatile("s_waitcnt vmcnt(0)" ::: "memory");
        }
    }
    __syncthreads();
}

struct Args { const float* in[33]; float* out; unsigned char* ws; int lo, hi, pad0, pad1; };
enum { I_X = 0, I_C, I_CTX, I_CCTX, I_WMOD, I_BMOD, I_NORMG, I_FINALG, I_NAWQKV, I_NABQKV, I_NARPB, I_NAWOUT, I_NABOUT, I_POOLW, I_POOLS, I_MLWUP, I_MLCONVW, I_MLCONVB,
       I_MLWQ, I_MLWK, I_MLWV, I_MLWG, I_MLBG, I_MLGN, I_MLSKIP, I_MLWDOWN, I_FW1, I_FW3, I_FW2, I_MROUTER, I_MW1, I_MW3, I_MW2 };

struct PArgs { const LAS unsigned long long* tab; float* out; unsigned char* ws;
    __device__ __forceinline__ const float* in(int i) const { const unsigned long long v = tab[i]; const unsigned lo = __builtin_amdgcn_readfirstlane((unsigned)v), hi = __builtin_amdgcn_readfirstlane((unsigned)(v >> 32));
        return (const float*)(const __attribute__((address_space(1))) float*)(((unsigned long long)hi << 32) | lo); } };
struct Ctx {
    LAS unsigned char* lds; int tid, lane, wave, G, bid;
};

__device__ __forceinline__ Ctx fresh_ctx(const Ctx& X0) {
    Ctx Y = X0; int t = X0.wave * 64 + (int)__builtin_amdgcn_mbcnt_hi(~0u, __builtin_amdgcn_mbcnt_lo(~0u, 0u)); asm volatile("" : "+v"(t)); Y.tid = t; Y.lane = t & 63; Y.wave = __builtin_amdgcn_readfirstlane(t >> 6); return Y;
}
__device__ __forceinline__ void conv_item(const float* W, int K, int N, bf16_t* WT, int mode, int half, LAS float* scr, int item, int lane) {
    const int nblk = N / 64, kb = item / nblk, nb = item % nblk, k0 = 64 * kb, n0 = 64 * nb;
    const float* src = W + (size_t)(k0 + (lane >> 4)) * N + n0 + 4 * (lane & 15);
    f32x4 v[16];
#pragma unroll
    for (int i = 0; i < 16; ++i) v[i] = *(const f32x4*)(src + (size_t)(4 * i) * N);
#pragma unroll
    for (int i = 0; i < 16; ++i) { LAS float* d = scr + (4 * i + (lane >> 4)) * 65 + 4 * (lane & 15); d[0] = v[i][0]; d[1] = v[i][1]; d[2] = v[i][2]; d[3] = v[i][3]; }
    LDS_WAIT(); asm volatile("" ::: "memory");
    const int c = lane & 7;
    float tv[8][8];
#pragma unroll
    for (int j = 0; j < 8; ++j) { const LAS float* sp = scr + (8 * c) * 65 + (lane >> 3) + 8 * j;
#pragma unroll
        for (int q = 0; q < 8; ++q) tv[j][q] = sp[q * 65]; }
#pragma unroll
    for (int j = 0; j < 8; ++j) { const int n = (lane >> 3) + 8 * j;
        const int nn = n0 + n; const int drow = mode ? ((nn >> 7) * 256 + (nn & 127) + 128 * half) : nn;
        u32x4 o; o.x = cvt_pk_bf16(tv[j][0], tv[j][1]); o.y = cvt_pk_bf16(tv[j][2], tv[j][3]); o.z = cvt_pk_bf16(tv[j][4], tv[j][5]); o.w = cvt_pk_bf16(tv[j][6], tv[j][7]);
        *(u32x4*)(WT + (size_t)drow * K + k0 + 8 * c) = o; }
    LDS_WAIT(); asm volatile("" ::: "memory");
}
__device__ __forceinline__ void conv_item_f8(const float* W, int K, int N, unsigned char* WT, int mode, int half, float scale, LAS float* scr, int item, int lane) {
    const int nblk = N / 64, kb = item / nblk, nb = item % nblk, k0 = 64 * kb, n0 = 64 * nb;
    const float* src = W + (size_t)(k0 + (lane >> 4)) * N + n0 + 4 * (lane & 15);
    f32x4 v[16];
#pragma unroll
    for (int i = 0; i < 16; ++i) v[i] = *(const f32x4*)(src + (size_t)(4 * i) * N);
#pragma unroll
    for (int i = 0; i < 16; ++i) { LAS float* d = scr + (4 * i + (lane >> 4)) * 65 + 4 * (lane & 15); d[0] = v[i][0]; d[1] = v[i][1]; d[2] = v[i][2]; d[3] = v[i][3]; }
    LDS_WAIT(); asm volatile("" ::: "memory");
    const int c = lane & 3;
    float tv[4][16];
#pragma unroll
    for (int j = 0; j < 4; ++j) { const LAS float* sp = scr + (16 * c) * 65 + (lane >> 2) + 16 * j;
#pragma unroll
        for (int q = 0; q < 16; ++q) tv[j][q] = sp[q * 65]; }
#pragma unroll
    for (int j = 0; j < 4; ++j) { const int n = (lane >> 2) + 16 * j;
        const int nn = n0 + n; const int drow = mode ? ((nn >> 7) * 256 + (nn & 127) + 128 * half) : nn;
        u32x4 o;
#pragma unroll
        for (int q = 0; q < 4; ++q) { float w4[4];
#pragma unroll
            for (int r = 0; r < 4; ++r) w4[r] = __builtin_fminf(__builtin_fmaxf(tv[j][4 * q + r] * scale, -448.f), 448.f);
            int pk = __builtin_amdgcn_cvt_pk_fp8_f32(w4[0], w4[1], 0, false); pk = __builtin_amdgcn_cvt_pk_fp8_f32(w4[2], w4[3], pk, true); o[q] = (unsigned)pk; }
        *(u32x4*)(WT + (size_t)drow * K + k0 + 16 * c) = o; }
    LDS_WAIT(); asm volatile("" ::: "memory");
}
constexpr float F8_SW1 = 32.0f, F8_SW2 = 64.0f, F8_ST = 2.0f, F8_SWD = 64.0f;
struct ConvDesc { const float* W; bf16_t* WT; int K, N, mode, half; };
__device__ __forceinline__ ConvDesc conv_desc_base(const PArgs& a, int mi) {
    unsigned char* ws = a.ws; ConvDesc d;
    if (mi < 2)       { const int j = mi;      d = ConvDesc{a.in(I_NAWQKV) + (size_t)j * D * 3 * D, (bf16_t*)(ws + WS_WQKV) + (size_t)j * 3 * D * D, D, 3 * D, 0, 0}; }
    else if (mi < 4)  { const int j = mi - 2;  d = ConvDesc{a.in(I_NAWOUT) + (size_t)j * D * D, (bf16_t*)(ws + WS_WOUT) + (size_t)j * D * D, D, D, 0, 0}; }
    else if (mi < 6)  { const int j = mi - 4;  d = ConvDesc{a.in(I_FW1) + (size_t)j * D * FFD, (bf16_t*)(ws + WS_WF13) + (size_t)j * 2 * FFD * D, D, FFD, 1, 0}; }
    else if (mi < 8)  { const int j = mi - 6;  d = ConvDesc{a.in(I_FW3) + (size_t)j * D * FFD, (bf16_t*)(ws + WS_WF13) + (size_t)j * 2 * FFD * D, D, FFD, 1, 1}; }
    else if (mi < 10) { const int j = mi - 8;  d = ConvDesc{a.in(I_FW2) + (size_t)j * FFD * D, (bf16_t*)(ws + WS_WF2 + (size_t)j * D * FFD), FFD, D, 0, 0}; }
    else if (mi < 14) { const int g = mi - 10; d = ConvDesc{a.in(I_POOLW) + (size_t)g * 256 * 256, (bf16_t*)(ws + WS_WPOOL) + (size_t)g * 256 * 256, 256, 256, 0, 0}; }
    else if (mi == 14) { d = ConvDesc{a.in(I_MLWUP), (bf16_t*)(ws + WS_WUP), D, 2 * MLI, 0, 0}; }
    else { d = ConvDesc{a.in(I_MLWDOWN), (bf16_t*)(ws + WS_WDOWN), MLI, D, 0, 0}; }
    return d;
}
__device__ __forceinline__ ConvDesc conv_desc_moe(const PArgs& a, int le, int mi) {
    unsigned char* ws = a.ws; const int e = mi & 7, k = mi >> 3; ConvDesc d;
    if (k == 0)      d = ConvDesc{a.in(I_MW1) + ((size_t)le * NEXP + e) * D * FFE, (bf16_t*)(ws + WS_WM13 + (size_t)e * 2 * FFE * D), D, FFE, 1, 0};
    else if (k == 1) d = ConvDesc{a.in(I_MW3) + ((size_t)le * NEXP + e) * D * FFE, (bf16_t*)(ws + WS_WM13 + (size_t)e * 2 * FFE * D), D, FFE, 1, 1};
    else             d = ConvDesc{a.in(I_MW2) + ((size_t)le * NEXP + e) * FFE * D, (bf16_t*)(ws + WS_WM2 + (size_t)e * D * FFE), FFE, D, 0, 0};
    return d;
}
constexpr int CONV_SPLIT = 32;
__device__ __forceinline__ void conv_weights(const Ctx& X0, const PArgs& a, int moe_le, int gsub = 0, int bsub = 0, int f0 = 0, int f1 = 256) {
    Ctx X = fresh_ctx(X0); if (gsub > 0) { X.G = gsub; X.bid = bsub; }
    LAS float* scr = (LAS float*)(X.lds + X.wave * 16640);
    const int NGW = X.G * 8, nmat = moe_le < 0 ? 16 : 24;
    for (int mi = 0; mi < nmat; ++mi) {
        const ConvDesc d = moe_le < 0 ? conv_desc_base(a, mi) : conv_desc_moe(a, moe_le, mi);
        const int nall = (d.K / 64) * (d.N / 64), i0 = (nall * f0) >> 8, nitems = (nall * f1) >> 8; const int gw = i0 + (X.bid * 8 + X.wave + mi * 397) % NGW;
        if (moe_le < 0 && (mi == 8 || mi == 9)) { for (int it = gw; it < nitems; it += NGW) conv_item_f8(d.W, d.K, d.N, (unsigned char*)d.WT, d.mode, d.half, F8_SWD, scr, it, X.lane); }
        else if (moe_le < 0) { for (int it = gw; it < nitems; it += NGW) conv_item(d.W, d.K, d.N, d.WT, d.mode, d.half, scr, it, X.lane); }
        else { const float sc = (mi >> 3) == 2 ? F8_SW2 : F8_SW1; for (int it = gw; it < nitems; it += NGW) conv_item_f8(d.W, d.K, d.N, (unsigned char*)d.WT, d.mode, d.half, sc, scr, it, X.lane); }
    }
}
__device__ __forceinline__ void prologue_phase(const Ctx& X0, const PArgs& a) {
    const Ctx X = fresh_ctx(X0);
    unsigned char* ws = a.ws;
    conv_weights(X, a, -1);
    if (X.G < CONV_SPLIT * 2) conv_weights(X, a, 0);
    { bf16_t* g1t = (bf16_t*)(ws + WS_WGT); bf16_t* g2t = g1t + 16 * MLI; const float* wg = a.in(I_MLWG); const float* wq = a.in(I_MLWQ); const float* wk = a.in(I_MLWK); const float* wv = a.in(I_MLWV);
      for (int i = X.bid * 512 + X.tid; i < 16 * MLI; i += X.G * 512) { const int g = i / MLI, c = i % MLI, n = c >> 2, cc = c & 3; float s1 = 0.f, s2 = 0.f;
#pragma unroll
          for (int j = 0; j < 4; ++j) { s1 += wq[n * 16 + cc * 4 + j] * wg[(4 * n + j) * 16 + g] + wk[n * 16 + cc * 4 + j] * wg[(MLI + 4 * n + j) * 16 + g]; s2 += wv[n * 16 + cc * 4 + j] * wg[(2 * MLI + 4 * n + j) * 16 + g]; }
          g1t[i] = f2bf(s1); g2t[i] = f2bf(s2); } }
    { u32x4* wbd = (u32x4*)(ws + WS_WGT + 131072); const float* wq = a.in(I_MLWQ); const float* wk = a.in(I_MLWK);
      for (int i = X.bid * 512 + X.tid; i < 64 * 4 * 64; i += X.G * 512) { const int ln = i & 63, k = (i >> 6) & 3, jj = i >> 8, ql = ln & 15, g = ln >> 4, nt = k & 1; const float* wsrc = (k < 2) ? wq : wk; const float sc = (k < 2) ? 1.0f : 0.044194173824159216f;
          float f[8];
#pragma unroll
          for (int j = 0; j < 8; ++j) { const int cl = 8 * g + j, nl = (k < 2) ? 16 * nt + ql : 8 * (ql >> 2) + 4 * nt + (ql & 3); const bool on = (cl >> 2) == (nl >> 2); const int nb = (32 * jj + cl) >> 2; f[j] = on ? wsrc[nb * 16 + (cl & 3) * 4 + (nl & 3)] * sc : 0.f; }
          u32x4 o; o.x = cvt_pk_bf16(f[0], f[1]); o.y = cvt_pk_bf16(f[2], f[3]); o.z = cvt_pk_bf16(f[4], f[5]); o.w = cvt_pk_bf16(f[6], f[7]); wbd[i] = o; } }
    __syncthreads();
    LAS float* sc = (LAS float*)(X.lds);
    LAS float* part = (LAS float*)(X.lds + 20480);
    for (int i = X.tid; i < 5 * D; i += 512) { const int j = i >> 10, k = i & 1023; const float v = j < 4 ? a.in(I_C)[j * D + k] : a.in(I_CCTX)[k]; sc[i] = v / (1.0f + expf(-v)); }
    __syncthreads();
    float* MOD = (float*)(ws + WS_MOD);
    for (int item = X.bid; item < DEPTH * 96; item += X.G) {
        const int L = item / 96, cg = item % 96, cl = X.tid & 63, ks = X.tid >> 6, col = cg * 64 + cl;
        float acc[5] = {0.f, 0.f, 0.f, 0.f, 0.f};
        const float* wp = a.in(I_WMOD) + ((size_t)L * D + ks * 128) * (6 * D) + col;
#pragma unroll 4
        for (int k = 0; k < 128; ++k) { const float w = wp[(size_t)k * (6 * D)];
#pragma unroll
            for (int j = 0; j < 5; ++j) acc[j] += sc[j * D + ks * 128 + k] * w; }
#pragma unroll
        for (int j = 0; j < 5; ++j) part[(ks * 64 + cl) * 5 + j] = acc[j];
        __syncthreads();
        if (X.tid < 320) { const int j = X.tid >> 6; float m = a.in(I_BMOD)[L * 6 * D + col];
#pragma unroll
            for (int s = 0; s < 8; ++s) m += part[(s * 64 + cl) * 5 + j];
            const int which = cg >> 4, c = (cg & 15) * 64 + cl; float* mp = MOD + (size_t)((L * 5 + j) * NMODV) * D;
            mp[which * D + c] = m;
            if (which == 2) { const int kind = L % 3, jj = L / 3;
                mp[6 * D + c] = m * (kind == 1 ? a.in(I_POOLS)[c] : 1.0f);
                mp[7 * D + c] = m * (kind == 0 ? a.in(I_NABOUT)[jj * D + c] : 0.0f); } }
        __syncthreads();
    }
}

__device__ __forceinline__ void moe_tstart(const unsigned* cntw, int (&ts)[9], int (&cn)[8]) {
    int acc = 0;
#pragma unroll
    for (int e = 0; e < 8; ++e) { cn[e] = (int)__hip_atomic_load(cntw + 64 * e, RLX_AGENT); ts[e] = acc; acc += (cn[e] + 255) >> 8; }
    ts[8] = acc;
}
__device__ __forceinline__ void norm_phase(const Ctx& X0, const PArgs& a, int L, int which, int rbeg, int rend, int gsub, int bsub, bool combine, int comb_L, int comb_set, bool route, int route_set, bool final_, bool dry = false) {
    const Ctx X = fresh_ctx(X0);
    unsigned char* ws = a.ws;
    bf16_t* H = (bf16_t*)(ws + WS_H); bf16_t* A = (bf16_t*)(ws + WS_A); const float* MOD = (const float*)(ws + WS_MOD);
    unsigned* ctl = (unsigned*)(ws + WS_CTL);
    const int rpb = (rend - rbeg + gsub - 1) / gsub, row_lo = rbeg + bsub * rpb, row_hi = (row_lo + rpb < rend) ? row_lo + rpb : rend;
    LAS float* wrl = (LAS float*)(X.lds);
    LAS int* lcnt = (LAS int*)(X.lds + 32768);
    LAS int* info = (LAS int*)(X.lds + 32768 + 64);
    int ts[9], cn[8];
    if (combine) moe_tstart(ctl + CW_CNT + 64 * 8 * comb_set, ts, cn);
    if (route) {
        const float* wr = a.in(I_MROUTER) + (size_t)(L / 2) * D * NEXP;
        __syncthreads();
        for (int i = X.tid; i < D * NEXP; i += 512) wrl[i] = wr[i];
        if (X.tid < 16) lcnt[X.tid] = 0;
        __syncthreads();
    }
    const bf16_t* Y = (const bf16_t*)(ws + WS_MY); const int* POS = (const int*)(ws + WS_POS); const float* GATE = (const float*)(ws + WS_GATE);
    f32x4 rawA[4], rawB[4], rawC[4]; int pA0 = 0, pA1 = 0, pB0 = 0, pB1 = 0, pC0 = 0, pC1 = 0; float gA0 = 0.f, gA1 = 0.f, gB0 = 0.f, gB1 = 0.f, gC0 = 0.f, gC1 = 0.f; int pcond = -1; f32x4 pg[4], ps[4];
    const float* xin = a.in(I_X); const float* cin = a.in(I_CTX); const bool from_in = (L == 0 && which == 0 && !final_);
#define NP_LOAD(raw_, p0_, p1_, g0_, g1_, row_) do { if (from_in) { const f32x4* hr_ = (const f32x4*)((row_) < NLAT ? xin + (size_t)(row_) * D : cin + (size_t)((row_) - NLAT) * D) + X.lane; _Pragma("unroll") for (int j_ = 0; j_ < 4; ++j_) raw_[j_] = hr_[64 * j_]; } \
        else { const u32x2* hr_ = (const u32x2*)(H + (size_t)(row_) * D) + X.lane; _Pragma("unroll") for (int j_ = 0; j_ < 4; ++j_) { const u32x2 w_ = hr_[64 * j_]; raw_[j_][0] = __uint_as_float(w_.x); raw_[j_][1] = __uint_as_float(w_.y); } } \
        if (combine) { p0_ = POS[(row_) * 2]; p1_ = POS[(row_) * 2 + 1]; g0_ = GATE[(row_) * 2]; g1_ = GATE[(row_) * 2 + 1]; } } while (0)
    if (row_lo + X.wave < row_hi) NP_LOAD(rawA, pA0, pA1, gA0, gA1, row_lo + X.wave);
    if (row_lo + X.wave + 8 < row_hi) NP_LOAD(rawB, pB0, pB1, gB0, gB1, row_lo + X.wave + 8);
    if (row_lo + X.wave + 16 < row_hi) NP_LOAD(rawC, pC0, pC1, gC0, gC1, row_lo + X.wave + 16);
    for (int row = row_lo + X.wave; row < row_hi; row += 8) {
        const int cond = row_cond(row);
        f32x4 v[4];
#pragma unroll
        for (int j = 0; j < 4; ++j) { if (from_in) v[j] = rawA[j]; else { const unsigned w0 = __float_as_uint(rawA[j][0]), w1 = __float_as_uint(rawA[j][1]); v[j] = (f32x4){bf_lo(w0), bf_hi(w0), bf_lo(w1), bf_hi(w1)}; } }
        const int p0 = pA0, p1 = pA1; const float g0 = gA0, g1 = gA1;
#pragma unroll
        for (int j = 0; j < 4; ++j) { rawA[j] = rawB[j]; rawB[j] = rawC[j]; }
        pA0 = pB0; pA1 = pB1; gA0 = gB0; gA1 = gB1; pB0 = pC0; pB1 = pC1; gB0 = gC0; gB1 = gC1;
        if (row + 24 < row_hi) NP_LOAD(rawC, pC0, pC1, gC0, gC1, row + 24);
        if (cond != pcond) { pcond = cond;
            if (final_) { const float* fg = a.in(I_FINALG);
#pragma unroll
                for (int j = 0; j < 4; ++j) { pg[j] = *(const f32x4*)(fg + 256 * j + 4 * X.lane); ps[j] = (f32x4){0.f, 0.f, 0.f, 0.f}; } }
            else { const float* ng = a.in(I_NORMG) + (size_t)(L * 2 + which) * D; const float* sh = MOD + (size_t)((L * 5 + cond) * NMODV + which * 3) * D; const float* scl = sh + D;
#pragma unroll
                for (int j = 0; j < 4; ++j) { const int c = 256 * j + 4 * X.lane; pg[j] = *(const f32x4*)(ng + c) * (*(const f32x4*)(scl + c) + 1.0f); ps[j] = *(const f32x4*)(sh + c); } } }
        if (combine) {
            const int e0 = p0 >> 24, e1 = p1 >> 24; int t0 = 0, t1 = 0;
#pragma unroll
            for (int e = 0; e < 8; ++e) { t0 = (e == e0) ? ts[e] : t0; t1 = (e == e1) ? ts[e] : t1; }
            const size_t y0 = ((size_t)t0 * 256 + (p0 & 0xffffff)) * D, y1 = ((size_t)t1 * 256 + (p1 & 0xffffff)) * D;
            const float* g2 = MOD + (size_t)((comb_L * 5 + cond) * NMODV + 5) * D;
#pragma unroll
            for (int j = 0; j < 4; ++j) { const int c = 256 * j + 4 * X.lane;
                const u32x2 w0 = *(const u32x2*)(Y + y0 + c), w1 = *(const u32x2*)(Y + y1 + c); const f32x4 gg = *(const f32x4*)(g2 + c);
                v[j][0] += gg[0] * (g0 * bf_lo(w0.x) + g1 * bf_lo(w1.x)); v[j][1] += gg[1] * (g0 * bf_hi(w0.x) + g1 * bf_hi(w1.x));
                v[j][2] += gg[2] * (g0 * bf_lo(w0.y) + g1 * bf_lo(w1.y)); v[j][3] += gg[3] * (g0 * bf_hi(w0.y) + g1 * bf_hi(w1.y)); }
            if (!final_ && !dry) { u32x2* hw = (u32x2*)(H + (size_t)row * D) + X.lane;
#pragma unroll
                for (int j = 0; j < 4; ++j) { u32x2 w; w.x = cvt_pk_bf16(v[j][0], v[j][1]); w.y = cvt_pk_bf16(v[j][2], v[j][3]); hw[64 * j] = w; } }
        }
        float ss = 0.f;
#pragma unroll
        for (int j = 0; j < 4; ++j) ss += (v[j][0] * v[j][0] + v[j][1] * v[j][1]) + (v[j][2] * v[j][2] + v[j][3] * v[j][3]);
        const float rs = 1.0f / sqrtf(wave_sum(ss) * (1.0f / D) + NORM_EPS);
        if (final_) {
            f32x4* o = (f32x4*)(a.out + (size_t)row * D) + X.lane;
#pragma unroll
            for (int j = 0; j < 4; ++j) o[64 * j] = v[j] * rs * pg[j];
            continue;
        }
        float lg[8] = {0.f, 0.f, 0.f, 0.f, 0.f, 0.f, 0.f, 0.f};
#pragma unroll
        for (int j = 0; j < 4; ++j) { const int c = 256 * j + 4 * X.lane;
            const f32x4 y = v[j] * rs * pg[j] + ps[j];
            u32x2 w; w.x = cvt_pk_bf16(y[0], y[1]); w.y = cvt_pk_bf16(y[2], y[3]);
            *(u32x2*)(A + (size_t)row * D + c) = w;
            if (route) {
#pragma unroll
                for (int i = 0; i < 4; ++i) { const f32x4 wa = *(const LAS f32x4*)(wrl + (c + i) * 8), wb = *(const LAS f32x4*)(wrl + (c + i) * 8 + 4);
                    lg[0] += y[i] * wa[0]; lg[1] += y[i] * wa[1]; lg[2] += y[i] * wa[2]; lg[3] += y[i] * wa[3];
                    lg[4] += y[i] * wb[0]; lg[5] += y[i] * wb[1]; lg[6] += y[i] * wb[2]; lg[7] += y[i] * wb[3]; } }
        }
        if (route) {
#pragma unroll
            for (int e = 0; e < 8; ++e) lg[e] = wave_sum(lg[e]);
            int e0 = 0; float l0 = lg[0];
#pragma unroll
            for (int e = 1; e < 8; ++e) if (lg[e] > l0) { l0 = lg[e]; e0 = e; }
            int e1 = -1; float l1 = -3.0e38f;
#pragma unroll
            for (int e = 0; e < 8; ++e) if (e != e0 && lg[e] > l1) { l1 = lg[e]; e1 = e; }
            if (X.lane == 0) {
                const float g0 = 1.0f / (1.0f + expf(l1 - l0));
                const int s0 = __hip_atomic_fetch_add(lcnt + e0, 1, __ATOMIC_RELAXED, __HIP_MEMORY_SCOPE_WORKGROUP);
                const int s1 = __hip_atomic_fetch_add(lcnt + e1, 1, __ATOMIC_RELAXED, __HIP_MEMORY_SCOPE_WORKGROUP);
                LAS int* ip = info + (row - row_lo) * 6; ip[0] = e0; ip[1] = e1; ip[2] = s0; ip[3] = s1; ip[4] = __float_as_int(g0); ip[5] = __float_as_int(1.0f - g0);
            }
        }
    }
#undef NP_LOAD
    if (route && !dry) {
        __syncthreads();
        if (X.tid < 8) lcnt[8 + X.tid] = (int)__hip_atomic_fetch_add(ctl + CW_CNT + 64 * (8 * route_set + X.tid), (unsigned)lcnt[X.tid], RLX_AGENT);
        __syncthreads();
        int* LIST = (int*)(ws + WS_LIST); int* POSW = (int*)(ws + WS_POS); float* GATEW = (float*)(ws + WS_GATE);
        for (int r = X.tid; r < row_hi - row_lo; r += 512) { const LAS int* ip = info + r * 6; const int row = row_lo + r;
            const int e0 = ip[0], e1 = ip[1], s0 = lcnt[8 + e0] + ip[2], s1 = lcnt[8 + e1] + ip[3];
            LIST[(size_t)e0 * MT + s0] = row; LIST[(size_t)e1 * MT + s1] = row;
            POSW[row * 2] = (e0 << 24) | s0; POSW[row * 2 + 1] = (e1 << 24) | s1;
            GATEW[row * 2] = __int_as_float(ip[4]); GATEW[row * 2 + 1] = __int_as_float(ip[5]); }
        __syncthreads();
    }
}

__device__ __forceinline__ void poolprep2_phase(const Ctx& X0, const PArgs& a, int nrows) {
    const Ctx X = fresh_ctx(X0);
    const bf16_t* __restrict__ A = (const bf16_t*)(a.ws + WS_A); bf16_t* __restrict__ PL = (bf16_t*)(a.ws + WS_PL);
    const int nwv = X.G * 8, rpi = (nrows * 4 + nwv - 1) / nwv;
    for (int item = X.bid * 8 + X.wave; item * rpi < nrows * 4; item += nwv) {
        const int g = item & 3, half = 1 << g, c = g * 256 + 4 * X.lane, rbeg = (item >> 2) * rpi, rend = rbeg + rpi < nrows ? rbeg + rpi : nrows;
        int base = 0, t = 0, len = 0, lo = 0, hi = 0; float s0 = 0.f, s1 = 0.f, s2 = 0.f, s3 = 0.f;
        for (int row = rbeg; row < rend; ++row) {
            if (row == rbeg || t == len) {
                if (row < NLAT) { base = row & ~(SEQ - 1); t = row & (SEQ - 1); len = SEQ; } else { const int r = row - NLAT; base = NLAT + (r & ~(CTXL - 1)); t = r & (CTXL - 1); len = CTXL; }
                lo = t - half > 0 ? t - half : 0; hi = t + half < len ? t + half : len; s0 = s1 = s2 = s3 = 0.f;
                for (int s = lo; s < hi; ++s) { const u32x2 x = *(const u32x2*)(A + (size_t)(base + s) * D + c); s0 += bf_lo(x.x); s1 += bf_hi(x.x); s2 += bf_lo(x.y); s3 += bf_hi(x.y); } }
            const bf16_t* Ab = A + (size_t)base * D + c;
            const u32x2 me = *(const u32x2*)(Ab + (size_t)t * D); const float inv = 1.0f / (float)(hi - lo);
            u32x2 o; o.x = cvt_pk_bf16(s0 * inv - bf_lo(me.x), s1 * inv - bf_hi(me.x)); o.y = cvt_pk_bf16(s2 * inv - bf_lo(me.y), s3 * inv - bf_hi(me.y));
            *(u32x2*)(PL + (size_t)row * D + c) = o;
            const int hin = t + 1 + half < len ? t + 1 + half : len, lon = t + 1 - half > 0 ? t + 1 - half : 0;
            if (hin > hi) { const u32x2 x = *(const u32x2*)(Ab + (size_t)hi * D); s0 += bf_lo(x.x); s1 += bf_hi(x.x); s2 += bf_lo(x.y); s3 += bf_hi(x.y); }
            if (lon > lo) { const u32x2 x = *(const u32x2*)(Ab + (size_t)lo * D); s0 -= bf_lo(x.x); s1 -= bf_hi(x.x); s2 -= bf_lo(x.y); s3 -= bf_hi(x.y); }
            hi = hin; lo = lon; ++t;
        }
    }
}
__device__ __forceinline__ void poolprep_phase(const Ctx& X0, const PArgs& a, int nrows) {
    const Ctx X = fresh_ctx(X0);
    const bf16_t* __restrict__ A = (const bf16_t*)(a.ws + WS_A); bf16_t* __restrict__ PL = (bf16_t*)(a.ws + WS_PL);
    for (int row = X.bid * 8 + X.wave; row < nrows; row += X.G * 8) {
        int base, t, len; if (row < NLAT) { base = row & ~(SEQ - 1); t = row & (SEQ - 1); len = SEQ; } else { const int r = row - NLAT; base = NLAT + (r & ~(CTXL - 1)); t = r & (CTXL - 1); len = CTXL; }
#pragma unroll
        for (int g = 0; g < 4; ++g) { const int w = 2 << g, lo = (t - w / 2 > 0) ? t - w / 2 : 0, hi = (t + w / 2 < len) ? t + w / 2 : len; const int c = g * 256 + 4 * X.lane;
            float s0 = 0.f, s1 = 0.f, s2 = 0.f, s3 = 0.f;
            for (int s = lo; s < hi; ++s) { const u32x2 x = *(const u32x2*)(A + (size_t)(base + s) * D + c); s0 += bf_lo(x.x); s1 += bf_hi(x.x); s2 += bf_lo(x.y); s3 += bf_hi(x.y); }
            const u32x2 me = *(const u32x2*)(A + (size_t)row * D + c); const float inv = 1.0f / (float)(hi - lo);
            u32x2 o; o.x = cvt_pk_bf16(s0 * inv - bf_lo(me.x), s1 * inv - bf_hi(me.x)); o.y = cvt_pk_bf16(s2 * inv - bf_lo(me.y), s3 * inv - bf_hi(me.y));
            *(u32x2*)(PL + (size_t)row * D + c) = o; }
    }
}
typedef short s16x4 __attribute__((ext_vector_type(4)));
__device__ __forceinline__ int launder_i(int x) { asm volatile("" : "+v"(x)); return x; }
__device__ __forceinline__ float swz_xor(float v, int m) { return m == 1 ? __int_as_float(__builtin_amdgcn_ds_swizzle(__float_as_int(v), (1 << 10) | 0x1f)) : (m == 2 ? __int_as_float(__builtin_amdgcn_ds_swizzle(__float_as_int(v), (2 << 10) | 0x1f)) : __int_as_float(__builtin_amdgcn_ds_swizzle(__float_as_int(v), (4 << 10) | 0x1f))); }
typedef __bf16 bf16x2_t __attribute__((ext_vector_type(2)));
__device__ __forceinline__ unsigned cvtpk(float lo, float hi) { f32x2 v = {lo, hi}; bf16x2_t b = __builtin_convertvector(v, bf16x2_t); return __builtin_bit_cast(unsigned, b); }
__device__ __forceinline__ s16x4 lds_tr16(const LAS unsigned char* p) { return __builtin_bit_cast(s16x4, __builtin_amdgcn_ds_read_tr16_b64_v4i16((LAS s16x4*)p)); }

__device__ __forceinline__ void seq_of_row(int row, int& base, int& t, int& len) {
    if (row < NLAT) { base = row & ~(SEQ - 1); t = row & (SEQ - 1); len = SEQ; } else { const int r = row - NLAT; base = NLAT + (r & ~(CTXL - 1)); t = r & (CTXL - 1); len = CTXL; }
}

__device__ __forceinline__ void feat_phase(const Ctx& X0, const PArgs& a) {
    const Ctx X = fresh_ctx(X0);
    unsigned char* ws = a.ws;
    const bf16_t* XM = (const bf16_t*)(ws + WS_XM); bf16_t* XC = (bf16_t*)(ws + WS_XC); float* GT = (float*)(ws + WS_GT); const bf16_t* G1T = (const bf16_t*)(ws + WS_WGT); const bf16_t* G2T = G1T + 16 * MLI;
    LAS float* cwl = (LAS float*)X.lds;
    { const float* cw = a.in(I_MLCONVW); const float* cb = a.in(I_MLCONVB);
      for (int i = X.tid; i < 4 * MLI; i += 512) cwl[i] = cw[i];
      for (int i = X.tid; i < MLI; i += 512) cwl[4 * MLI + i] = cb[i]; }
    __syncthreads();
    const int fr = X.lane & 15, fq = X.lane >> 4;
    for (int item = X.bid * 8 + X.wave; item < MT / 16; item += X.G * 8) {
        const int row = item * 16 + fr; int base, t, len; seq_of_row(row, base, t, len);
        f32x4 acc = (f32x4){0.f, 0.f, 0.f, 0.f};
        const bool v0 = t >= 2, v1 = t >= 1, v3 = t + 1 < len;
        const bf16_t* xr = XM + (size_t)row * MLI + 8 * fq;
#pragma unroll 2
        for (int jj = 0; jj < MLI / 32; ++jj) {
            const int c0 = 32 * jj + 8 * fq;
            u32x4 w[4]; const u32x4 z4 = (u32x4){0u, 0u, 0u, 0u};
            w[0] = v0 ? *(const u32x4*)(xr + 32 * jj - 2 * MLI) : z4; w[1] = v1 ? *(const u32x4*)(xr + 32 * jj - MLI) : z4; w[2] = *(const u32x4*)(xr + 32 * jj); w[3] = v3 ? *(const u32x4*)(xr + 32 * jj + MLI) : z4;
            const bf16x8 b1 = *(const bf16x8*)(G1T + (size_t)fr * MLI + c0), b2 = *(const bf16x8*)(G2T + (size_t)fr * MLI + c0);
            float xc[8];
            { const f32x4 ba = *(const LAS f32x4*)(cwl + 4 * MLI + c0), bb = *(const LAS f32x4*)(cwl + 4 * MLI + c0 + 4);
              xc[0] = ba[0]; xc[1] = ba[1]; xc[2] = ba[2]; xc[3] = ba[3]; xc[4] = bb[0]; xc[5] = bb[1]; xc[6] = bb[2]; xc[7] = bb[3]; }
#pragma unroll
            for (int tap = 0; tap < 4; ++tap) { const f32x4 ca = *(const LAS f32x4*)(cwl + tap * MLI + c0), cc = *(const LAS f32x4*)(cwl + tap * MLI + c0 + 4);
                xc[0] += bf_lo(w[tap].x) * ca[0]; xc[1] += bf_hi(w[tap].x) * ca[1]; xc[2] += bf_lo(w[tap].y) * ca[2]; xc[3] += bf_hi(w[tap].y) * ca[3];
                xc[4] += bf_lo(w[tap].z) * cc[0]; xc[5] += bf_hi(w[tap].z) * cc[1]; xc[6] += bf_lo(w[tap].w) * cc[2]; xc[7] += bf_hi(w[tap].w) * cc[3]; }
#pragma unroll
            for (int i = 0; i < 8; ++i) xc[i] = silu_f(xc[i]);
            u32x4 o; o.x = cvtpk(xc[0], xc[1]); o.y = cvtpk(xc[2], xc[3]); o.z = cvtpk(xc[4], xc[5]); o.w = cvtpk(xc[6], xc[7]);
            *(u32x4*)(XC + (size_t)row * MLI + c0) = o;
            acc = __builtin_amdgcn_mfma_f32_16x16x32_bf16(__builtin_bit_cast(bf16x8, o), b1, acc, 0, 0, 0);
            acc = __builtin_amdgcn_mfma_f32_16x16x32_bf16(__builtin_bit_cast(bf16x8, w[2]), b2, acc, 0, 0, 0);
        }
        const float bg = a.in(I_MLBG)[fr];
#pragma unroll
        for (int r = 0; r < 4; ++r) GT[(size_t)(item * 16 + 4 * fq + r) * 16 + fr] = acc[r] + bg;
    }
}

__device__ __forceinline__ int chain_row(int b, int dir, int p) {
    if (p < CTXL) return NLAT + b * CTXL + (dir ? CTXL - 1 - p : p);
    const int tt = p - CTXL; return b * SEQ + (dir ? SEQ - 1 - tt : tt);
}
__device__ __forceinline__ void scan_naive_phase(const Ctx& X0, const PArgs& a) {
    const Ctx X = fresh_ctx(X0);
    unsigned char* ws = a.ws;
    const bf16_t* XM = (const bf16_t*)(ws + WS_XM); const bf16_t* XC = (const bf16_t*)(ws + WS_XC); const float* GT = (const float*)(ws + WS_GT);
    LAS bf16_t* qL = (LAS bf16_t*)(X.lds); LAS bf16_t* kL = (LAS bf16_t*)(X.lds + 65536); LAS float* vL = (LAS float*)(X.lds + 131072); LAS float* gL = (LAS float*)(X.lds + 131072 + 16384);
    const float* wq = a.in(I_MLWQ); const float* wk = a.in(I_MLWK); const float* wv = a.in(I_MLWV);
    const float kscale = 0.044194173824159216f;
    for (int item = X.bid; item < 256; item += X.G) {
        const int chain = item >> 3, sl = item & 7, b = chain >> 3, h = (chain >> 1) & 3, dir = chain & 1;
        bf16_t* HO = (bf16_t*)(ws + (dir ? WS_HB : WS_HF));
        const int d = X.tid >> 3, ep = X.tid & 7;
        float C[64], n[64];
#pragma unroll
        for (int j = 0; j < 64; ++j) { C[j] = 0.f; n[j] = 0.f; }
        const int bc = X.tid & 127, nbq = h * 128 + bc;
        float wqr[16], wkr[16];
#pragma unroll
        for (int i = 0; i < 16; ++i) { wqr[i] = wq[nbq * 16 + i]; wkr[i] = wk[nbq * 16 + i] * kscale; }
        for (int ch = 0; ch < (CTXL + SEQ) / 64; ++ch) {
            __syncthreads();
            for (int i = 0; i < 16; ++i) { const int tl = (X.tid >> 7) + 4 * i; const int row = chain_row(b, dir, ch * 64 + tl);
                const u32x2 w = *(const u32x2*)(XC + (size_t)row * MLI + h * 512 + 4 * bc);
                const float x0 = bf_lo(w.x), x1 = bf_hi(w.x), x2 = bf_lo(w.y), x3 = bf_hi(w.y);
                float qo[4], ko[4];
#pragma unroll
                for (int dd = 0; dd < 4; ++dd) { qo[dd] = x0 * wqr[dd] + x1 * wqr[4 + dd] + x2 * wqr[8 + dd] + x3 * wqr[12 + dd]; ko[dd] = x0 * wkr[dd] + x1 * wkr[4 + dd] + x2 * wkr[8 + dd] + x3 * wkr[12 + dd]; }
                u32x2 oq, ok; oq.x = cvt_pk_bf16(qo[0], qo[1]); oq.y = cvt_pk_bf16(qo[2], qo[3]); ok.x = cvt_pk_bf16(ko[0], ko[1]); ok.y = cvt_pk_bf16(ko[2], ko[3]);
                *(LAS u32x2*)(qL + tl * 512 + 4 * bc) = oq; *(LAS u32x2*)(kL + tl * 512 + 4 * bc) = ok; }
            for (int i = 0; i < 2; ++i) { const int id = X.tid + 512 * i, tl = id >> 4, vb = id & 15; const int row = chain_row(b, dir, ch * 64 + tl); const int nb = h * 128 + sl * 16 + vb;
                const u32x2 w = *(const u32x2*)(XM + (size_t)row * MLI + 4 * nb);
                const float x0 = bf_lo(w.x), x1 = bf_hi(w.x), x2 = bf_lo(w.y), x3 = bf_hi(w.y); const float* pv = wv + nb * 16;
#pragma unroll
                for (int dd = 0; dd < 4; ++dd) vL[tl * 64 + 4 * vb + dd] = x0 * pv[dd] + x1 * pv[4 + dd] + x2 * pv[8 + dd] + x3 * pv[12 + dd]; }
            if (X.tid < 64) { const int row = chain_row(b, dir, ch * 64 + X.tid); const float ip = GT[(size_t)row * 16 + (2 * dir) * 4 + h], fp = GT[(size_t)row * 16 + (2 * dir + 1) * 4 + h];
                gL[X.tid * 2] = expf(ip); gL[X.tid * 2 + 1] = 1.0f / (1.0f + expf(-fp)); }
            __syncthreads();
            for (int tl = 0; tl < 64; ++tl) {
                const float ig = gL[tl * 2], fg = gL[tl * 2 + 1]; const float iv = ig * vL[tl * 64 + d];
                float num = 0.f, den = 0.f;
#pragma unroll
                for (int g8 = 0; g8 < 8; ++g8) {
                    const u32x4 kw = *(const LAS u32x4*)(kL + tl * 512 + 64 * ep + 8 * g8), qw = *(const LAS u32x4*)(qL + tl * 512 + 64 * ep + 8 * g8);
                    const float kk[8] = {bf_lo(kw.x), bf_hi(kw.x), bf_lo(kw.y), bf_hi(kw.y), bf_lo(kw.z), bf_hi(kw.z), bf_lo(kw.w), bf_hi(kw.w)};
                    const float qq[8] = {bf_lo(qw.x), bf_hi(qw.x), bf_lo(qw.y), bf_hi(qw.y), bf_lo(qw.z), bf_hi(qw.z), bf_lo(qw.w), bf_hi(qw.w)};
#pragma unroll
                    for (int j = 0; j < 8; ++j) { const int e = g8 * 8 + j; C[e] = fg * C[e] + iv * kk[j]; n[e] = fg * n[e] + ig * kk[j]; num += C[e] * qq[j]; den += n[e] * qq[j]; }
                }
                num += __shfl_xor(num, 1); den += __shfl_xor(den, 1); num += __shfl_xor(num, 2); den += __shfl_xor(den, 2); num += __shfl_xor(num, 4); den += __shfl_xor(den, 4);
                if (ep == 0) { const int row = chain_row(b, dir, ch * 64 + tl); const float dn = fabsf(den) > 1.0f ? fabsf(den) : 1.0f;
                    HO[(size_t)row * MLI + h * 512 + sl * 64 + d] = f2bf(num / dn); }
            }
        }
    }
}

__device__ __forceinline__ void outprep_phase(const Ctx& X0, const PArgs& a) {
    const Ctx X = fresh_ctx(X0);
    unsigned char* ws = a.ws;
    const bf16_t* HF = (const bf16_t*)(ws + WS_HF); const bf16_t* HB = (const bf16_t*)(ws + WS_HB); const bf16_t* XC = (const bf16_t*)(ws + WS_XC); const bf16_t* Z = (const bf16_t*)(ws + WS_Z);
    bf16_t* OA = (bf16_t*)(ws + WS_OA); const float* gn = a.in(I_MLGN); const float* sk = a.in(I_MLSKIP);
    for (int row = X.bid * 8 + X.wave; row < MT; row += X.G * 8) {
#pragma unroll
        for (int hh = 0; hh < 4; ++hh) { const int c = hh * 512 + 8 * X.lane; const size_t o = (size_t)row * MLI + c;
            const u32x4 wf = *(const u32x4*)(HF + o), wb = *(const u32x4*)(HB + o), wx = *(const u32x4*)(XC + o), wz = *(const u32x4*)(Z + o);
            float hs[8] = {bf_lo(wf.x) + bf_lo(wb.x), bf_hi(wf.x) + bf_hi(wb.x), bf_lo(wf.y) + bf_lo(wb.y), bf_hi(wf.y) + bf_hi(wb.y), bf_lo(wf.z) + bf_lo(wb.z), bf_hi(wf.z) + bf_hi(wb.z), bf_lo(wf.w) + bf_lo(wb.w), bf_hi(wf.w) + bf_hi(wb.w)};
            const float xcv[8] = {bf_lo(wx.x), bf_hi(wx.x), bf_lo(wx.y), bf_hi(wx.y), bf_lo(wx.z), bf_hi(wx.z), bf_lo(wx.w), bf_hi(wx.w)};
            const float zv[8] = {bf_lo(wz.x), bf_hi(wz.x), bf_lo(wz.y), bf_hi(wz.y), bf_lo(wz.z), bf_hi(wz.z), bf_lo(wz.w), bf_hi(wz.w)};
            float s = 0.f;
#pragma unroll
            for (int i = 0; i < 8; ++i) s += hs[i];
            const float mu = wave_sum(s) * (1.0f / 512.0f); float q = 0.f;
#pragma unroll
            for (int i = 0; i < 8; ++i) { hs[i] -= mu; q += hs[i] * hs[i]; }
            const float rstd = 1.0f / sqrtf(wave_sum(q) * (1.0f / 512.0f) + NORM_EPS);
            float ov[8];
#pragma unroll
            for (int i = 0; i < 8; ++i) ov[i] = (hs[i] * rstd * gn[c + i] + sk[c + i] * xcv[i]) * silu_f(zv[i]);
            u32x4 w; w.x = cvt_pk_bf16(ov[0], ov[1]); w.y = cvt_pk_bf16(ov[2], ov[3]); w.z = cvt_pk_bf16(ov[4], ov[5]); w.w = cvt_pk_bf16(ov[6], ov[7]);
            *(u32x4*)(OA + o) = w; }
    }
}

__device__ __forceinline__ void attn_naive_phase(const Ctx& X0, const PArgs& a, int j_na, bool with_ctx) {
    const Ctx X = fresh_ctx(X0);
    unsigned char* ws = a.ws;
    const bf16_t* Q = (const bf16_t*)(ws + WS_Q); const bf16_t* K = (const bf16_t*)(ws + WS_K); const bf16_t* V = (const bf16_t*)(ws + WS_V); bf16_t* O = (bf16_t*)(ws + WS_O);
    const float* rpb = a.in(I_NARPB) + (size_t)j_na * NAH * 15 * 31;
    LAS bf16_t* kT = (LAS bf16_t*)(X.lds); LAS bf16_t* vT = (LAS bf16_t*)(X.lds + 8192 + 1024);
    const int PITCH = 72;
    const int nunits = NB * GROWS * NAH + (with_ctx ? NB * NAH * 4 : 0);
    const int qi = X.tid >> 3, kp = X.tid & 7;
    for (int u = X.bid; u < nunits; u += X.G) {
        int b, h, r = 0, r0 = 0, qrow, ntl; bool lat = u < NB * GROWS * NAH;
        if (lat) { b = u / (GROWS * NAH); const int rem = u % (GROWS * NAH); r = rem / NAH; h = rem % NAH; r0 = r - 4; r0 = r0 < 0 ? 0 : (r0 > GROWS - 8 ? GROWS - 8 : r0); qrow = b * SEQ + r * GRIDW + qi; ntl = 12; }
        else { const int v = u - NB * GROWS * NAH; b = v / (NAH * 4); h = (v / 4) % NAH; qrow = NLAT + b * CTXL + (v & 3) * 64 + qi; ntl = 4; }
        float q[64];
        { const u32x4* qp = (const u32x4*)(Q + (size_t)qrow * D + h * 64);
#pragma unroll
          for (int g = 0; g < 8; ++g) { const u32x4 w = qp[g]; q[8 * g] = bf_lo(w.x); q[8 * g + 1] = bf_hi(w.x); q[8 * g + 2] = bf_lo(w.y); q[8 * g + 3] = bf_hi(w.y); q[8 * g + 4] = bf_lo(w.z); q[8 * g + 5] = bf_hi(w.z); q[8 * g + 6] = bf_lo(w.w); q[8 * g + 7] = bf_hi(w.w); } }
        float m = -3.0e38f, l = 0.f, acc[64];
#pragma unroll
        for (int i = 0; i < 64; ++i) acc[i] = 0.f;
        const int c0 = qi - 8 < 0 ? 0 : (qi - 8 > 48 ? 48 : qi - 8);
        for (int tl = 0; tl < ntl; ++tl) {
            const bool local = lat && tl < 8;
            const int krow0 = local ? b * SEQ + (r0 + tl) * GRIDW : NLAT + b * CTXL + (lat ? tl - 8 : tl) * 64;
            __syncthreads();
            { const int kr = X.tid >> 3, kc = (X.tid & 7) * 8;
              *(LAS u32x4*)(kT + kr * PITCH + kc) = *(const u32x4*)(K + (size_t)(krow0 + kr) * D + h * 64 + kc);
              *(LAS u32x4*)(vT + kr * PITCH + kc) = *(const u32x4*)(V + (size_t)(krow0 + kr) * D + h * 64 + kc); }
            __syncthreads();
            for (int j = 0; j < 8; ++j) { const int key = kp + 8 * j;
                if (local && (key < c0 || key >= c0 + 16)) continue;
                float s = 0.f;
#pragma unroll
                for (int g = 0; g < 8; ++g) { const u32x4 w = *(const LAS u32x4*)(kT + key * PITCH + 8 * g);
                    s += q[8 * g] * bf_lo(w.x) + q[8 * g + 1] * bf_hi(w.x) + q[8 * g + 2] * bf_lo(w.y) + q[8 * g + 3] * bf_hi(w.y) + q[8 * g + 4] * bf_lo(w.z) + q[8 * g + 5] * bf_hi(w.z) + q[8 * g + 6] * bf_lo(w.w) + q[8 * g + 7] * bf_hi(w.w); }
                s *= 0.125f;
                if (local) { int dc = key - qi; dc = dc < -15 ? -15 : (dc > 15 ? 15 : dc); s += rpb[(h * 15 + (r0 + tl - r + 7)) * 31 + dc + 15]; }
                if (s > m) { const float sc = __expf(m - s); l *= sc;
#pragma unroll
                    for (int i = 0; i < 64; ++i) acc[i] *= sc;
                    m = s; }
                const float p = __expf(s - m); l += p;
#pragma unroll
                for (int g = 0; g < 8; ++g) { const u32x4 w = *(const LAS u32x4*)(vT + key * PITCH + 8 * g);
                    acc[8 * g] += p * bf_lo(w.x); acc[8 * g + 1] += p * bf_hi(w.x); acc[8 * g + 2] += p * bf_lo(w.y); acc[8 * g + 3] += p * bf_hi(w.y);
                    acc[8 * g + 4] += p * bf_lo(w.z); acc[8 * g + 5] += p * bf_hi(w.z); acc[8 * g + 6] += p * bf_lo(w.w); acc[8 * g + 7] += p * bf_hi(w.w); }
            }
        }
        float mm = m;
        mm = fmaxf(mm, __shfl_xor(mm, 1)); mm = fmaxf(mm, __shfl_xor(mm, 2)); mm = fmaxf(mm, __shfl_xor(mm, 4));
        const float sc = __expf(m - mm); l *= sc;
        l += __shfl_xor(l, 1); l += __shfl_xor(l, 2); l += __shfl_xor(l, 4);
        const float inv = 1.0f / l;
        float mine[8];
#pragma unroll
        for (int i = 0; i < 64; ++i) { float v = acc[i] * sc; v += __shfl_xor(v, 1); v += __shfl_xor(v, 2); v += __shfl_xor(v, 4); if ((i >> 3) == kp) mine[i & 7] = v * inv; }
        u32x4 w; w.x = cvt_pk_bf16(mine[0], mine[1]); w.y = cvt_pk_bf16(mine[2], mine[3]); w.z = cvt_pk_bf16(mine[4], mine[5]); w.w = cvt_pk_bf16(mine[6], mine[7]);
        *(u32x4*)(O + (size_t)qrow * D + h * 64 + kp * 8) = w;
    }
}

template <int CBLO, int CBHI, bool LOCAL>
__device__ __forceinline__ void attn_tile(const LAS unsigned char* kt, const LAS unsigned char* vt, const LAS float* blr, const bf16x8 (&qf)[2], float& m, float& lsum, f32x4 (&o)[4], int ql, int g, int qc, int c0) {
    constexpr int PITCH = 272;
    f32x4 s[4];
#pragma unroll
    for (int cb = CBLO; cb <= CBHI; ++cb) { s[cb] = (f32x4){0.f, 0.f, 0.f, 0.f};
#pragma unroll
        for (int ss = 0; ss < 2; ++ss) { const bf16x8 kf = *(const LAS bf16x8*)(kt + (16 * cb + ql) * PITCH + ss * 64 + g * 16);
            s[cb] = __builtin_amdgcn_mfma_f32_16x16x32_bf16(kf, qf[ss], s[cb], 0, 0, 0); } }
    float mx = -1.0e30f;
#pragma unroll
    for (int cb = CBLO; cb <= CBHI; ++cb)
#pragma unroll
        for (int rg = 0; rg < 4; ++rg) { float v = s[cb][rg] * 0.18033688011112042f;
            if (LOCAL) { const int kc = 16 * cb + 4 * g + rg; int dc = kc - qc; dc = dc < -15 ? -15 : (dc > 15 ? 15 : dc);
                v += blr[dc + 15]; v = (kc >= c0 && kc < c0 + 16) ? v : -1.0e30f; }
            s[cb][rg] = v; mx = fmaxf(mx, v); }
    mx = fmaxf(mx, __shfl_xor(mx, 16)); mx = fmaxf(mx, __shfl_xor(mx, 32));
    const float mn = fmaxf(m, mx), alpha = __builtin_amdgcn_exp2f(m - mn); m = mn;
    float ps = 0.f;
#pragma unroll
    for (int cb = CBLO; cb <= CBHI; ++cb)
#pragma unroll
        for (int rg = 0; rg < 4; ++rg) { const float p = __builtin_amdgcn_exp2f(s[cb][rg] - mn); s[cb][rg] = p; ps += p; }
    lsum = lsum * alpha + ps;
#pragma unroll
    for (int db = 0; db < 4; ++db) o[db] = o[db] * alpha;
#pragma unroll
    for (int pr = 0; pr < 2; ++pr) {
        if (2 * pr + 1 < CBLO || 2 * pr > CBHI) continue;
        const f32x4 z = (f32x4){0.f, 0.f, 0.f, 0.f};
        const f32x4 s0 = (2 * pr >= CBLO && 2 * pr <= CBHI) ? s[2 * pr] : z, s1 = (2 * pr + 1 >= CBLO && 2 * pr + 1 <= CBHI) ? s[2 * pr + 1] : z;
        u32x4 pw; pw.x = cvtpk(s0[0], s0[1]); pw.y = cvtpk(s0[2], s0[3]); pw.z = cvtpk(s1[0], s1[1]); pw.w = cvtpk(s1[2], s1[3]);
        const bf16x8 pf = __builtin_bit_cast(bf16x8, pw);
#pragma unroll
        for (int db = 0; db < 4; ++db) {
            const LAS unsigned char* vp = vt + (32 * pr + 4 * g + (ql >> 2)) * PITCH + (16 * db + 4 * (ql & 3)) * 2;
            const s16x4 t0 = lds_tr16(vp), t1 = lds_tr16(vp + 16 * PITCH);
            const bf16x8 vf = (bf16x8){t0[0], t0[1], t0[2], t0[3], t1[0], t1[1], t1[2], t1[3]};
            o[db] = __builtin_amdgcn_mfma_f32_16x16x32_bf16(vf, pf, o[db], 0, 0, 0); } }
}
__device__ __forceinline__ void attn_phase(const Ctx& X0, const PArgs& a, int j_na, bool with_ctx) {
    const Ctx X = fresh_ctx(X0);
    unsigned char* ws = a.ws;
    const bf16_t* Q = (const bf16_t*)(ws + WS_Q); const bf16_t* K = (const bf16_t*)(ws + WS_K); const bf16_t* V = (const bf16_t*)(ws + WS_V); bf16_t* O = (bf16_t*)(ws + WS_O);
    const float* rpb = a.in(I_NARPB) + (size_t)j_na * NAH * 15 * 31;
    constexpr int PITCH = 272, TILEB = 64 * PITCH;
    LAS unsigned char* Kb = X.lds; LAS unsigned char* Vb = X.lds + 2 * TILEB; LAS float* bl = (LAS float*)(X.lds + 4 * TILEB);
    const int hsel = X.wave >> 2, jb = X.wave & 3, ql = X.lane & 15, g = X.lane >> 4;
    const int nlat = NB * GROWS * 8, nunits = nlat + (with_ctx ? NB * 8 * 4 : 0);
    const int skey = X.tid >> 3, sch = (X.tid & 7) * 16;
    const int qc = 16 * jb + ql, c0 = qc - 8 < 0 ? 0 : (qc - 8 > 48 ? 48 : qc - 8);
    const int nper = (X.G % 8 == 0 && nlat % 8 == 0) ? nlat / 8 : 0, wpx = X.G / 8;
    for (int k = 0; ; ++k) {
        int u;
        if (nper) { const int iu = (X.bid >> 3) + wpx * k; u = iu < nper ? (X.bid & 7) * nper + iu : nlat + (iu - nper) * 8 + (X.bid & 7); }
        else u = X.bid + X.G * k;
        if (u >= nunits) break;
        const bool lat = u < nlat; int b, h0, r = 0, r0 = 0, qrow0, ntl;
        if (lat) { b = u / (GROWS * 8); const int rem = u % (GROWS * 8); h0 = (rem >> 7) * 2; r = rem & 127; r0 = r - 4; r0 = r0 < 0 ? 0 : (r0 > GROWS - 8 ? GROWS - 8 : r0); qrow0 = b * SEQ + r * GRIDW; ntl = 12; }
        else { const int v = u - nlat; b = v >> 5; h0 = ((v >> 2) & 7) * 2; qrow0 = NLAT + b * CTXL + (v & 3) * 64; ntl = 4; }
        const int h = h0 + hsel;
        bf16x8 qf[2];
        { const bf16_t* qp = Q + (size_t)(qrow0 + 16 * jb + ql) * D + h * 64 + 8 * g; qf[0] = *(const bf16x8*)qp; qf[1] = *(const bf16x8*)(qp + 32); }
        __syncthreads();
        if (lat) for (int idx = X.tid; idx < 512; idx += 512) { const int hh = idx >> 8, i = (idx >> 5) & 7, dc = idx & 31; bl[idx] = dc < 31 ? rpb[((h0 + hh) * 15 + (r0 + i - r + 7)) * 31 + dc] * 1.4426950408889634f : 0.f; }
        float m = -1.0e30f, lsum = 0.f; f32x4 o[4];
#pragma unroll
        for (int i = 0; i < 4; ++i) o[i] = (f32x4){0.f, 0.f, 0.f, 0.f};
        u32x4 kr[2], vr[2];
        { const int krow0 = lat ? b * SEQ + r0 * GRIDW : NLAT + b * CTXL; const size_t go = (size_t)(krow0 + skey) * D + h0 * 64 + sch;
          kr[0] = *(const u32x4*)(K + go); kr[1] = *(const u32x4*)(K + go + 8); vr[0] = *(const u32x4*)(V + go); vr[1] = *(const u32x4*)(V + go + 8); }
        for (int tl = 0; tl < ntl; ++tl) {
            const int buf = tl & 1;
            { LAS unsigned char* kd = Kb + buf * TILEB + skey * PITCH + sch * 2; LAS unsigned char* vd = Vb + buf * TILEB + skey * PITCH + sch * 2;
              *(LAS u32x4*)kd = kr[0]; *(LAS u32x4*)(kd + 16) = kr[1]; *(LAS u32x4*)vd = vr[0]; *(LAS u32x4*)(vd + 16) = vr[1]; }
            __syncthreads();
            if (tl + 1 < ntl) { const int t1 = tl + 1; const int krow0 = (lat && t1 < 8) ? b * SEQ + (r0 + t1) * GRIDW : NLAT + b * CTXL + (lat ? t1 - 8 : t1) * 64;
                const size_t go = (size_t)(krow0 + skey) * D + h0 * 64 + sch;
                kr[0] = *(const u32x4*)(K + go); kr[1] = *(const u32x4*)(K + go + 8); vr[0] = *(const u32x4*)(V + go); vr[1] = *(const u32x4*)(V + go + 8); }
            const bool local = lat && tl < 8;
            const LAS unsigned char* kt = Kb + buf * TILEB + hsel * 128; const LAS unsigned char* vt = Vb + buf * TILEB + hsel * 128; const LAS float* blr = bl + hsel * 256 + tl * 32;
            if (!local) attn_tile<0, 3, false>(kt, vt, blr, qf, m, lsum, o, ql, g, qc, c0);
            else if (jb == 0) attn_tile<0, 1, true>(kt, vt, blr, qf, m, lsum, o, ql, g, qc, c0);
            else if (jb == 1) attn_tile<0, 2, true>(kt, vt, blr, qf, m, lsum, o, ql, g, qc, c0);
            else if (jb == 2) attn_tile<1, 3, true>(kt, vt, blr, qf, m, lsum, o, ql, g, qc, c0);
            else attn_tile<2, 3, true>(kt, vt, blr, qf, m, lsum, o, ql, g, qc, c0);
        }
        lsum += __shfl_xor(lsum, 16); lsum += __shfl_xor(lsum, 32);
        const float inv = 1.0f / lsum;
        bf16_t* op = O + (size_t)(qrow0 + 16 * jb + ql) * D + h * 64 + 4 * g;
#pragma unroll
        for (int db = 0; db < 4; ++db) { u32x2 w; w.x = cvtpk(o[db][0] * inv, o[db][1] * inv); w.y = cvtpk(o[db][2] * inv, o[db][3] * inv); *(u32x2*)(op + 16 * db) = w; }
    }
}

constexpr size_t WS_GW = 931 * MiB, WS_DEN = 934 * MiB;
constexpr int QK_PITCH = 1040;
__device__ __forceinline__ int tb_row0(int b, int tb) { return tb < 4 ? NLAT + b * CTXL + tb * 64 : b * SEQ + (tb - 4) * 64; }
template <class RowMap>
__device__ __forceinline__ void stage_qk_direct(const Ctx& X, const bf16_t* XC, int h, const float* wq, const float* wk, LAS unsigned char* qL, LAS unsigned char* kL, const RowMap& rowmap) {
    const int bc = X.tid & 127, nbq = h * 128 + bc, rr = X.tid >> 7; const float kscale = 0.044194173824159216f;
    float wqr[16], wkr[16];
#pragma unroll
    for (int i = 0; i < 16; ++i) { wqr[i] = wq[nbq * 16 + i]; wkr[i] = wk[nbq * 16 + i] * kscale; }
#pragma unroll 4
    for (int i = 0; i < 16; ++i) { const int tl = rr + 4 * i; const int row = rowmap(tl);
        const u32x2 w = *(const u32x2*)(XC + (size_t)row * MLI + h * 512 + 4 * bc);
        const float x0 = bf_lo(w.x), x1 = bf_hi(w.x), x2 = bf_lo(w.y), x3 = bf_hi(w.y);
        float qo[4], ko[4];
#pragma unroll
        for (int dd = 0; dd < 4; ++dd) { qo[dd] = x0 * wqr[dd] + x1 * wqr[4 + dd] + x2 * wqr[8 + dd] + x3 * wqr[12 + dd]; ko[dd] = x0 * wkr[dd] + x1 * wkr[4 + dd] + x2 * wkr[8 + dd] + x3 * wkr[12 + dd]; }
        u32x2 oq, ok; oq.x = cvtpk(qo[0], qo[1]); oq.y = cvtpk(qo[2], qo[3]); ok.x = cvtpk(ko[0], ko[1]); ok.y = cvtpk(ko[2], ko[3]);
        *(LAS u32x2*)(qL + tl * QK_PITCH + 8 * bc) = oq; *(LAS u32x2*)(kL + tl * QK_PITCH + 8 * bc) = ok; }
}
__device__ __forceinline__ void scanA_phase(const Ctx& X0, const PArgs& a) {
    const Ctx X = fresh_ctx(X0);
    unsigned char* ws = a.ws;
    const bf16_t* XM = (const bf16_t*)(ws + WS_XM); const bf16_t* XC = (const bf16_t*)(ws + WS_XC); const float* GT = (const float*)(ws + WS_GT);
    float* GW = (float*)(ws + WS_GW); float* DEN = (float*)(ws + WS_DEN);
    LAS unsigned char* qL = X.lds; LAS unsigned char* kL = X.lds + 64 * QK_PITCH; LAS unsigned char* atL = X.lds + 128 * QK_PITCH;
    LAS unsigned char* vtL = X.lds;
    LAS float* gl = (LAS float*)(X.lds + 128 * QK_PITCH + 2 * 64 * 144);
    constexpr int AP = 144;
    const int ql = X.lane & 15, g = X.lane >> 4;
    for (int item = X.bid; item < NB * MLH * 132; item += X.G) {
        const int b = item / (MLH * 132), rem = item % (MLH * 132), h = rem / 132, tb = rem % 132, R0 = tb_row0(b, tb);
        __syncthreads();
        stage_qk_direct(X, XC, h, a.in(I_MLWQ), a.in(I_MLWK), qL, kL, [&](int tl) { return R0 + tl; });
        if (X.wave == 0) {
            const float* gp = GT + (size_t)(R0 + X.lane) * 16;
            const float i_f = gp[h], f_f = gp[4 + h], i_b = gp[8 + h], f_b = gp[12 + h];
            const float lf = fminf(f_f, 0.f) - log1pf(expf(-fabsf(f_f))), lb = fminf(f_b, 0.f) - log1pf(expf(-fabsf(f_b)));
            float cf = lf, cb = lb;
#pragma unroll
            for (int o = 1; o < 64; o <<= 1) { const float tf = __shfl_up(cf, o), tb2 = __shfl_down(cb, o); if (X.lane >= o) cf += tf; if (X.lane + o < 64) cb += tb2; }
            gl[X.lane] = cf; gl[64 + X.lane] = cb; gl[128 + X.lane] = i_f; gl[192 + X.lane] = i_b;
            const float cfT = __shfl(cf, 63), cbT = __shfl(cb, 0);
            float* gw = GW + ((size_t)(R0 + X.lane) * 8 + h) * 2;
            gw[0] = expf(cf); gw[1] = expf(cfT - cf + i_f); gw[8] = expf(cb); gw[9] = expf(cbT - cb + i_b);
        }
        __syncthreads();
        { const int tt = X.wave & 3, sh = X.wave >> 2;
          f32x4 s2[2] = {(f32x4){0.f, 0.f, 0.f, 0.f}, (f32x4){0.f, 0.f, 0.f, 0.f}};
          const LAS unsigned char* qa = qL + (16 * tt + ql) * QK_PITCH + 16 * g; const LAS unsigned char* ka = kL + (32 * sh + ql) * QK_PITCH + 16 * g;
#pragma unroll 4
          for (int ks = 0; ks < 16; ++ks) { const bf16x8 qf = *(const LAS bf16x8*)(qa + 64 * ks), k0 = *(const LAS bf16x8*)(ka + 64 * ks), k1 = *(const LAS bf16x8*)(ka + 16 * QK_PITCH + 64 * ks);
              s2[0] = __builtin_amdgcn_mfma_f32_16x16x32_bf16(k0, qf, s2[0], 0, 0, 0); s2[1] = __builtin_amdgcn_mfma_f32_16x16x32_bf16(k1, qf, s2[1], 0, 0, 0); }
          const int t = 16 * tt + ql; const float bft = gl[t], bbt = gl[64 + t];
#pragma unroll
          for (int i = 0; i < 2; ++i) { float af[4], ab[4];
#pragma unroll
              for (int rg = 0; rg < 4; ++rg) { const int s = 32 * sh + 16 * i + 4 * g + rg; const float v = s2[i][rg];
                  af[rg] = (s <= t) ? v * __expf(bft - gl[s] + gl[128 + s]) : 0.f; ab[rg] = (s >= t) ? v * __expf(bbt - gl[64 + s] + gl[192 + s]) : 0.f; }
              u32x2 wf, wb; wf.x = cvtpk(af[0], af[1]); wf.y = cvtpk(af[2], af[3]); wb.x = cvtpk(ab[0], ab[1]); wb.y = cvtpk(ab[2], ab[3]);
              *(LAS u32x2*)(atL + t * AP + (32 * sh + 16 * i + 4 * g) * 2) = wf; *(LAS u32x2*)(atL + 64 * AP + t * AP + (32 * sh + 16 * i + 4 * g) * 2) = wb; } }
        __syncthreads();
        { const int bc = X.tid & 127, sg = X.tid >> 7, nb = h * 128 + bc; const float* pv = a.in(I_MLWV) + nb * 16; float wvr[16];
#pragma unroll
          for (int i = 0; i < 16; ++i) wvr[i] = pv[i];
#pragma unroll
          for (int i = 0; i < 4; ++i) { const int s0 = 16 * i + 4 * sg; float vv[4][4];
#pragma unroll
              for (int r = 0; r < 4; ++r) { const u32x2 w = *(const u32x2*)(XM + (size_t)(R0 + s0 + r) * MLI + 4 * nb); const float x0 = bf_lo(w.x), x1 = bf_hi(w.x), x2 = bf_lo(w.y), x3 = bf_hi(w.y);
#pragma unroll
                  for (int dd = 0; dd < 4; ++dd) vv[r][dd] = x0 * wvr[dd] + x1 * wvr[4 + dd] + x2 * wvr[8 + dd] + x3 * wvr[12 + dd]; }
#pragma unroll
              for (int dd = 0; dd < 4; ++dd) { u32x2 o; o.x = cvtpk(vv[0][dd], vv[1][dd]); o.y = cvtpk(vv[2][dd], vv[3][dd]); *(LAS u32x2*)(vtL + (4 * bc + dd) * AP + s0 * 2) = o; } }
          if (X.tid < 128) { const int dir = X.tid >> 6, t = X.tid & 63; float s = 0.f;
#pragma unroll
              for (int c = 0; c < 8; ++c) { const u32x4 w = *(const LAS u32x4*)(atL + dir * 64 * AP + t * AP + 16 * c); s += (bf_lo(w.x) + bf_hi(w.x)) + (bf_lo(w.y) + bf_hi(w.y)) + (bf_lo(w.z) + bf_hi(w.z)) + (bf_lo(w.w) + bf_hi(w.w)); }
              DEN[((size_t)(R0 + t) * 2 + dir) * 4 + h] = s; } }
        __syncthreads();
        { bf16x8 vf[4][2];
#pragma unroll
          for (int dt = 0; dt < 4; ++dt)
#pragma unroll
              for (int ks = 0; ks < 2; ++ks) vf[dt][ks] = *(const LAS bf16x8*)(vtL + (64 * X.wave + 16 * dt + ql) * AP + 64 * ks + 16 * g);
#pragma unroll
          for (int dir = 0; dir < 2; ++dir) { bf16_t* HO = (bf16_t*)(ws + (dir ? WS_HB : WS_HF));
#pragma unroll
              for (int tt = 0; tt < 4; ++tt) { f32x4 acc[4];
#pragma unroll
                  for (int dt = 0; dt < 4; ++dt) acc[dt] = (f32x4){0.f, 0.f, 0.f, 0.f};
#pragma unroll
                  for (int ks = 0; ks < 2; ++ks) { const bf16x8 af = *(const LAS bf16x8*)(atL + dir * 64 * AP + (16 * tt + ql) * AP + 64 * ks + 16 * g);
#pragma unroll
                      for (int dt = 0; dt < 4; ++dt) acc[dt] = __builtin_amdgcn_mfma_f32_16x16x32_bf16(vf[dt][ks], af, acc[dt], 0, 0, 0); }
                  bf16_t* op = HO + (size_t)(R0 + 16 * tt + ql) * MLI + h * 512 + 64 * X.wave + 4 * g;
#pragma unroll
                  for (int dt = 0; dt < 4; ++dt) { u32x2 w; w.x = cvtpk(acc[dt][0], acc[dt][1]); w.y = cvtpk(acc[dt][2], acc[dt][3]); *(u32x2*)(op + 16 * dt) = w; } } } }
    }
}

__device__ __forceinline__ void scanB_phase(const Ctx& X0, const PArgs& a, bool dry = false) {
    const Ctx X = fresh_ctx(X0);
    unsigned char* ws = a.ws;
    const bf16_t* XM = (const bf16_t*)(ws + WS_XM); const bf16_t* XC = (const bf16_t*)(ws + WS_XC); const float* GW = (const float*)(ws + WS_GW); const float* DEN = (const float*)(ws + WS_DEN);
    constexpr int AP = 144;
    LAS unsigned char* qL = X.lds; LAS unsigned char* kL = X.lds + 64 * QK_PITCH; LAS unsigned char* vL = X.lds + 128 * QK_PITCH;
    LAS bf16_t* xL = (LAS bf16_t*)(X.lds + 128 * QK_PITCH + 64 * AP);
    LAS float* sm = (LAS float*)(X.lds + 128 * QK_PITCH + 64 * AP + 8192);
    LAS float* wL = sm; LAS float* wgL = sm + 128; LAS float* denL = sm + 256; LAS float* qnL = sm + 384; LAS float* nL = sm + 448;
    const int db = X.wave & 3, eh = X.wave >> 2;
    const float kscale = 0.044194173824159216f;
    for (int item = X.bid; item < 256; item += X.G) {
        int chain = item >> 3, sl = item & 7;
        if (X.G == 256) { const int k = item >> 3; chain = (k >> 3) * 8 + (item & 7); sl = k & 7; }
        const int b = chain >> 3, h = (chain >> 1) & 3, dir = chain & 1;
        bf16_t* HO = (bf16_t*)(ws + (dir ? WS_HB : WS_HF));
        f32x4 ct[16];
#pragma unroll
        for (int j = 0; j < 16; ++j) ct[j] = (f32x4){0.f, 0.f, 0.f, 0.f};
        float n_e = 0.f;
        const int vb = X.tid & 15, vr = X.tid >> 4;
        bf16x8 aq[2][2], ak[2][2];
        { const int ql0 = X.lane & 15, g0 = X.lane >> 4; const float* wq = a.in(I_MLWQ); const float* wk = a.in(I_MLWK);
#pragma unroll
          for (int i = 0; i < 2; ++i)
#pragma unroll
              for (int nt = 0; nt < 2; ++nt) { float fq[8], fk[8];
#pragma unroll
                  for (int j = 0; j < 8; ++j) { const int cl = 8 * g0 + j, nl = 16 * nt + ql0; const bool on = (cl >> 2) == (nl >> 2);
                      const int nb = h * 128 + ((64 * X.wave + 32 * i + cl) >> 2); const int wi = nb * 16 + (cl & 3) * 4 + (nl & 3);
                      fq[j] = on ? wq[wi] : 0.f; fk[j] = on ? wk[wi] * kscale : 0.f; }
                  u32x4 pq, pk; pq.x = cvtpk(fq[0], fq[1]); pq.y = cvtpk(fq[2], fq[3]); pq.z = cvtpk(fq[4], fq[5]); pq.w = cvtpk(fq[6], fq[7]);
                  pk.x = cvtpk(fk[0], fk[1]); pk.y = cvtpk(fk[2], fk[3]); pk.z = cvtpk(fk[4], fk[5]); pk.w = cvtpk(fk[6], fk[7]);
                  aq[i][nt] = __builtin_bit_cast(bf16x8, pq); ak[i][nt] = __builtin_bit_cast(bf16x8, pk); } }
        const float* wvp = a.in(I_MLWV) + (h * 128 + sl * 16) * 16;
        u32x4 pxc[2][4]; u32x2 pxm[2]; float pw = 0.f, pwg = 0.f, pden = 0.f;
        const int rstep = dir ? -1 : 1;
#define SCB_RB(ch_) (((ch_) < 4) ? (NLAT + b * CTXL + (dir ? CTXL - 1 - 64 * (ch_) : 64 * (ch_))) : (b * SEQ + (dir ? SEQ - 1 - 64 * ((ch_) - 4) : 64 * ((ch_) - 4))))
#define SCB_LOAD(ch_) do { const int rbn_ = SCB_RB(ch_); const int ltid_ = ltid; _Pragma("unroll") for (int i = 0; i < 2; ++i) _Pragma("unroll") for (int tt = 0; tt < 4; ++tt) pxc[i][tt] = *(const u32x4*)(XC + (size_t)(rbn_ + rstep * (16 * tt + pql)) * MLI + xcoff + 32 * i); \
            _Pragma("unroll") for (int i = 0; i < 2; ++i) pxm[i] = *(const u32x2*)(XM + (size_t)(rbn_ + rstep * (2 * vr + i)) * MLI + xmoff); \
            if (ltid_ < 64) { const int row_ = rbn_ + rstep * ltid_; const float* gw_ = GW + (((size_t)row_ * 2 + dir) * 4 + h) * 2; pw = gw_[0]; pwg = gw_[1]; pden = DEN[((size_t)row_ * 2 + dir) * 4 + h]; } } while (0)
        { const int ltid = X.tid, pql = X.lane & 15; const size_t xcoff = (size_t)h * 512 + 64 * X.wave + 8 * (X.lane >> 4), xmoff = (size_t)h * 512 + sl * 64 + 4 * vb; SCB_LOAD(0); }
        for (int ch = 0; ch < (CTXL + SEQ) / 64; ++ch) {
            const int buf = ch & 1;
            { const int t1 = launder_i(X.tid); const int vb = t1 & 15, vr = t1 >> 4, sql = t1 & 15, sg = (t1 >> 4) & 3;
            nL[t1] = n_e;
            f32x4 wv4[4];
#pragma unroll
            for (int i = 0; i < 4; ++i) wv4[i] = *(const f32x4*)(wvp + vb * 16 + 4 * i);
            { const f32x4 zero4 = (f32x4){0.f, 0.f, 0.f, 0.f};
#pragma unroll
              for (int i = 0; i < 2; ++i)
#pragma unroll
                  for (int tt = 0; tt < 4; ++tt) { const bf16x8 xb = __builtin_bit_cast(bf16x8, pxc[i][tt]);
#pragma unroll
                      for (int nt = 0; nt < 2; ++nt) { const f32x4 dq = __builtin_amdgcn_mfma_f32_16x16x32_bf16(aq[i][nt], xb, zero4, 0, 0, 0), dk = __builtin_amdgcn_mfma_f32_16x16x32_bf16(ak[i][nt], xb, zero4, 0, 0, 0);
                          u32x2 oq, ok; oq.x = cvtpk(dq[0], dq[1]); oq.y = cvtpk(dq[2], dq[3]); ok.x = cvtpk(dk[0], dk[1]); ok.y = cvtpk(dk[2], dk[3]);
                          const int off = (16 * tt + sql) * QK_PITCH + (64 * X.wave + 32 * i + 16 * nt + 4 * sg) * 2;
                          *(LAS u32x2*)(qL + off) = oq; *(LAS u32x2*)(kL + off) = ok; } } }
            { float vv[2][4];
#pragma unroll
              for (int i = 0; i < 2; ++i) { const u32x2 w = pxm[i]; const float x0 = bf_lo(w.x), x1 = bf_hi(w.x), x2 = bf_lo(w.y), x3 = bf_hi(w.y);
#pragma unroll
                  for (int dd = 0; dd < 4; ++dd) vv[i][dd] = x0 * wv4[0][dd] + x1 * wv4[1][dd] + x2 * wv4[2][dd] + x3 * wv4[3][dd]; }
#pragma unroll
              for (int dd = 0; dd < 4; ++dd) *(LAS unsigned*)(vL + (4 * vb + dd) * AP + (2 * vr) * 2) = cvtpk(vv[0][dd], vv[1][dd]); }
            if (t1 < 64) { wL[buf * 64 + t1] = pw; wgL[buf * 64 + t1] = pwg; denL[buf * 64 + t1] = pden; } }
            asm volatile("s_waitcnt lgkmcnt(0)\n\ts_barrier" ::: "memory");
            if (ch + 1 < (CTXL + SEQ) / 64) { const int ltid = launder_i(X.tid); const int vb = ltid & 15, vr = ltid >> 4, pql = ltid & 15;
                const size_t xcoff = (size_t)h * 512 + 64 * X.wave + 8 * ((ltid >> 4) & 3), xmoff = (size_t)h * 512 + sl * 64 + 4 * vb; SCB_LOAD(ch + 1); }
            const int rb0 = SCB_RB(ch);
            const int l2 = launder_i(X.lane); const int ql = l2 & 15, g = l2 >> 4; const size_t hooff = (size_t)h * 512 + sl * 64 + 16 * db + 4 * g;
            u32x2 ni[4];
            if (eh == 0) {
#pragma unroll
                for (int tt = 0; tt < 4; ++tt) ni[tt] = *(const u32x2*)(HO + (size_t)(rb0 + rstep * (16 * tt + ql)) * MLI + hooff);
            }
            f32x4 acc[4];
#pragma unroll
            for (int tt = 0; tt < 4; ++tt) acc[tt] = (f32x4){0.f, 0.f, 0.f, 0.f};
#pragma unroll
            for (int kp = 0; kp < 8; ++kp) {
                u32x4 cw; cw.x = cvtpk(ct[2 * kp][0], ct[2 * kp][1]); cw.y = cvtpk(ct[2 * kp][2], ct[2 * kp][3]); cw.z = cvtpk(ct[2 * kp + 1][0], ct[2 * kp + 1][1]); cw.w = cvtpk(ct[2 * kp + 1][2], ct[2 * kp + 1][3]);
                const bf16x8 cf = __builtin_bit_cast(bf16x8, cw);
#pragma unroll
                for (int tt = 0; tt < 4; ++tt) { const LAS unsigned char* qp = qL + (16 * tt + ql) * QK_PITCH + (eh * 256 + 32 * kp + 4 * g) * 2;
                    const u32x2 lo = *(const LAS u32x2*)qp, hi = *(const LAS u32x2*)(qp + 32); const u32x4 qa = {lo.x, lo.y, hi.x, hi.y};
                    acc[tt] = __builtin_amdgcn_mfma_f32_16x16x32_bf16(cf, __builtin_bit_cast(bf16x8, qa), acc[tt], 0, 0, 0); } }
            if (eh == 1) {
#pragma unroll
                for (int tt = 0; tt < 4; ++tt) { u32x2 w; w.x = cvtpk(acc[tt][0], acc[tt][1]); w.y = cvtpk(acc[tt][2], acc[tt][3]); *(LAS u32x2*)(xL + (db * 64 + 16 * tt + ql) * 16 + 4 * g) = w; }
            }
            { const int t3 = launder_i(X.tid); const int t = t3 >> 3, part = t3 & 7; float s = 0.f;
#pragma unroll
              for (int c = 0; c < 8; ++c) { const u32x4 w = *(const LAS u32x4*)(qL + t * QK_PITCH + (64 * part + 8 * c) * 2); const f32x4 n0 = *(const LAS f32x4*)(nL + 64 * part + 8 * c), n1 = *(const LAS f32x4*)(nL + 64 * part + 8 * c + 4);
                  s += bf_lo(w.x) * n0[0] + bf_hi(w.x) * n0[1] + bf_lo(w.y) * n0[2] + bf_hi(w.y) * n0[3] + bf_lo(w.z) * n1[0] + bf_hi(w.z) * n1[1] + bf_lo(w.w) * n1[2] + bf_hi(w.w) * n1[3]; }
              s += swz_xor(s, 1); s += swz_xor(s, 2); s += swz_xor(s, 4);
              if (part == 0) qnL[t] = s; }
            const float decay = wL[buf * 64 + 63];
            { float s = 0.f;
              const int t4 = launder_i(X.tid);
#pragma unroll 8
              for (int sidx = 0; sidx < 64; ++sidx) s += wgL[buf * 64 + sidx] * bf2f(*(const LAS bf16_t*)(kL + sidx * QK_PITCH + t4 * 2));
              n_e = decay * n_e + s; }
#pragma unroll
            for (int j = 0; j < 16; ++j) ct[j] = ct[j] * decay;
            { const int l3 = launder_i(X.lane); const int ql = l3 & 15, g = l3 >> 4;
#pragma unroll
            for (int ks = 0; ks < 2; ++ks) {
                const u32x4 vraw = *(const LAS u32x4*)(vL + (16 * db + ql) * AP + 64 * ks + 16 * g);
                const f32x4 w0 = *(const LAS f32x4*)(wgL + buf * 64 + 32 * ks + 8 * g), w1 = *(const LAS f32x4*)(wgL + buf * 64 + 32 * ks + 8 * g + 4);
                u32x4 vw; vw.x = cvtpk(bf_lo(vraw.x) * w0[0], bf_hi(vraw.x) * w0[1]); vw.y = cvtpk(bf_lo(vraw.y) * w0[2], bf_hi(vraw.y) * w0[3]);
                vw.z = cvtpk(bf_lo(vraw.z) * w1[0], bf_hi(vraw.z) * w1[1]); vw.w = cvtpk(bf_lo(vraw.w) * w1[2], bf_hi(vraw.w) * w1[3]);
                const bf16x8 vf = __builtin_bit_cast(bf16x8, vw);
#pragma unroll
                for (int j = 0; j < 16; ++j) { const LAS unsigned char* kp2 = kL + (32 * ks + 8 * g + (ql >> 2)) * QK_PITCH + (eh * 256 + 16 * j + 4 * (ql & 3)) * 2;
                    const s16x4 t0 = lds_tr16(kp2), t1 = lds_tr16(kp2 + 4 * QK_PITCH);
                    const bf16x8 kf = (bf16x8){t0[0], t0[1], t0[2], t0[3], t1[0], t1[1], t1[2], t1[3]};
                    ct[j] = __builtin_amdgcn_mfma_f32_16x16x32_bf16(kf, vf, ct[j], 0, 0, 0); } } }
            asm volatile("s_waitcnt lgkmcnt(0)\n\ts_barrier" ::: "memory");
            if (eh == 0) {
#pragma unroll
                for (int tt = 0; tt < 4; ++tt) { const int t = 16 * tt + ql; const float w = wL[buf * 64 + t]; const float den = denL[buf * 64 + t] + w * qnL[t];
                    const float sc = 1.0f / (fabsf(den) > 1.0f ? fabsf(den) : 1.0f); const u32x2 xw = *(const LAS u32x2*)(xL + (db * 64 + t) * 16 + 4 * g);
                    const float o0 = (bf_lo(ni[tt].x) + w * (acc[tt][0] + bf_lo(xw.x))) * sc, o1 = (bf_hi(ni[tt].x) + w * (acc[tt][1] + bf_hi(xw.x))) * sc;
                    const float o2 = (bf_lo(ni[tt].y) + w * (acc[tt][2] + bf_lo(xw.y))) * sc, o3 = (bf_hi(ni[tt].y) + w * (acc[tt][3] + bf_hi(xw.y))) * sc;
                    u32x2 ow; ow.x = cvtpk(o0, o1); ow.y = cvtpk(o2, o3); if (!dry) *(u32x2*)(HO + (size_t)(rb0 + rstep * t) * MLI + hooff) = ow; }
            }
        }
#undef SCB_RB
#undef SCB_LOAD
    }
}
constexpr size_t WS_GT8 = 946 * MiB;
constexpr size_t WS_ZC = 132 * MiB;
constexpr size_t WS_QG = WS_R + 132 * MiB, WS_KG = WS_R + 264 * MiB, WS_Z2 = WS_QG, WS_OA2 = WS_KG, WS_WBD = WS_WGT + 131072;

__device__ __forceinline__ void feat2_phase(const Ctx& X0, const PArgs& a, bool fewld = false) {
    const Ctx X = fresh_ctx(X0);
    unsigned char* ws = a.ws;
    const bf16_t* XM = (const bf16_t*)(ws + WS_XM); bf16_t* QG = (bf16_t*)(ws + WS_QG); bf16_t* KG = (bf16_t*)(ws + WS_KG); float* GT = (float*)(ws + WS_GT8);
    const bf16_t* G1T = (const bf16_t*)(ws + WS_WGT); const bf16_t* G2T = G1T + 16 * MLI; const u32x4* WBD = (const u32x4*)(ws + WS_WBD);
    LAS float* cwl = (LAS float*)X.lds;
    { const float* cw = a.in(I_MLCONVW); const float* cb = a.in(I_MLCONVB);
      for (int i = X.tid; i < 4 * MLI; i += 512) cwl[i] = cw[i];
      for (int i = X.tid; i < MLI; i += 512) cwl[4 * MLI + i] = cb[i]; }
    const int fr = X.lane & 15, fq = X.lane >> 4;
    const bool lp = (X.G & 7) == 0; const int mypart = X.bid & 7;
    LAS u32x4* wbL = (LAS u32x4*)(X.lds + 40960); LAS bf16x8* g1L = (LAS bf16x8*)(X.lds + 73728); LAS bf16x8* g2L = (LAS bf16x8*)(X.lds + 81920);
    if (lp) { for (int i = X.tid; i < 2048; i += 512) wbL[i] = WBD[mypart * 2048 + i];
              { const int j = X.tid >> 6, l = X.tid & 63, c0_ = 32 * (8 * mypart + j) + 8 * (l >> 4); g1L[X.tid] = *(const bf16x8*)(G1T + (size_t)(l & 15) * MLI + c0_); g2L[X.tid] = *(const bf16x8*)(G2T + (size_t)(l & 15) * MLI + c0_); } }
    __syncthreads();
    const int it_lo = lp ? (X.bid >> 3) * 8 + X.wave : X.bid * 8 + X.wave, it_hi = lp ? MT / 16 : 8 * (MT / 16), it_st = lp ? X.G : X.G * 8;
    for (int it8 = it_lo; it8 < it_hi; it8 += it_st) {
        const int item = lp ? it8 : it8 >> 3, part = lp ? mypart : it8 & 7;
        const int row = item * 16 + fr; int base, t, len; seq_of_row(row, base, t, len);
        f32x4 acc = (f32x4){0.f, 0.f, 0.f, 0.f}; const f32x4 zero4 = (f32x4){0.f, 0.f, 0.f, 0.f};
        const bool v0 = t >= 2, v1 = t >= 1, v3 = t + 1 < len;
        const bf16_t* xr = XM + (size_t)row * MLI + 8 * fq;
        u32x4 w[4], wf[4]; bf16x8 b1, b2; const u32x4 z4 = (u32x4){0u, 0u, 0u, 0u};
#define FT_W_LOADS(jj_) if (fewld) { w[2] = *(const u32x4*)(xr + 32 * (jj_)); w[0] = v0 ? w[2] : z4; w[1] = v1 ? w[2] : z4; w[3] = v3 ? w[2] : z4; } else { \
            w[0] = v0 ? *(const u32x4*)(xr + 32 * (jj_) - 2 * MLI) : z4; w[1] = v1 ? *(const u32x4*)(xr + 32 * (jj_) - MLI) : z4; w[2] = *(const u32x4*)(xr + 32 * (jj_)); w[3] = v3 ? *(const u32x4*)(xr + 32 * (jj_) + MLI) : z4; }
#define FT_LOAD(jj_) do { const int c0_ = 32 * (jj_) + 8 * fq; \
            FT_W_LOADS(jj_) \
            if (lp) { b1 = g1L[((jj_) & 7) * 64 + X.lane]; b2 = g2L[((jj_) & 7) * 64 + X.lane]; _Pragma("unroll") for (int k_ = 0; k_ < 4; ++k_) wf[k_] = wbL[(((jj_) & 7) * 4 + k_) * 64 + X.lane]; } \
            else { b1 = *(const bf16x8*)(G1T + (size_t)fr * MLI + c0_); b2 = *(const bf16x8*)(G2T + (size_t)fr * MLI + c0_); \
            _Pragma("unroll") for (int k_ = 0; k_ < 4; ++k_) wf[k_] = WBD[((jj_) * 4 + k_) * 64 + X.lane]; } } while (0)
        u32x4 wB[4], wfB[4]; bf16x8 b1B, b2B;
#define FT_LOAD2(jj_) do { const int c0_ = 32 * (jj_) + 8 * fq; \
            wB[0] = v0 ? *(const u32x4*)(xr + 32 * (jj_) - 2 * MLI) : z4; wB[1] = v1 ? *(const u32x4*)(xr + 32 * (jj_) - MLI) : z4; wB[2] = *(const u32x4*)(xr + 32 * (jj_)); wB[3] = v3 ? *(const u32x4*)(xr + 32 * (jj_) + MLI) : z4; \
            if (lp) { b1B = g1L[((jj_) & 7) * 64 + X.lane]; b2B = g2L[((jj_) & 7) * 64 + X.lane]; _Pragma("unroll") for (int k_ = 0; k_ < 4; ++k_) wfB[k_] = wbL[(((jj_) & 7) * 4 + k_) * 64 + X.lane]; } \
            else { b1B = *(const bf16x8*)(G1T + (size_t)fr * MLI + c0_); b2B = *(const bf16x8*)(G2T + (size_t)fr * MLI + c0_); \
            _Pragma("unroll") for (int k_ = 0; k_ < 4; ++k_) wfB[k_] = WBD[((jj_) * 4 + k_) * 64 + X.lane]; } } while (0)
        auto step = [&](const int jj, u32x4 (&cw4)[4], u32x4 (&cwf)[4], bf16x8& cb1, bf16x8& cb2, auto reload) {
            const int c0 = 32 * jj + 8 * fq;
            float xc[8];
            { const f32x4 ba = *(const LAS f32x4*)(cwl + 4 * MLI + c0), bb = *(const LAS f32x4*)(cwl + 4 * MLI + c0 + 4);
              xc[0] = ba[0]; xc[1] = ba[1]; xc[2] = ba[2]; xc[3] = ba[3]; xc[4] = bb[0]; xc[5] = bb[1]; xc[6] = bb[2]; xc[7] = bb[3]; }
#pragma unroll
            for (int tap = 0; tap < 4; ++tap) { const f32x4 ca = *(const LAS f32x4*)(cwl + tap * MLI + c0), cc = *(const LAS f32x4*)(cwl + tap * MLI + c0 + 4);
                xc[0] += bf_lo(cw4[tap].x) * ca[0]; xc[1] += bf_hi(cw4[tap].x) * ca[1]; xc[2] += bf_lo(cw4[tap].y) * ca[2]; xc[3] += bf_hi(cw4[tap].y) * ca[3];
                xc[4] += bf_lo(cw4[tap].z) * cc[0]; xc[5] += bf_hi(cw4[tap].z) * cc[1]; xc[6] += bf_lo(cw4[tap].w) * cc[2]; xc[7] += bf_hi(cw4[tap].w) * cc[3]; }
#pragma unroll
            for (int i = 0; i < 8; ++i) xc[i] = silu_f(xc[i]);
            u32x4 o; o.x = cvtpk(xc[0], xc[1]); o.y = cvtpk(xc[2], xc[3]); o.z = cvtpk(xc[4], xc[5]); o.w = cvtpk(xc[6], xc[7]);
            const bf16x8 xf = __builtin_bit_cast(bf16x8, o);
            acc = __builtin_amdgcn_mfma_f32_16x16x32_bf16(xf, cb1, acc, 0, 0, 0);
            acc = __builtin_amdgcn_mfma_f32_16x16x32_bf16(__builtin_bit_cast(bf16x8, cw4[2]), cb2, acc, 0, 0, 0);
            { const f32x4 dq0 = __builtin_amdgcn_mfma_f32_16x16x32_bf16(__builtin_bit_cast(bf16x8, cwf[0]), xf, zero4, 0, 0, 0), dq1 = __builtin_amdgcn_mfma_f32_16x16x32_bf16(__builtin_bit_cast(bf16x8, cwf[1]), xf, zero4, 0, 0, 0);
              const f32x4 dk0 = __builtin_amdgcn_mfma_f32_16x16x32_bf16(__builtin_bit_cast(bf16x8, cwf[2]), xf, zero4, 0, 0, 0), dk1 = __builtin_amdgcn_mfma_f32_16x16x32_bf16(__builtin_bit_cast(bf16x8, cwf[3]), xf, zero4, 0, 0, 0);
              u32x4 oq, ok; oq.x = cvtpk(dq0[0], dq0[1]); oq.y = cvtpk(dq0[2], dq0[3]); oq.z = cvtpk(dq1[0], dq1[1]); oq.w = cvtpk(dq1[2], dq1[3]);
              ok.x = cvtpk(dk0[0], dk0[1]); ok.y = cvtpk(dk0[2], dk0[3]); ok.z = cvtpk(dk1[0], dk1[1]); ok.w = cvtpk(dk1[2], dk1[3]);
              reload();
              *(u32x4*)(QG + (size_t)((item >> 2) * 64 + (item & 3) * 16 + (jj & 15)) * MLI + (jj >> 4) * 512 + X.lane * 8) = oq;
              *(u32x4*)(KG + (size_t)((item >> 2) * 64 + (item & 3) * 16 + (jj & 15)) * MLI + (jj >> 4) * 512 + X.lane * 8) = ok; }
        };
        FT_LOAD(8 * part); FT_LOAD2(8 * part + 1);
        for (int jj = 8 * part; jj < 8 * part + 8; jj += 2) {
            step(jj, w, wf, b1, b2, [&]() { if (jj + 2 < 8 * part + 8) FT_LOAD(jj + 2); });
            step(jj + 1, wB, wfB, b1B, b2B, [&]() { if (jj + 3 < 8 * part + 8) FT_LOAD2(jj + 3); });
        }
#undef FT_LOAD2
#undef FT_LOAD
#pragma unroll
        for (int r = 0; r < 4; ++r) GT[((size_t)part * MT + item * 16 + 4 * fq + r) * 16 + (fr & 3) * 4 + (fr >> 2)] = acc[r];
    }
}

__device__ __forceinline__ void scanA2_phase(const Ctx& X0, const PArgs& a) {
    const Ctx X = fresh_ctx(X0);
    unsigned char* ws = a.ws;
    const bf16_t* XM = (const bf16_t*)(ws + WS_XM); const bf16_t* QG = (const bf16_t*)(ws + WS_QG); bf16_t* KG = (bf16_t*)(ws + WS_KG); const float* GT = (const float*)(ws + WS_GT8);
    float* GW = (float*)(ws + WS_GW); float* DEN = (float*)(ws + WS_DEN);
    LAS unsigned char* qL = X.lds; LAS unsigned char* kL = X.lds + 64 * QK_PITCH; LAS unsigned char* atL = X.lds + 128 * QK_PITCH;
    LAS unsigned char* vtL = X.lds;
    LAS float* gl = (LAS float*)(X.lds + 128 * QK_PITCH + 2 * 64 * 144);
    constexpr int AP = 144;
    const int ql = X.lane & 15, g = X.lane >> 4;
    u32x4 qn[8], kn[8];
#define SA_LOAD(item_) do { const int b_ = (item_) / (MLH * 132), rem_ = (item_) % (MLH * 132), h_ = rem_ / 132, R0_ = tb_row0(b_, rem_ % 132); \
        _Pragma("unroll") for (int i = 0; i < 8; ++i) { const int id = X.tid + 512 * i; const size_t go = (size_t)(R0_ + (id >> 6)) * MLI + h_ * 512 + (id & 63) * 8; qn[i] = *(const u32x4*)(QG + go); kn[i] = *(const u32x4*)(KG + go); } } while (0)
    if (X.bid < NB * MLH * 132) SA_LOAD(X.bid);
    for (int item = X.bid; item < NB * MLH * 132; item += X.G) {
        const int b = item / (MLH * 132), rem = item % (MLH * 132), h = rem / 132, tb = rem % 132, R0 = tb_row0(b, tb);
        __syncthreads();
#pragma unroll
        for (int i = 0; i < 8; ++i) { const int id = X.tid + 512 * i, rw = id >> 6, pc = id & 63;
            *(LAS u32x4*)(qL + (16 * (rw >> 4) + (pc & 15)) * QK_PITCH + (4 * (rw & 15) + (pc >> 4)) * 16) = qn[i];
            *(LAS u32x4*)(kL + (16 * (rw >> 4) + (pc & 15)) * QK_PITCH + (4 * (rw & 15) + (pc >> 4)) * 16) = kn[i]; }
        if (item + X.G < NB * MLH * 132) SA_LOAD(item + X.G);
        if (X.wave == 0) {
            const float* gp = GT + (size_t)(R0 + X.lane) * 16; const float* bgp = a.in(I_MLBG);
            float i_f = bgp[h], f_f = bgp[4 + h], i_b = bgp[8 + h], f_b = bgp[12 + h];
#pragma unroll
            for (int pp = 0; pp < 8; ++pp) { const f32x4 g4 = *(const f32x4*)(gp + (size_t)pp * MT * 16 + 4 * h); i_f += g4[0]; f_f += g4[1]; i_b += g4[2]; f_b += g4[3]; }
            const float lf = fminf(f_f, 0.f) - log1pf(expf(-fabsf(f_f))), lb = fminf(f_b, 0.f) - log1pf(expf(-fabsf(f_b)));
            float cf = lf, cb = lb;
#pragma unroll
            for (int o = 1; o < 64; o <<= 1) { const float tf = __shfl_up(cf, o), tb2 = __shfl_down(cb, o); if (X.lane >= o) cf += tf; if (X.lane + o < 64) cb += tb2; }
            gl[X.lane] = cf; gl[64 + X.lane] = cb; gl[128 + X.lane] = i_f; gl[192 + X.lane] = i_b;
            const float cfT = __shfl(cf, 63), cbT = __shfl(cb, 0);
            float* gw = GW + ((size_t)(R0 + X.lane) * 8 + h) * 2;
            gw[0] = expf(cf); gw[1] = expf(cfT - cf + i_f); gw[8] = expf(cb); gw[9] = expf(cbT - cb + i_b);
        }
        __syncthreads();
        { const int tt = X.wave & 3, sh = X.wave >> 2;
          f32x4 s2[2] = {(f32x4){0.f, 0.f, 0.f, 0.f}, (f32x4){0.f, 0.f, 0.f, 0.f}};
          const LAS unsigned char* qa = qL + (16 * tt + ql) * QK_PITCH + 16 * g; const LAS unsigned char* ka = kL + (32 * sh + ql) * QK_PITCH + 8 * g;
#pragma unroll 4
          for (int ks = 0; ks < 16; ++ks) { const bf16x8 qf = *(const LAS bf16x8*)(qa + 64 * ks);
              const u32x2 a0 = *(const LAS u32x2*)(ka + 64 * ks), a1 = *(const LAS u32x2*)(ka + 64 * ks + 32), c0 = *(const LAS u32x2*)(ka + 16 * QK_PITCH + 64 * ks), c1 = *(const LAS u32x2*)(ka + 16 * QK_PITCH + 64 * ks + 32);
              const u32x4 k0 = {a0.x, a0.y, a1.x, a1.y}, k1 = {c0.x, c0.y, c1.x, c1.y};
              s2[0] = __builtin_amdgcn_mfma_f32_16x16x32_bf16(__builtin_bit_cast(bf16x8, k0), qf, s2[0], 0, 0, 0); s2[1] = __builtin_amdgcn_mfma_f32_16x16x32_bf16(__builtin_bit_cast(bf16x8, k1), qf, s2[1], 0, 0, 0); }
          const int t = 16 * tt + ql; const float bft = gl[t], bbt = gl[64 + t];
          f32x4 gF[2], gB[2], gI[2], gJ[2];
#pragma unroll
          for (int i = 0; i < 2; ++i) { const int s0 = 32 * sh + 16 * i + 4 * g; gF[i] = *(const LAS f32x4*)(gl + s0); gB[i] = *(const LAS f32x4*)(gl + 64 + s0); gI[i] = *(const LAS f32x4*)(gl + 128 + s0); gJ[i] = *(const LAS f32x4*)(gl + 192 + s0); }
#pragma unroll
          for (int i = 0; i < 2; ++i) { float af[4], ab[4];
#pragma unroll
              for (int rg = 0; rg < 4; ++rg) { const int s = 32 * sh + 16 * i + 4 * g + rg; const float v = s2[i][rg];
                  const float ef = __expf((s <= t) ? bft - gF[i][rg] + gI[i][rg] : 0.f), eb = __expf((s >= t) ? bbt - gB[i][rg] + gJ[i][rg] : 0.f);
                  af[rg] = (s <= t) ? v * ef : 0.f; ab[rg] = (s >= t) ? v * eb : 0.f; }
              u32x2 wf, wb; wf.x = cvtpk(af[0], af[1]); wf.y = cvtpk(af[2], af[3]); wb.x = cvtpk(ab[0], ab[1]); wb.y = cvtpk(ab[2], ab[3]);
              *(LAS u32x2*)(atL + t * AP + (32 * sh + 16 * i + 4 * g) * 2) = wf; *(LAS u32x2*)(atL + 64 * AP + t * AP + (32 * sh + 16 * i + 4 * g) * 2) = wb; } }
        s16x4 kt0[8], kt1[8];
#pragma unroll
        for (int it = 0; it < 8; ++it) { const int ci = X.wave * 32 + it * 4 + g, eb = ci >> 3, oc = ci & 7;
            const LAS unsigned char* kp = kL + (8 * oc + (ql >> 2)) * QK_PITCH + (16 * eb + 4 * (ql & 3)) * 2; kt0[it] = lds_tr16(kp); kt1[it] = lds_tr16(kp + 4 * QK_PITCH); }
#pragma unroll
        for (int it = 0; it < 8; ++it) { const int ci = X.wave * 32 + it * 4 + g, eb = ci >> 3, oc = ci & 7;
            const s16x4 t0 = kt0[it], t1 = kt1[it];
            const bf16x8 kv = (bf16x8){t0[0], t0[1], t0[2], t0[3], t1[0], t1[1], t1[2], t1[3]};
            *(bf16x8*)(KG + (size_t)(R0 + 2 * eb + (oc >> 2)) * MLI + h * 512 + (16 * (oc & 3) + ql) * 8) = kv; }
        __syncthreads();
        { const int bc = X.tid & 127, sg = X.tid >> 7, nb = h * 128 + bc; const float* pv = a.in(I_MLWV) + nb * 16; float wvr[16];
#pragma unroll
          for (int i = 0; i < 16; ++i) wvr[i] = pv[i];
          u32x2 xw[16];
#pragma unroll
          for (int i = 0; i < 4; ++i)
#pragma unroll
              for (int r = 0; r < 4; ++r) xw[4 * i + r] = *(const u32x2*)(XM + (size_t)(R0 + 16 * i + 4 * sg + r) * MLI + 4 * nb);
#pragma unroll
          for (int i = 0; i < 4; ++i) { const int s0 = 16 * i + 4 * sg; float vv[4][4];
#pragma unroll
              for (int r = 0; r < 4; ++r) { const u32x2 w = xw[4 * i + r]; const float x0 = bf_lo(w.x), x1 = bf_hi(w.x), x2 = bf_lo(w.y), x3 = bf_hi(w.y);
#pragma unroll
                  for (int dd = 0; dd < 4; ++dd) vv[r][dd] = x0 * wvr[dd] + x1 * wvr[4 + dd] + x2 * wvr[8 + dd] + x3 * wvr[12 + dd]; }
#pragma unroll
              for (int dd = 0; dd < 4; ++dd) { u32x2 o; o.x = cvtpk(vv[0][dd], vv[1][dd]); o.y = cvtpk(vv[2][dd], vv[3][dd]); *(LAS u32x2*)(vtL + (4 * bc + dd) * AP + s0 * 2) = o; } }
          if (X.tid < 128) { const int dir = X.tid >> 6, t = X.tid & 63; float s = 0.f;
#pragma unroll
              for (int c = 0; c < 8; ++c) { const u32x4 w = *(const LAS u32x4*)(atL + dir * 64 * AP + t * AP + 16 * c); s += (bf_lo(w.x) + bf_hi(w.x)) + (bf_lo(w.y) + bf_hi(w.y)) + (bf_lo(w.z) + bf_hi(w.z)) + (bf_lo(w.w) + bf_hi(w.w)); }
              DEN[((size_t)(R0 + t) * 2 + dir) * 4 + h] = s; } }
        __syncthreads();
        { bf16x8 vf[4][2];
#pragma unroll
          for (int dt = 0; dt < 4; ++dt)
#pragma unroll
              for (int ks = 0; ks < 2; ++ks) vf[dt][ks] = *(const LAS bf16x8*)(vtL + (64 * X.wave + 16 * dt + ql) * AP + 64 * ks + 16 * g);
#pragma unroll
          for (int dir = 0; dir < 2; ++dir) { bf16_t* HO = (bf16_t*)(ws + (dir ? WS_HB : WS_HF));
#pragma unroll
              for (int tt = 0; tt < 4; ++tt) { f32x4 acc[4];
#pragma unroll
                  for (int dt = 0; dt < 4; ++dt) acc[dt] = (f32x4){0.f, 0.f, 0.f, 0.f};
#pragma unroll
                  for (int ks = 0; ks < 2; ++ks) { const bf16x8 af = *(const LAS bf16x8*)(atL + dir * 64 * AP + (16 * tt + ql) * AP + 64 * ks + 16 * g);
#pragma unroll
                      for (int dt = 0; dt < 4; ++dt) acc[dt] = __builtin_amdgcn_mfma_f32_16x16x32_bf16(vf[dt][ks], af, acc[dt], 0, 0, 0); }
                  bf16_t* op = HO + (size_t)(R0 + 16 * tt + ql) * MLI + h * 512 + 64 * X.wave + 4 * g;
#pragma unroll
                  for (int dt = 0; dt < 4; ++dt) { u32x2 w; w.x = cvtpk(acc[dt][0], acc[dt][1]); w.y = cvtpk(acc[dt][2], acc[dt][3]); *(u32x2*)(op + 16 * dt) = w; } } } }
    }
#undef SA_LOAD
}

#define SC2_BAR() asm volatile("s_waitcnt lgkmcnt(0)\n\ts_barrier" ::: "memory")
__device__ __forceinline__ void scanB2_phase(const Ctx& X0, const PArgs& a, bool dry = false, int variant = 0) {
    const Ctx X = fresh_ctx(X0);
    unsigned char* ws = a.ws;
    const bf16_t* XM = (const bf16_t*)(ws + WS_XM); const bf16_t* QG = (const bf16_t*)(ws + WS_QG); const bf16_t* KG = (const bf16_t*)(ws + WS_KG); const float* GW = (const float*)(ws + WS_GW); const float* DEN = (const float*)(ws + WS_DEN);
    constexpr int AP = 144;
    LAS unsigned char* qL = X.lds; LAS unsigned char* ktL = X.lds + 64 * QK_PITCH; LAS unsigned char* vL = ktL + 65536;
    LAS bf16_t* xL = (LAS bf16_t*)(vL + 64 * AP);
    LAS float* sm = (LAS float*)(vL + 64 * AP + 8192);
    LAS float* wL = sm; LAS float* wgL = sm + 128; LAS float* denL = sm + 256; LAS float* qnL = sm + 384; LAS float* nL = sm + 512; LAS float* wvL = sm + 1024;
    const int db = X.wave & 3, eh = X.wave >> 2;
    for (int item = X.bid; item < 256; item += X.G) {
        int chain = item >> 3, sl = item & 7;
        if (X.G == 256) { const int k = item >> 3, x = item & 7; chain = (x >> 1) * 8 + (k >> 3) * 2 + (x & 1); sl = k & 7; }
        const int b = chain >> 3, h = (chain >> 1) & 3, dir = chain & 1;
        bf16_t* HO = (bf16_t*)(ws + (dir ? WS_HB : WS_HF));
        f32x4 ct[16];
#pragma unroll
        for (int j = 0; j < 16; ++j) ct[j] = (f32x4){0.f, 0.f, 0.f, 0.f};
        f32x4 nacc[4];
#pragma unroll
        for (int j = 0; j < 4; ++j) nacc[j] = (f32x4){0.f, 0.f, 0.f, 0.f};
        __syncthreads();
        if (X.tid < 256) wvL[X.tid] = a.in(I_MLWV)[(h * 128 + sl * 16) * 16 + X.tid];
#define SC2_R0(ch_) tb_row0(b, dir ? ((ch_) < 4 ? 3 - (ch_) : 135 - (ch_)) : (ch_))
#define SC2_DMA_Q(ch_) do { const int r0_ = SC2_R0(ch_); _Pragma("unroll") for (int i_ = 0; i_ < 8; ++i_) { const int tl_ = X.wave * 8 + i_; \
            __builtin_amdgcn_global_load_lds((const unsigned*)(QG + (size_t)(r0_ + tl_) * MLI + h * 512 + X.lane * 8), (LAS unsigned*)(qL + tl_ * QK_PITCH), 16, 0, 0); } } while (0)
#define SC2_DMA_K(ch_) do { const int r0_ = SC2_R0(ch_); const int rr_ = X.lane >> 3, pp_ = X.lane & 7; _Pragma("unroll") for (int i_ = 0; i_ < 8; ++i_) { const int sg_ = X.wave * 8 + i_; \
            __builtin_amdgcn_global_load_lds((const unsigned*)(KG + (size_t)(r0_ + sg_) * MLI + h * 512 + rr_ * 64 + (pp_ ^ ((4 * (sg_ & 1) + (rr_ >> 1)) & 7)) * 8), (LAS unsigned*)(ktL + sg_ * 1024), 16, 0, 0); } } while (0)
        u32x2 pxm[2]; float pw = 0.f, pwg = 0.f, pden = 0.f;
#define SC2_REGS(ch_) do { const int r0_ = SC2_R0(ch_); const int vb_ = X.tid & 15, vr_ = X.tid >> 4; \
            _Pragma("unroll") for (int i_ = 0; i_ < 2; ++i_) pxm[i_] = *(const u32x2*)(XM + (size_t)(r0_ + 2 * vr_ + i_) * MLI + h * 512 + sl * 64 + 4 * vb_); \
            if (X.tid < 64) { const int row_ = r0_ + X.tid; const float* gw_ = GW + (((size_t)row_ * 2 + dir) * 4 + h) * 2; pw = gw_[0]; pwg = gw_[1]; pden = DEN[((size_t)row_ * 2 + dir) * 4 + h]; } } while (0)
        SC2_REGS(0); SC2_DMA_Q(0); SC2_DMA_K(0);
        for (int ch = 0; ch < (CTXL + SEQ) / 64; ++ch) {
            const int buf = ch & 1, r0 = SC2_R0(ch);
            { const int t1 = launder_i(X.tid); const int vb = t1 & 15, vr = t1 >> 4;
              if ((t1 & 15) == 0) { const int g1 = (t1 >> 4) & 3;
#pragma unroll
                  for (int jj = 0; jj < 4; ++jj) { const int tile = 4 * db + jj; *(LAS f32x4*)(nL + eh * 256 + 32 * (tile >> 1) + 8 * g1 + 4 * (tile & 1)) = nacc[jj]; } }
              float vv[2][4]; f32x4 wv4[4];
#pragma unroll
              for (int i = 0; i < 4; ++i) wv4[i] = *(const LAS f32x4*)(wvL + vb * 16 + 4 * i);
#pragma unroll
              for (int i = 0; i < 2; ++i) { const u32x2 w = pxm[i]; const float x0 = bf_lo(w.x), x1 = bf_hi(w.x), x2 = bf_lo(w.y), x3 = bf_hi(w.y);
#pragma unroll
                  for (int dd = 0; dd < 4; ++dd) vv[i][dd] = x0 * wv4[0][dd] + x1 * wv4[1][dd] + x2 * wv4[2][dd] + x3 * wv4[3][dd]; }
#pragma unroll
              for (int dd = 0; dd < 4; ++dd) *(LAS unsigned*)(vL + (4 * vb + dd) * AP + (2 * vr) * 2) = cvtpk(vv[0][dd], vv[1][dd]);
              if (t1 < 64) { wL[buf * 64 + t1] = pw; wgL[buf * 64 + t1] = pwg; denL[buf * 64 + t1] = pden; } }
            asm volatile("s_waitcnt vmcnt(8)" ::: "memory");
            SC2_BAR();
            const int l2 = launder_i(X.lane); const int ql = l2 & 15, g = l2 >> 4;
            f32x4 acc[4]; f32x4 qacc = (f32x4){0.f, 0.f, 0.f, 0.f};
#pragma unroll
            for (int tt = 0; tt < 4; ++tt) acc[tt] = (f32x4){0.f, 0.f, 0.f, 0.f};
            if (variant != 1) {
                const LAS unsigned char* qb = qL + ql * QK_PITCH + (eh * 256) * 2 + 16 * g; const LAS float* nb = nL + eh * 256 + 8 * g;
                bf16x8 qn_[5]; f32x4 nn0, nn1;
#define SC2_QLOAD(kq_) do { const int kp_ = (variant == 3) ? 0 : (kq_); _Pragma("unroll") for (int tt_ = 0; tt_ < 4; ++tt_) qn_[tt_] = *(const LAS bf16x8*)(qb + (variant == 3 ? 0 : tt_) * 16 * QK_PITCH + 64 * (kp_)); \
                    qn_[4] = *(const LAS bf16x8*)(qb + db * 16 * QK_PITCH + 64 * (kp_)); nn0 = *(const LAS f32x4*)(nb + 32 * (kp_)); nn1 = *(const LAS f32x4*)(nb + 32 * (kp_) + 4); } while (0)
                SC2_QLOAD(0);
#pragma unroll
                for (int kp = 0; kp < 8; ++kp) {
                    bf16x8 qa[5];
#pragma unroll
                    for (int i = 0; i < 5; ++i) qa[i] = qn_[i];
                    const f32x4 n0 = nn0, n1 = nn1;
                    if (kp + 1 < 8) SC2_QLOAD(kp + 1);
                    u32x4 cw; cw.x = cvtpk(ct[2 * kp][0], ct[2 * kp][1]); cw.y = cvtpk(ct[2 * kp][2], ct[2 * kp][3]); cw.z = cvtpk(ct[2 * kp + 1][0], ct[2 * kp + 1][1]); cw.w = cvtpk(ct[2 * kp + 1][2], ct[2 * kp + 1][3]);
                    const bf16x8 cf = __builtin_bit_cast(bf16x8, cw);
                    u32x4 nw; nw.x = cvtpk(n0[0], n0[1]); nw.y = cvtpk(n0[2], n0[3]); nw.z = cvtpk(n1[0], n1[1]); nw.w = cvtpk(n1[2], n1[3]);
                    if (ql != 0) nw = (u32x4){0u, 0u, 0u, 0u};
#pragma unroll
                    for (int tt = 0; tt < 4; ++tt) acc[tt] = __builtin_amdgcn_mfma_f32_16x16x32_bf16(cf, qa[tt], acc[tt], 0, 0, 0);
                    qacc = __builtin_amdgcn_mfma_f32_16x16x32_bf16(qa[4], __builtin_bit_cast(bf16x8, nw), qacc, 0, 0, 0); }
#undef SC2_QLOAD
            }
            if (eh == 1) {
#pragma unroll
                for (int tt = 0; tt < 4; ++tt) { u32x2 w; w.x = cvtpk(acc[tt][0], acc[tt][1]); w.y = cvtpk(acc[tt][2], acc[tt][3]); *(LAS u32x2*)(xL + (db * 64 + 16 * tt + ql) * 16 + 4 * g) = w; }
            }
            if (ql == 0) *(LAS f32x4*)(qnL + eh * 64 + 16 * db + 4 * g) = qacc;
            asm volatile("s_waitcnt vmcnt(0)" ::: "memory");
            SC2_BAR();
            u32x2 ni[4];
#pragma unroll
            for (int tt = 0; tt < 4; ++tt) ni[tt] = *(const u32x2*)(HO + (size_t)(r0 + 16 * tt + ql) * MLI + h * 512 + sl * 64 + 16 * db + 4 * g);
            if (ch + 1 < (CTXL + SEQ) / 64) { SC2_REGS(ch + 1); SC2_DMA_Q(ch + 1); }
            const float decay = wL[buf * 64 + (dir ? 0 : 63)];
#pragma unroll
            for (int j = 0; j < 16; ++j) ct[j] = ct[j] * decay;
#pragma unroll
            for (int j = 0; j < 4; ++j) nacc[j] = nacc[j] * decay;
            if (variant != 2)
#pragma unroll
            for (int ks = 0; ks < 2; ++ks) {
                const u32x4 vraw = *(const LAS u32x4*)(vL + (16 * db + ql) * AP + 64 * ks + 16 * g);
                const f32x4 w0 = *(const LAS f32x4*)(wgL + buf * 64 + 32 * ks + 8 * g), w1 = *(const LAS f32x4*)(wgL + buf * 64 + 32 * ks + 8 * g + 4);
                u32x4 vw; vw.x = cvtpk(bf_lo(vraw.x) * w0[0], bf_hi(vraw.x) * w0[1]); vw.y = cvtpk(bf_lo(vraw.y) * w0[2], bf_hi(vraw.y) * w0[3]);
                vw.z = cvtpk(bf_lo(vraw.z) * w1[0], bf_hi(vraw.z) * w1[1]); vw.w = cvtpk(bf_lo(vraw.w) * w1[2], bf_hi(vraw.w) * w1[3]);
                const bf16x8 vf = __builtin_bit_cast(bf16x8, vw);
                u32x4 gwv; gwv.x = cvtpk(w0[0], w0[1]); gwv.y = cvtpk(w0[2], w0[3]); gwv.z = cvtpk(w1[0], w1[1]); gwv.w = cvtpk(w1[2], w1[3]);
                if (ql != 0) gwv = (u32x4){0u, 0u, 0u, 0u};
                const bf16x8 gwf = __builtin_bit_cast(bf16x8, gwv);
                const LAS unsigned char* kb = ktL + (eh * 256 + ql) * 128 + (((4 * ks + g) ^ ((ql >> 1) & 7)) << 4);
                bf16x8 kn_[4];
#pragma unroll
                for (int jj = 0; jj < 4; ++jj) kn_[jj] = *(const LAS bf16x8*)(kb + 16 * (variant == 4 ? 0 : jj) * 128);
#pragma unroll
                for (int j4 = 0; j4 < 4; ++j4) { bf16x8 kf[4];
#pragma unroll
                    for (int jj = 0; jj < 4; ++jj) kf[jj] = kn_[jj];
                    if (j4 + 1 < 4) {
#pragma unroll
                        for (int jj = 0; jj < 4; ++jj) kn_[jj] = *(const LAS bf16x8*)(kb + 16 * (variant == 4 ? 0 : 4 * (j4 + 1) + jj) * 128); }
#pragma unroll
                    for (int jj = 0; jj < 4; ++jj) ct[4 * j4 + jj] = __builtin_amdgcn_mfma_f32_16x16x32_bf16(kf[jj], vf, ct[4 * j4 + jj], 0, 0, 0);
                    if (j4 == db) {
#pragma unroll
                        for (int jj = 0; jj < 4; ++jj) nacc[jj] = __builtin_amdgcn_mfma_f32_16x16x32_bf16(kf[jj], gwf, nacc[jj], 0, 0, 0); } } }
            SC2_BAR();
            if (ch + 1 < (CTXL + SEQ) / 64) SC2_DMA_K(ch + 1);
            if (eh == 0) {
#pragma unroll
                for (int tt = 0; tt < 4; ++tt) { const int t = 16 * tt + ql; const float w = wL[buf * 64 + t]; const float den = denL[buf * 64 + t] + w * (qnL[t] + qnL[64 + t]);
                    const float sc = 1.0f / (fabsf(den) > 1.0f ? fabsf(den) : 1.0f); const u32x2 xw = *(const LAS u32x2*)(xL + (db * 64 + t) * 16 + 4 * g);
                    const float o0 = (bf_lo(ni[tt].x) + w * (acc[tt][0] + bf_lo(xw.x))) * sc, o1 = (bf_hi(ni[tt].x) + w * (acc[tt][1] + bf_hi(xw.x))) * sc;
                    const float o2 = (bf_lo(ni[tt].y) + w * (acc[tt][2] + bf_lo(xw.y))) * sc, o3 = (bf_hi(ni[tt].y) + w * (acc[tt][3] + bf_hi(xw.y))) * sc;
                    u32x2 ow; ow.x = cvtpk(o0, o1); ow.y = cvtpk(o2, o3); if (!dry) *(u32x2*)(HO + (size_t)(r0 + t) * MLI + h * 512 + sl * 64 + 16 * db + 4 * g) = ow; }
            }
        }
        asm volatile("s_waitcnt vmcnt(0)" ::: "memory");
#undef SC2_R0
#undef SC2_DMA_Q
#undef SC2_DMA_K
#undef SC2_REGS
    }
}

__device__ __forceinline__ float xmax_rows(float v) { float a = v, b = v; asm volatile("s_nop 1\n\tv_permlane16_swap_b32 %0, %1" : "+v"(a), "+v"(b)); v = fmaxf(a, b); a = v; b = v;
    asm volatile("s_nop 1\n\tv_permlane32_swap_b32 %0, %1" : "+v"(a), "+v"(b)); return fmaxf(a, b); }
__device__ __forceinline__ float xsum_rows(float v) { float a = v, b = v; asm volatile("s_nop 1\n\tv_permlane16_swap_b32 %0, %1" : "+v"(a), "+v"(b)); v = a + b; a = v; b = v;
    asm volatile("s_nop 1\n\tv_permlane32_swap_b32 %0, %1" : "+v"(a), "+v"(b)); return a + b; }
template <int B0, int B1>
__device__ __forceinline__ void attn_tile3p(const LAS unsigned char* kt0, const LAS unsigned char* vt0, const LAS float* blq, const bf16x8 (&qf)[2], float& m, float& lsum, f32x4 (&o)[4], const int (&kq)[2], const int (&vq)[4], const bool (&sb)[4]) {
    constexpr int TILEB = 16384;
    float bv[2][4];
#pragma unroll
    for (int ts = 0; ts < 2; ++ts)
#pragma unroll
        for (int rg = 0; rg < 4; ++rg) bv[ts][rg] = sb[rg] ? blq[ts * 128 + 16 * B1 + rg] : blq[ts * 128 + 16 * B0 + rg];
    f32x4 s[2][2];
#pragma unroll
    for (int ts = 0; ts < 2; ++ts) { bf16x8 kf[2][2];
#pragma unroll
        for (int i = 0; i < 2; ++i)
#pragma unroll
            for (int ss = 0; ss < 2; ++ss) kf[i][ss] = *(const LAS bf16x8*)(kt0 + ts * TILEB + (i ? B1 : B0) * 4096 + kq[ss]);
#pragma unroll
        for (int i = 0; i < 2; ++i) { s[ts][i] = (f32x4){0.f, 0.f, 0.f, 0.f};
#pragma unroll
            for (int ss = 0; ss < 2; ++ss) s[ts][i] = __builtin_amdgcn_mfma_f32_16x16x32_bf16(kf[i][ss], qf[ss], s[ts][i], 0, 0, 0); } }
    float v[2][4]; float mx = -1.0e30f;
#pragma unroll
    for (int ts = 0; ts < 2; ++ts)
#pragma unroll
        for (int rg = 0; rg < 4; ++rg) { v[ts][rg] = __builtin_fmaf(sb[rg] ? s[ts][1][rg] : s[ts][0][rg], 0.18033688011112042f, bv[ts][rg]); mx = fmaxf(mx, v[ts][rg]); }
    mx = xmax_rows(mx);
    const float mn = fmaxf(m, mx), alpha = __builtin_amdgcn_exp2f(m - mn); m = mn;
    float ps = 0.f;
#pragma unroll
    for (int ts = 0; ts < 2; ++ts)
#pragma unroll
        for (int rg = 0; rg < 4; ++rg) { const float p = __builtin_amdgcn_exp2f(v[ts][rg] - mn); v[ts][rg] = p; ps += p; }
    lsum = lsum * alpha + ps;
#pragma unroll
    for (int db = 0; db < 4; ++db) o[db] = o[db] * alpha;
#pragma unroll
    for (int ts = 0; ts < 2; ++ts) {
        float p0[4], p1[4];
#pragma unroll
        for (int rg = 0; rg < 4; ++rg) { p0[rg] = sb[rg] ? 0.f : v[ts][rg]; p1[rg] = sb[rg] ? v[ts][rg] : 0.f; }
        u32x4 pw; pw.x = cvtpk(p0[0], p0[1]); pw.y = cvtpk(p0[2], p0[3]); pw.z = cvtpk(p1[0], p1[1]); pw.w = cvtpk(p1[2], p1[3]);
        const bf16x8 pf = __builtin_bit_cast(bf16x8, pw);
        s16x4 t0[4], t1[4];
#pragma unroll
        for (int db = 0; db < 4; ++db) { const LAS unsigned char* vp = vt0 + ts * TILEB + vq[db]; t0[db] = lds_tr16(vp + B0 * 4096); t1[db] = lds_tr16(vp + B1 * 4096); }
#pragma unroll
        for (int db = 0; db < 4; ++db) { const bf16x8 vf = (bf16x8){t0[db][0], t0[db][1], t0[db][2], t0[db][3], t1[db][0], t1[db][1], t1[db][2], t1[db][3]};
            o[db] = __builtin_amdgcn_mfma_f32_16x16x32_bf16(vf, pf, o[db], 0, 0, 0); } }
}
__device__ __forceinline__ void attn_tile3c(const LAS unsigned char* kt0, const LAS unsigned char* vt0, const bf16x8 (&qf)[2], float& m, float& lsum, f32x4 (&o)[4], const int (&kq)[2], const int (&vq)[4]) {
    constexpr int TILEB = 16384;
    f32x4 s[2][4];
#pragma unroll
    for (int ts = 0; ts < 2; ++ts) { bf16x8 kf[4][2];
#pragma unroll
        for (int cb = 0; cb < 4; ++cb)
#pragma unroll
            for (int ss = 0; ss < 2; ++ss) kf[cb][ss] = *(const LAS bf16x8*)(kt0 + ts * TILEB + cb * 4096 + kq[ss]);
#pragma unroll
        for (int cb = 0; cb < 4; ++cb) { s[ts][cb] = (f32x4){0.f, 0.f, 0.f, 0.f};
#pragma unroll
            for (int ss = 0; ss < 2; ++ss) s[ts][cb] = __builtin_amdgcn_mfma_f32_16x16x32_bf16(kf[cb][ss], qf[ss], s[ts][cb], 0, 0, 0); } }
    float mx = -1.0e30f;
#pragma unroll
    for (int ts = 0; ts < 2; ++ts)
#pragma unroll
        for (int cb = 0; cb < 4; ++cb)
#pragma unroll
            for (int rg = 0; rg < 4; ++rg) mx = fmaxf(mx, s[ts][cb][rg]);
    mx = xmax_rows(mx) * 0.18033688011112042f;
    const float mn = fmaxf(m, mx), alpha = __builtin_amdgcn_exp2f(m - mn); m = mn;
    f32x2 ps2 = (f32x2){0.f, 0.f}; const f32x2 sc2 = (f32x2){0.18033688011112042f, 0.18033688011112042f}, mn2 = (f32x2){-mn, -mn};
#pragma unroll
    for (int ts = 0; ts < 2; ++ts)
#pragma unroll
        for (int cb = 0; cb < 4; ++cb)
#pragma unroll
            for (int hp = 0; hp < 2; ++hp) { const f32x2 e2 = __builtin_elementwise_fma((f32x2){s[ts][cb][2 * hp], s[ts][cb][2 * hp + 1]}, sc2, mn2);
                const f32x2 p2 = (f32x2){__builtin_amdgcn_exp2f(e2[0]), __builtin_amdgcn_exp2f(e2[1])}; s[ts][cb][2 * hp] = p2[0]; s[ts][cb][2 * hp + 1] = p2[1]; ps2 = ps2 + p2; }
    lsum = lsum * alpha + (ps2[0] + ps2[1]);
    { const f32x2 al2 = (f32x2){alpha, alpha};
#pragma unroll
      for (int db = 0; db < 4; ++db) { f32x2 lo = (f32x2){o[db][0], o[db][1]} * al2, hi = (f32x2){o[db][2], o[db][3]} * al2; o[db] = (f32x4){lo[0], lo[1], hi[0], hi[1]}; } }
#pragma unroll
    for (int ts = 0; ts < 2; ++ts)
#pragma unroll
        for (int pr = 0; pr < 2; ++pr) {
            const f32x4 s0 = s[ts][2 * pr], s1 = s[ts][2 * pr + 1];
            u32x4 pw; pw.x = cvtpk(s0[0], s0[1]); pw.y = cvtpk(s0[2], s0[3]); pw.z = cvtpk(s1[0], s1[1]); pw.w = cvtpk(s1[2], s1[3]);
            const bf16x8 pf = __builtin_bit_cast(bf16x8, pw);
            s16x4 t0[4], t1[4];
#pragma unroll
            for (int db = 0; db < 4; ++db) { const LAS unsigned char* vp = vt0 + ts * TILEB + (2 * pr) * 4096 + vq[db]; t0[db] = lds_tr16(vp); t1[db] = lds_tr16(vp + 4096); }
#pragma unroll
            for (int db = 0; db < 4; ++db) { const bf16x8 vf = (bf16x8){t0[db][0], t0[db][1], t0[db][2], t0[db][3], t1[db][0], t1[db][1], t1[db][2], t1[db][3]};
                o[db] = __builtin_amdgcn_mfma_f32_16x16x32_bf16(vf, pf, o[db], 0, 0, 0); } }
}
#pragma clang diagnostic push
#pragma clang diagnostic ignored "-Winline-asm"
__device__ __forceinline__ void attn3_phase(const Ctx& X0, const PArgs& a, int j_na, bool with_ctx) {
    const Ctx X = fresh_ctx(X0);
    unsigned char* ws = a.ws;
    const bf16_t* Q = (const bf16_t*)(ws + WS_Q); const bf16_t* K = (const bf16_t*)(ws + WS_K); const bf16_t* V = (const bf16_t*)(ws + WS_V); bf16_t* O = (bf16_t*)(ws + WS_O);
    const float* rpb = a.in(I_NARPB) + (size_t)j_na * NAH * 15 * 31;
    constexpr int TILEB = 16384;
    LAS unsigned char* Kb = X.lds; LAS unsigned char* Vb = X.lds + 4 * TILEB; LAS float* bl = (LAS float*)(X.lds + 8 * TILEB);
    const int hsel = X.wave >> 2, jb = X.wave & 3, ql = X.lane & 15, g = X.lane >> 4;
    const int nlat = NB * GROWS * 8, nunits = nlat + (with_ctx ? NB * 8 * 4 : 0);
    const int qc = jb == 0 ? (ql < 8 ? ql : 48 + ql) : 16 * jb - 8 + ql, c0 = qc - 8 < 0 ? 0 : (qc - 8 > 48 ? 48 : qc - 8);
    bool sb03[4], sbj[4];
#pragma unroll
    for (int rg = 0; rg < 4; ++rg) { const int k3 = 48 + 4 * g + rg, kj = 16 * jb + 4 * g + rg; sb03[rg] = (k3 >= c0 && k3 < c0 + 16); sbj[rg] = (kj >= c0 && kj < c0 + 16); }
    int kq[2], vq[4];
#pragma unroll
    for (int ss = 0; ss < 2; ++ss) kq[ss] = ql * 256 + (((8 * hsel + 4 * ss + g) ^ ql) << 4);
    { const int xv = 4 * g + (ql >> 2);
#pragma unroll
      for (int db = 0; db < 4; ++db) vq[db] = xv * 256 + (((8 * hsel + 2 * db + ((ql >> 1) & 1)) ^ xv) << 4) + 8 * (ql & 1); }
    const int dkv = X.wave >> 2, dts = (X.wave >> 1) & 1, dgrp0 = 8 * (X.wave & 1), drin = X.lane >> 4, dpp = X.lane & 15;
    const int nper = (X.G % 8 == 0 && nlat % 8 == 0) ? nlat / 8 : 0, wpx = X.G / 8;
    for (int k = 0; ; ++k) {
        int u;
        if (nper) { const int iu = (X.bid >> 3) + wpx * k; u = iu < nper ? (X.bid & 7) * nper + iu : nlat + (iu - nper) * 8 + (X.bid & 7); }
        else u = X.bid + X.G * k;
        if (u >= nunits) break;
        const bool lat = u < nlat; int b, h0, r = 0, r0 = 0, qrow0, nst;
        if (lat) { b = u / (GROWS * 8); const int rem = u % (GROWS * 8); h0 = (rem >> 7) * 2; r = rem & 127; r0 = r - 4; r0 = r0 < 0 ? 0 : (r0 > GROWS - 8 ? GROWS - 8 : r0); qrow0 = b * SEQ + r * GRIDW; nst = 6; }
        else { const int v = u - nlat; b = v >> 5; h0 = ((v >> 2) & 7) * 2; qrow0 = NLAT + b * CTXL + (v & 3) * 64; nst = 2; }
        const int h = h0 + hsel;
        bf16x8 qf[2];
        { const bf16_t* qp = Q + (size_t)(qrow0 + qc) * D + h * 64 + 8 * g; qf[0] = *(const bf16x8*)qp; qf[1] = *(const bf16x8*)(qp + 32); }
        __syncthreads();
        if (lat) {
#pragma unroll
            for (int q4 = 0; q4 < 4; ++q4) { const int idx = X.tid + 512 * q4; const int hh = idx >> 10, i = (idx >> 7) & 7, dcx = (idx & 127) - 63;
                bl[idx] = (dcx >= -15 && dcx <= 15) ? rpb[((h0 + hh) * 15 + (r0 + i - r + 7)) * 31 + dcx + 15] * 1.4426950408889634f : 0.f; } }
        float m = -1.0e30f, lsum = 0.f; f32x4 o[4];
#pragma unroll
        for (int i = 0; i < 4; ++i) o[i] = (f32x4){0.f, 0.f, 0.f, 0.f};
#define AT_KROW(tl_) ((lat && (tl_) < 8) ? b * SEQ + (r0 + (tl_)) * GRIDW : NLAT + b * CTXL + (lat ? (tl_) - 8 : (tl_)) * 64)
#define AT_DMA(st_) do { const bf16_t* sb_ = (dkv ? V : K) + (size_t)(AT_KROW(2 * (st_) + dts) + drin) * D + h0 * 64; LAS unsigned char* db_ = (dkv ? Vb : Kb) + (((st_) & 1) * 2 + dts) * TILEB; \
            _Pragma("unroll") for (int i_ = 0; i_ < 8; ++i_) { const int grp_ = dgrp0 + i_; const bf16_t* gp_ = sb_ + (size_t)(4 * grp_) * D + ((dpp ^ ((4 * (grp_ & 3) + drin) & 15)) << 3); \
                const unsigned la_ = __builtin_amdgcn_readfirstlane((unsigned)(size_t)(db_ + grp_ * 1024)); \
                asm volatile("s_mov_b32 m0, %1\n\ts_nop 0\n\tglobal_load_lds_dwordx4 %0, off" :: "v"(gp_), "s"(la_) : "memory", "m0"); } } while (0)
        AT_DMA(0);
        for (int st = 0; st < nst; ++st) {
            const int buf = st & 1;
            asm volatile("s_waitcnt vmcnt(0)" ::: "memory");
            __syncthreads();
            if (st + 1 < nst) AT_DMA(st + 1);
            const bool local = lat && st < 4;
            const LAS unsigned char* kt0 = Kb + (buf * 2) * TILEB; const LAS unsigned char* vt0 = Vb + (buf * 2) * TILEB; const LAS float* blq = bl + hsel * 1024 + (2 * st) * 128 + (4 * g - qc + 63);
            if (!local) attn_tile3c(kt0, vt0, qf, m, lsum, o, kq, vq);
            else if (jb == 0) attn_tile3p<0, 3>(kt0, vt0, blq, qf, m, lsum, o, kq, vq, sb03);
            else if (jb == 1) attn_tile3p<0, 1>(kt0, vt0, blq, qf, m, lsum, o, kq, vq, sbj);
            else if (jb == 2) attn_tile3p<1, 2>(kt0, vt0, blq, qf, m, lsum, o, kq, vq, sbj);
            else attn_tile3p<2, 3>(kt0, vt0, blq, qf, m, lsum, o, kq, vq, sbj);
        }
#undef AT_KROW
#undef AT_DMA
        lsum = xsum_rows(lsum);
        const float inv = 1.0f / lsum;
        bf16_t* op = O + (size_t)(qrow0 + qc) * D + h * 64 + 4 * g;
#pragma unroll
        for (int db = 0; db < 4; ++db) { u32x2 w; w.x = cvtpk(o[db][0] * inv, o[db][1] * inv); w.y = cvtpk(o[db][2] * inv, o[db][3] * inv); *(u32x2*)(op + 16 * db) = w; }
    }
}
#pragma clang diagnostic pop
template <int B0, int B1>
__device__ __forceinline__ void attn_tile4p(const LAS unsigned char* kt0, const LAS unsigned char* vt0, const LAS float* blq, const bf16x8 (&qf)[2], float& m, float& lsum, f32x4 (&o)[4], const int (&kq)[2], const int (&vq)[4], const bool (&sb)[4]) {
    constexpr int TILEB = 8192;
    float bv[2][4];
#pragma unroll
    for (int ts = 0; ts < 2; ++ts)
#pragma unroll
        for (int rg = 0; rg < 4; ++rg) bv[ts][rg] = sb[rg] ? blq[ts * 128 + 16 * B1 + rg] : blq[ts * 128 + 16 * B0 + rg];
    f32x4 s[2][2];
#pragma unroll
    for (int ts = 0; ts < 2; ++ts) { bf16x8 kf[2][2];
#pragma unroll
        for (int i = 0; i < 2; ++i)
#pragma unroll
            for (int ss = 0; ss < 2; ++ss) kf[i][ss] = *(const LAS bf16x8*)(kt0 + ts * TILEB + (i ? B1 : B0) * 2048 + kq[ss]);
#pragma unroll
        for (int i = 0; i < 2; ++i) { s[ts][i] = (f32x4){0.f, 0.f, 0.f, 0.f};
#pragma unroll
            for (int ss = 0; ss < 2; ++ss) s[ts][i] = __builtin_amdgcn_mfma_f32_16x16x32_bf16(kf[i][ss], qf[ss], s[ts][i], 0, 0, 0); } }
    float v[2][4]; float mx = -1.0e30f;
#pragma unroll
    for (int ts = 0; ts < 2; ++ts)
#pragma unroll
        for (int rg = 0; rg < 4; ++rg) { v[ts][rg] = __builtin_fmaf(sb[rg] ? s[ts][1][rg] : s[ts][0][rg], 0.18033688011112042f, bv[ts][rg]); mx = fmaxf(mx, v[ts][rg]); }
    mx = xmax_rows(mx);
    const float mn = fmaxf(m, mx), alpha = __builtin_amdgcn_exp2f(m - mn); m = mn;
    float ps = 0.f;
#pragma unroll
    for (int ts = 0; ts < 2; ++ts)
#pragma unroll
        for (int rg = 0; rg < 4; ++rg) { const float p = __builtin_amdgcn_exp2f(v[ts][rg] - mn); v[ts][rg] = p; ps += p; }
    lsum = lsum * alpha + ps;
#pragma unroll
    for (int db = 0; db < 4; ++db) o[db] = o[db] * alpha;
#pragma unroll
    for (int ts = 0; ts < 2; ++ts) {
        float p0[4], p1[4];
#pragma unroll
        for (int rg = 0; rg < 4; ++rg) { p0[rg] = sb[rg] ? 0.f : v[ts][rg]; p1[rg] = sb[rg] ? v[ts][rg] : 0.f; }
        u32x4 pw; pw.x = cvtpk(p0[0], p0[1]); pw.y = cvtpk(p0[2], p0[3]); pw.z = cvtpk(p1[0], p1[1]); pw.w = cvtpk(p1[2], p1[3]);
        const bf16x8 pf = __builtin_bit_cast(bf16x8, pw);
        s16x4 t0[4], t1[4];
#pragma unroll
        for (int db = 0; db < 4; ++db) { const LAS unsigned char* vp = vt0 + ts * TILEB + vq[db]; t0[db] = lds_tr16(vp + B0 * 2048); t1[db] = lds_tr16(vp + B1 * 2048); }
#pragma unroll
        for (int db = 0; db < 4; ++db) { const bf16x8 vf = (bf16x8){t0[db][0], t0[db][1], t0[db][2], t0[db][3], t1[db][0], t1[db][1], t1[db][2], t1[db][3]};
            o[db] = __builtin_amdgcn_mfma_f32_16x16x32_bf16(vf, pf, o[db], 0, 0, 0); } }
}
__device__ __forceinline__ void attn_tile4c(const LAS unsigned char* kt0, const LAS unsigned char* vt0, const bf16x8 (&qf)[2], float& m, float& lsum, f32x4 (&o)[4], const int (&kq)[2], const int (&vq)[4]) {
    constexpr int TILEB = 8192;
    f32x4 s[2][4];
#pragma unroll
    for (int ts = 0; ts < 2; ++ts) { bf16x8 kf[4][2];
#pragma unroll
        for (int cb = 0; cb < 4; ++cb)
#pragma unroll
            for (int ss = 0; ss < 2; ++ss) kf[cb][ss] = *(const LAS bf16x8*)(kt0 + ts * TILEB + cb * 2048 + kq[ss]);
#pragma unroll
        for (int cb = 0; cb < 4; ++cb) { s[ts][cb] = (f32x4){0.f, 0.f, 0.f, 0.f};
#pragma unroll
            for (int ss = 0; ss < 2; ++ss) s[ts][cb] = __builtin_amdgcn_mfma_f32_16x16x32_bf16(kf[cb][ss], qf[ss], s[ts][cb], 0, 0, 0); } }
    float mx = -1.0e30f;
#pragma unroll
    for (int ts = 0; ts < 2; ++ts)
#pragma unroll
        for (int cb = 0; cb < 4; ++cb)
#pragma unroll
            for (int rg = 0; rg < 4; ++rg) mx = fmaxf(mx, s[ts][cb][rg]);
    mx = xmax_rows(mx) * 0.18033688011112042f;
    const float mn = fmaxf(m, mx), alpha = __builtin_amdgcn_exp2f(m - mn); m = mn;
    f32x2 ps2 = (f32x2){0.f, 0.f}; const f32x2 sc2 = (f32x2){0.18033688011112042f, 0.18033688011112042f}, mn2 = (f32x2){-mn, -mn};
#pragma unroll
    for (int ts = 0; ts < 2; ++ts)
#pragma unroll
        for (int cb = 0; cb < 4; ++cb)
#pragma unroll
            for (int hp = 0; hp < 2; ++hp) { const f32x2 e2 = __builtin_elementwise_fma((f32x2){s[ts][cb][2 * hp], s[ts][cb][2 * hp + 1]}, sc2, mn2);
                const f32x2 p2 = (f32x2){__builtin_amdgcn_exp2f(e2[0]), __builtin_amdgcn_exp2f(e2[1])}; s[ts][cb][2 * hp] = p2[0]; s[ts][cb][2 * hp + 1] = p2[1]; ps2 = ps2 + p2; }
    lsum = lsum * alpha + (ps2[0] + ps2[1]);
    { const f32x2 al2 = (f32x2){alpha, alpha};
#pragma unroll
      for (int db = 0; db < 4; ++db) { f32x2 lo = (f32x2){o[db][0], o[db][1]} * al2, hi = (f32x2){o[db][2], o[db][3]} * al2; o[db] = (f32x4){lo[0], lo[1], hi[0], hi[1]}; } }
#pragma unroll
    for (int ts = 0; ts < 2; ++ts)
#pragma unroll
        for (int pr = 0; pr < 2; ++pr) {
            const f32x4 s0 = s[ts][2 * pr], s1 = s[ts][2 * pr + 1];
            u32x4 pw; pw.x = cvtpk(s0[0], s0[1]); pw.y = cvtpk(s0[2], s0[3]); pw.z = cvtpk(s1[0], s1[1]); pw.w = cvtpk(s1[2], s1[3]);
            const bf16x8 pf = __builtin_bit_cast(bf16x8, pw);
            s16x4 t0[4], t1[4];
#pragma unroll
            for (int db = 0; db < 4; ++db) { const LAS unsigned char* vp = vt0 + ts * TILEB + (2 * pr) * 2048 + vq[db]; t0[db] = lds_tr16(vp); t1[db] = lds_tr16(vp + 2048); }
#pragma unroll
            for (int db = 0; db < 4; ++db) { const bf16x8 vf = (bf16x8){t0[db][0], t0[db][1], t0[db][2], t0[db][3], t1[db][0], t1[db][1], t1[db][2], t1[db][3]};
                o[db] = __builtin_amdgcn_mfma_f32_16x16x32_bf16(vf, pf, o[db], 0, 0, 0); } }
}
#pragma clang diagnostic push
#pragma clang diagnostic ignored "-Winline-asm"
__device__ __forceinline__ void attn4_phase(const Ctx& X0, const PArgs& a, int j_na, bool with_ctx) {
    const Ctx X = fresh_ctx(X0);
    if (X.wave >= 4) __builtin_amdgcn_s_setprio(1);
    unsigned char* ws = a.ws;
    const bf16_t* Q = (const bf16_t*)(ws + WS_Q); const bf16_t* K = (const bf16_t*)(ws + WS_K); const bf16_t* V = (const bf16_t*)(ws + WS_V); bf16_t* O = (bf16_t*)(ws + WS_O);
    const float* rpb = a.in(I_NARPB) + (size_t)j_na * NAH * 15 * 31;
    constexpr int TILEB = 8192;
    LAS unsigned char* Kb = X.lds; LAS unsigned char* Vb = X.lds + 8 * TILEB; LAS float* bl = (LAS float*)(X.lds + 16 * TILEB);
    const int rsel = X.wave >> 2, jb = X.wave & 3, ql = X.lane & 15, g = X.lane >> 4;
    const int nlat = NB * (GROWS / 2) * NAH, nunits = nlat + (with_ctx ? NB * NAH * 2 : 0);
    const int qc = jb == 0 ? (ql < 8 ? ql : 48 + ql) : 16 * jb - 8 + ql, c0 = qc - 8 < 0 ? 0 : (qc - 8 > 48 ? 48 : qc - 8);
    bool sb03[4], sbj[4];
#pragma unroll
    for (int rg = 0; rg < 4; ++rg) { const int k3 = 48 + 4 * g + rg, kj = 16 * jb + 4 * g + rg; sb03[rg] = (k3 >= c0 && k3 < c0 + 16); sbj[rg] = (kj >= c0 && kj < c0 + 16); }
    int kq[2], vq[4];
#pragma unroll
    for (int ss = 0; ss < 2; ++ss) kq[ss] = ql * 128 + (((4 * ss + g) ^ (ql & 7)) << 4);
    { const int xv = 4 * g + (ql >> 2);
#pragma unroll
      for (int db = 0; db < 4; ++db) vq[db] = xv * 128 + (((2 * db + ((ql >> 1) & 1)) ^ (xv & 7)) << 4) + 8 * (ql & 1); }
    const int dkv = X.wave >> 2, dslot = X.wave & 3, drin = X.lane >> 3, dpp = X.lane & 7;
    const int nper = (X.G % 8 == 0 && nlat % 8 == 0) ? nlat / 8 : 0, wpx = X.G / 8;
    for (int k = 0; ; ++k) {
        int u;
        if (nper) { const int iu = (X.bid >> 3) + wpx * k; u = iu < nper ? (X.bid & 7) * nper + iu : nlat + (iu - nper) * 8 + (X.bid & 7); }
        else u = X.bid + X.G * k;
        if (u >= nunits) break;
        const bool lat = u < nlat; int b, h, rp = 0, r = 0, r0a = 0, offB = 0, qrow0, nst;
        if (lat) { b = u / ((GROWS / 2) * NAH); const int rem = u % ((GROWS / 2) * NAH); h = rem / (GROWS / 2); rp = rem % (GROWS / 2); r = 2 * rp + rsel;
            r0a = 2 * rp - 4; r0a = r0a < 0 ? 0 : (r0a > GROWS - 8 ? GROWS - 8 : r0a); int r0b = 2 * rp + 1 - 4; r0b = r0b < 0 ? 0 : (r0b > GROWS - 8 ? GROWS - 8 : r0b); offB = r0b - r0a;
            qrow0 = b * SEQ + r * GRIDW; nst = 5; }
        else { const int v = u - nlat; b = v >> 5; h = (v >> 1) & 15; qrow0 = NLAT + b * CTXL + (2 * (v & 1) + rsel) * 64; nst = 1; }
        const int my_off = rsel ? offB : 0;
        bf16x8 qf[2];
        { const bf16_t* qp = Q + (size_t)(qrow0 + qc) * D + h * 64 + 8 * g; qf[0] = *(const bf16x8*)qp; qf[1] = *(const bf16x8*)(qp + 32); }
        float bvr[5] = {0.f, 0.f, 0.f, 0.f, 0.f};
        if (lat) {
#pragma unroll
            for (int q5 = 0; q5 < 5; ++q5) { const int idx = X.tid + 512 * q5; const int rs = idx / 1280, rem2 = idx % 1280, i = (rem2 >> 7) - 1, dcx = (rem2 & 127) - 63;
                const int rr = 2 * rp + rs; int r0r = rr - 4; r0r = r0r < 0 ? 0 : (r0r > GROWS - 8 ? GROWS - 8 : r0r);
                bvr[q5] = (i >= 0 && i < 8 && dcx >= -15 && dcx <= 15) ? rpb[(h * 15 + (r0r + i - rr + 7)) * 31 + dcx + 15] * 1.4426950408889634f : 0.f; } }
        __syncthreads();
        if (lat) {
#pragma unroll
            for (int q5 = 0; q5 < 5; ++q5) bl[X.tid + 512 * q5] = bvr[q5]; }
        float m = -1.0e30f, lsum = 0.f; f32x4 o[4];
#pragma unroll
        for (int i = 0; i < 4; ++i) o[i] = (f32x4){0.f, 0.f, 0.f, 0.f};
#define A4_WROW(w_) (b * SEQ + ((r0a + (w_)) < GROWS ? (r0a + (w_)) : GROWS - 1) * GRIDW)
#define A4_CROW(c_) (NLAT + b * CTXL + (c_) * 64)
#define A4_DMA(st_) do { const int st__ = (st_); int kr_; bool on_ = true; \
            if (!lat || st__ == 4) kr_ = A4_CROW(dslot); \
            else { kr_ = A4_WROW(2 * st__ + dslot); on_ = dslot < 3; } \
            if (on_) { const bf16_t* sb_ = (dkv ? V : K) + (size_t)(kr_ + drin) * D + h * 64 + ((dpp ^ drin) << 3); LAS unsigned char* db_ = (dkv ? Vb : Kb) + ((st__ & 1) * 4 + dslot) * TILEB; \
                _Pragma("unroll") for (int i_ = 0; i_ < 8; ++i_) { const bf16_t* gp_ = sb_ + (size_t)(8 * i_) * D; \
                    const unsigned la_ = __builtin_amdgcn_readfirstlane((unsigned)(size_t)(db_ + i_ * 1024)); \
                    asm volatile("s_mov_b32 m0, %1\n\ts_nop 0\n\tglobal_load_lds_dwordx4 %0, off" :: "v"(gp_), "s"(la_) : "memory", "m0"); } } } while (0)
        A4_DMA(0);
        for (int st = 0; st < nst; ++st) {
            const int buf = st & 1;
            asm volatile("s_waitcnt vmcnt(0)" ::: "memory");
            __syncthreads();
            if (st + 1 < nst) A4_DMA(st + 1);
            if (lat && st < 4) {
                const LAS unsigned char* kt0 = Kb + (buf * 4 + my_off) * TILEB; const LAS unsigned char* vt0 = Vb + (buf * 4 + my_off) * TILEB;
                const LAS float* blq = bl + rsel * 1280 + (2 * st + 1) * 128 + (4 * g - qc + 63);
                if (jb == 0) attn_tile4p<0, 3>(kt0, vt0, blq, qf, m, lsum, o, kq, vq, sb03);
                else if (jb == 1) attn_tile4p<0, 1>(kt0, vt0, blq, qf, m, lsum, o, kq, vq, sbj);
                else if (jb == 2) attn_tile4p<1, 2>(kt0, vt0, blq, qf, m, lsum, o, kq, vq, sbj);
                else attn_tile4p<2, 3>(kt0, vt0, blq, qf, m, lsum, o, kq, vq, sbj);
            } else {
#pragma unroll 1
                for (int c = 0; c < 2; ++c) attn_tile4c(Kb + (buf * 4 + 2 * c) * TILEB, Vb + (buf * 4 + 2 * c) * TILEB, qf, m, lsum, o, kq, vq);
            }
        }
#undef A4_WROW
#undef A4_CROW
#undef A4_DMA
        lsum = xsum_rows(lsum);
        const float inv = 1.0f / lsum;
        bf16_t* op = O + (size_t)(qrow0 + qc) * D + h * 64 + 4 * g;
#pragma unroll
        for (int db = 0; db < 4; ++db) { u32x2 w; w.x = cvtpk(o[db][0] * inv, o[db][1] * inv); w.y = cvtpk(o[db][2] * inv, o[db][3] * inv); *(u32x2*)(op + 16 * db) = w; }
    }
    __builtin_amdgcn_s_setprio(0);
}
#pragma clang diagnostic pop
#pragma clang diagnostic push
#pragma clang diagnostic ignored "-Winline-asm"
__device__ __forceinline__ void scanB3_phase(const Ctx& X0, const PArgs& a, bool dry = false) {
    const Ctx X = fresh_ctx(X0);
    unsigned char* ws = a.ws;
    const bf16_t* XM = (const bf16_t*)(ws + WS_XM); const bf16_t* QG = (const bf16_t*)(ws + WS_QG); const bf16_t* KG = (const bf16_t*)(ws + WS_KG); const float* GW = (const float*)(ws + WS_GW); const float* DEN = (const float*)(ws + WS_DEN);
    constexpr int AP = 144;
    LAS unsigned char* qL = X.lds; LAS unsigned char* ktL = X.lds + 64 * QK_PITCH; LAS unsigned char* vL = ktL + 65536;
    LAS unsigned char* xbL = vL + 64 * AP;
    LAS float* sm = (LAS float*)(xbL + 16384);
    LAS float* wL = sm; LAS float* wgL = sm + 128; LAS float* denL = sm + 256; LAS float* qnL = sm + 384; LAS float* wvL = sm + 640;
    const int dh = X.wave >> 2, eq = X.wave & 3, e2 = eq & 1; const bool fin = (eq >> 1) == dh;
    for (int item = X.bid; item < 256; item += X.G) {
        int chain = item >> 3, sl = item & 7;
        if (X.G == 256) { const int k = item >> 3, x = item & 7; chain = (x >> 1) * 8 + (k >> 3) * 2 + (x & 1); sl = k & 7; }
        const int b = chain >> 3, h = (chain >> 1) & 3, dir = chain & 1;
        bf16_t* HO = (bf16_t*)(ws + (dir ? WS_HB : WS_HF));
        f32x4 ct[16];
#pragma unroll
        for (int j = 0; j < 16; ++j) ct[j] = (f32x4){0.f, 0.f, 0.f, 0.f};
        f32x4 nacc[8];
#pragma unroll
        for (int j = 0; j < 8; ++j) nacc[j] = (f32x4){0.f, 0.f, 0.f, 0.f};
        __syncthreads();
        if (X.tid < 256) wvL[X.tid] = a.in(I_MLWV)[(h * 128 + sl * 16) * 16 + X.tid];
#define SC2_R0(ch_) tb_row0(b, dir ? ((ch_) < 4 ? 3 - (ch_) : 135 - (ch_)) : (ch_))
#define SC3_DMA16(gp_, lp_) do { const unsigned la_ = __builtin_amdgcn_readfirstlane((unsigned)(size_t)(lp_)); asm volatile("s_mov_b32 m0, %1\n\ts_nop 0\n\tglobal_load_lds_dwordx4 %0, off" :: "v"(gp_), "s"(la_) : "memory", "m0"); } while (0)
#define SC2_DMA_Q(ch_) do { const int r0_ = SC2_R0(ch_); _Pragma("unroll") for (int i_ = 0; i_ < 8; ++i_) { const int tl_ = X.wave * 8 + i_; \
            SC3_DMA16(QG + (size_t)(r0_ + tl_) * MLI + h * 512 + X.lane * 8, qL + tl_ * QK_PITCH); } } while (0)
#define SC2_DMA_K(ch_) do { const int r0_ = SC2_R0(ch_); const int rr_ = X.lane >> 3, pp_ = X.lane & 7; _Pragma("unroll") for (int i_ = 0; i_ < 8; ++i_) { const int sg_ = X.wave * 8 + i_; \
            SC3_DMA16(KG + (size_t)(r0_ + sg_) * MLI + h * 512 + rr_ * 64 + (pp_ ^ ((4 * (sg_ & 1) + (rr_ >> 1)) & 7)) * 8, ktL + sg_ * 1024); } } while (0)
#define SC3_GLD2(dst_, ptr_) asm volatile("global_load_dwordx2 %0, %1, off" : "=v"(dst_) : "v"(ptr_) : "memory")
#define SC3_GLD1(dst_, ptr_) asm volatile("global_load_dword %0, %1, off" : "=v"(dst_) : "v"(ptr_) : "memory")
        u32x2 pxm[2] = {(u32x2){0u, 0u}, (u32x2){0u, 0u}}; float pg[2] = {0.f, 0.f}; float pw = 0.f, pwg = 0.f, pden = 0.f;
#define SC2_REGS(ch_) do { const int r0_ = SC2_R0(ch_); const int vb_ = X.tid & 15, vr_ = X.tid >> 4; \
            _Pragma("unroll") for (int i_ = 0; i_ < 2; ++i_) SC3_GLD2(pxm[i_], XM + (size_t)(r0_ + 2 * vr_ + i_) * MLI + h * 512 + sl * 64 + 4 * vb_); \
            _Pragma("unroll") for (int i_ = 0; i_ < 2; ++i_) SC3_GLD1(pg[i_], GW + (((size_t)(r0_ + 2 * vr_ + i_) * 2 + dir) * 4 + h) * 2 + 1); \
            if (X.wave == 0) { const int row_ = r0_ + X.tid; const float* gw_ = GW + (((size_t)row_ * 2 + dir) * 4 + h) * 2; SC3_GLD1(pw, gw_); SC3_GLD1(pwg, gw_ + 1); SC3_GLD1(pden, DEN + ((size_t)row_ * 2 + dir) * 4 + h); } } while (0)
        SC2_REGS(0); SC2_DMA_Q(0); SC2_DMA_K(0);
        for (int ch = 0; ch < (CTXL + SEQ) / 64; ++ch) {
            const int buf = ch & 1, r0 = SC2_R0(ch);
            asm volatile("s_waitcnt vmcnt(16)" : "+v"(pxm[0]), "+v"(pxm[1]), "+v"(pg[0]), "+v"(pg[1]), "+v"(pw), "+v"(pwg), "+v"(pden) :: "memory");
            { const int t1 = launder_i(X.tid); const int vb = t1 & 15, vr = t1 >> 4;
              float vv[2][4]; f32x4 wv4[4];
#pragma unroll
              for (int i = 0; i < 4; ++i) wv4[i] = *(const LAS f32x4*)(wvL + vb * 16 + 4 * i);
#pragma unroll
              for (int i = 0; i < 2; ++i) { const u32x2 w = pxm[i]; const float x0 = bf_lo(w.x), x1 = bf_hi(w.x), x2 = bf_lo(w.y), x3 = bf_hi(w.y);
#pragma unroll
                  for (int dd = 0; dd < 4; ++dd) vv[i][dd] = (x0 * wv4[0][dd] + x1 * wv4[1][dd] + x2 * wv4[2][dd] + x3 * wv4[3][dd]) * pg[i]; }
#pragma unroll
              for (int dd = 0; dd < 4; ++dd) *(LAS unsigned*)(vL + (4 * vb + dd) * AP + (2 * vr) * 2) = cvtpk(vv[0][dd], vv[1][dd]);
              if (t1 < 64) { wL[buf * 64 + t1] = pw; wgL[buf * 64 + t1] = pwg; denL[buf * 64 + t1] = pden; } }
            if (ch == 0 || !fin || dry) asm volatile("s_waitcnt vmcnt(8)" ::: "memory"); else asm volatile("s_waitcnt vmcnt(12)" ::: "memory");
            SC2_BAR();
            const int l2 = launder_i(X.lane); const int ql = l2 & 15, g = l2 >> 4;
            f32x4 acc[8]; f32x4 qacc[4];
#pragma unroll
            for (int i = 0; i < 8; ++i) acc[i] = (f32x4){0.f, 0.f, 0.f, 0.f};
#pragma unroll
            for (int i = 0; i < 4; ++i) qacc[i] = (f32x4){0.f, 0.f, 0.f, 0.f};
            { const LAS unsigned char* qb = qL + ql * QK_PITCH + eq * 256 + 16 * g;
              bf16x8 qn_[4];
#pragma unroll
              for (int tt = 0; tt < 4; ++tt) qn_[tt] = *(const LAS bf16x8*)(qb + tt * 16 * QK_PITCH);
#pragma unroll
              for (int kp = 0; kp < 4; ++kp) {
                  bf16x8 qa[4];
#pragma unroll
                  for (int tt = 0; tt < 4; ++tt) qa[tt] = qn_[tt];
                  if (kp + 1 < 4) {
#pragma unroll
                      for (int tt = 0; tt < 4; ++tt) qn_[tt] = *(const LAS bf16x8*)(qb + tt * 16 * QK_PITCH + 64 * (kp + 1)); }
                  u32x4 c0, c1;
                  c0.x = cvtpk(ct[2 * kp][0], ct[2 * kp][1]); c0.y = cvtpk(ct[2 * kp][2], ct[2 * kp][3]); c0.z = cvtpk(ct[2 * kp + 1][0], ct[2 * kp + 1][1]); c0.w = cvtpk(ct[2 * kp + 1][2], ct[2 * kp + 1][3]);
                  c1.x = cvtpk(ct[8 + 2 * kp][0], ct[8 + 2 * kp][1]); c1.y = cvtpk(ct[8 + 2 * kp][2], ct[8 + 2 * kp][3]); c1.z = cvtpk(ct[9 + 2 * kp][0], ct[9 + 2 * kp][1]); c1.w = cvtpk(ct[9 + 2 * kp][2], ct[9 + 2 * kp][3]);
                  const bf16x8 cf0 = __builtin_bit_cast(bf16x8, c0), cf1 = __builtin_bit_cast(bf16x8, c1);
#pragma unroll
                  for (int tt = 0; tt < 4; ++tt) { acc[tt] = __builtin_amdgcn_mfma_f32_16x16x32_bf16(cf0, qa[tt], acc[tt], 0, 0, 0); acc[4 + tt] = __builtin_amdgcn_mfma_f32_16x16x32_bf16(cf1, qa[tt], acc[4 + tt], 0, 0, 0); }
                  if (dh == 0) {
                      u32x4 nw; nw.x = cvtpk(nacc[2 * kp][0], nacc[2 * kp][1]); nw.y = cvtpk(nacc[2 * kp][2], nacc[2 * kp][3]); nw.z = cvtpk(nacc[2 * kp + 1][0], nacc[2 * kp + 1][1]); nw.w = cvtpk(nacc[2 * kp + 1][2], nacc[2 * kp + 1][3]);
                      const bf16x8 nf = __builtin_bit_cast(bf16x8, nw);
#pragma unroll
                      for (int tt = 0; tt < 4; ++tt) qacc[tt] = __builtin_amdgcn_mfma_f32_16x16x32_bf16(qa[tt], nf, qacc[tt], 0, 0, 0); } } }
            if (dh == 0 && ql == 0) {
#pragma unroll
                for (int tt = 0; tt < 4; ++tt) *(LAS f32x4*)(qnL + eq * 64 + 16 * tt + 4 * g) = qacc[tt]; }
            LAS unsigned char* xmy = xbL + ((dh * 2 + e2) * 8) * 512 + l2 * 8;
            if (!fin) {
#pragma unroll
                for (int i = 0; i < 8; ++i) { u32x2 w; w.x = cvtpk(acc[i][0], acc[i][1]); w.y = cvtpk(acc[i][2], acc[i][3]); *(LAS u32x2*)(xmy + i * 512) = w; } }
            asm volatile("s_waitcnt vmcnt(0)" ::: "memory");
            SC2_BAR();
            u32x2 ni[4];
#pragma unroll
            for (int i = 0; i < 4; ++i) ni[i] = (u32x2){0u, 0u};
            u32x2 xr[8];
#pragma unroll
            for (int i = 0; i < 8; ++i) xr[i] = (u32x2){0u, 0u};
            if (fin) {
#pragma unroll
                for (int i = 0; i < 8; ++i) xr[i] = *(const LAS u32x2*)(xmy + i * 512);
#pragma unroll
                for (int i = 0; i < 4; ++i) SC3_GLD2(ni[i], HO + (size_t)(r0 + 16 * (2 * e2 + (i & 1)) + ql) * MLI + h * 512 + sl * 64 + 32 * dh + 16 * (i >> 1) + 4 * g); }
            const int chn = ch + 1 < (CTXL + SEQ) / 64 ? ch + 1 : ch;
            SC2_REGS(chn); SC2_DMA_Q(chn);
            if (fin) {
#pragma unroll
                for (int i = 0; i < 8; ++i) { const u32x2 w = xr[i]; acc[i][0] += bf_lo(w.x); acc[i][1] += bf_hi(w.x); acc[i][2] += bf_lo(w.y); acc[i][3] += bf_hi(w.y); }
                if (e2 == 0) {
#pragma unroll
                    for (int i = 0; i < 4; ++i) { const int ti = 4 * (i >> 1) + 2 + (i & 1); u32x2 w; w.x = cvtpk(acc[ti][0], acc[ti][1]); w.y = cvtpk(acc[ti][2], acc[ti][3]); *(LAS u32x2*)(xmy + ti * 512) = w; }
                } else {
#pragma unroll
                    for (int i = 0; i < 4; ++i) { const int ti = 4 * (i >> 1) + (i & 1); u32x2 w; w.x = cvtpk(acc[ti][0], acc[ti][1]); w.y = cvtpk(acc[ti][2], acc[ti][3]); *(LAS u32x2*)(xmy + ti * 512) = w; } } }
            const float decay = wL[buf * 64 + (dir ? 0 : 63)];
#pragma unroll
            for (int j = 0; j < 16; ++j) ct[j] = ct[j] * decay;
            if (dh == 0) {
#pragma unroll
                for (int j = 0; j < 8; ++j) nacc[j] = nacc[j] * decay; }
#pragma unroll
            for (int ks = 0; ks < 2; ++ks) {
                bf16x8 vf[2];
#pragma unroll
                for (int dblk = 0; dblk < 2; ++dblk) vf[dblk] = *(const LAS bf16x8*)(vL + (32 * dh + 16 * dblk + ql) * AP + 64 * ks + 16 * g);
                bf16x8 gwf = vf[0];
                if (dh == 0) { const f32x4 w0 = *(const LAS f32x4*)(wgL + buf * 64 + 32 * ks + 8 * g), w1 = *(const LAS f32x4*)(wgL + buf * 64 + 32 * ks + 8 * g + 4);
                    u32x4 gwv; gwv.x = cvtpk(w0[0], w0[1]); gwv.y = cvtpk(w0[2], w0[3]); gwv.z = cvtpk(w1[0], w1[1]); gwv.w = cvtpk(w1[2], w1[3]);
                    if (ql != 0) gwv = (u32x4){0u, 0u, 0u, 0u};
                    gwf = __builtin_bit_cast(bf16x8, gwv); }
                const LAS unsigned char* kb = ktL + (eq * 128 + ql) * 128 + (((4 * ks + g) ^ ((ql >> 1) & 7)) << 4);
                bf16x8 kn_[4];
#pragma unroll
                for (int jj = 0; jj < 4; ++jj) kn_[jj] = *(const LAS bf16x8*)(kb + 16 * jj * 128);
#pragma unroll
                for (int j4 = 0; j4 < 2; ++j4) { bf16x8 kf[4];
#pragma unroll
                    for (int jj = 0; jj < 4; ++jj) kf[jj] = kn_[jj];
                    if (j4 + 1 < 2) {
#pragma unroll
                        for (int jj = 0; jj < 4; ++jj) kn_[jj] = *(const LAS bf16x8*)(kb + 16 * (4 * (j4 + 1) + jj) * 128); }
#pragma unroll
                    for (int jj = 0; jj < 4; ++jj) { ct[4 * j4 + jj] = __builtin_amdgcn_mfma_f32_16x16x32_bf16(kf[jj], vf[0], ct[4 * j4 + jj], 0, 0, 0); ct[8 + 4 * j4 + jj] = __builtin_amdgcn_mfma_f32_16x16x32_bf16(kf[jj], vf[1], ct[8 + 4 * j4 + jj], 0, 0, 0); }
                    if (dh == 0) {
#pragma unroll
                        for (int jj = 0; jj < 4; ++jj) nacc[4 * j4 + jj] = __builtin_amdgcn_mfma_f32_16x16x32_bf16(kf[jj], gwf, nacc[4 * j4 + jj], 0, 0, 0); } } }
            SC2_BAR();
            SC2_DMA_K(chn);
            if (fin) {
                asm volatile("s_waitcnt vmcnt(20)" : "+v"(ni[0]), "+v"(ni[1]), "+v"(ni[2]), "+v"(ni[3]) :: "memory");
                const LAS unsigned char* xot = xbL + ((dh * 2 + (e2 ^ 1)) * 8) * 512 + l2 * 8;
#define SC3_FIN(TT_, AI_, NI_) do { const int t = 16 * (TT_) + ql; const float w = wL[buf * 64 + t]; const float den = denL[buf * 64 + t] + w * ((qnL[t] + qnL[64 + t]) + (qnL[128 + t] + qnL[192 + t])); \
                    const float sc = 1.0f / (fabsf(den) > 1.0f ? fabsf(den) : 1.0f); const u32x2 xw = *(const LAS u32x2*)(xot + (AI_) * 512); \
                    const float o0 = (bf_lo(ni[NI_].x) + w * (acc[AI_][0] + bf_lo(xw.x))) * sc, o1 = (bf_hi(ni[NI_].x) + w * (acc[AI_][1] + bf_hi(xw.x))) * sc; \
                    const float o2 = (bf_lo(ni[NI_].y) + w * (acc[AI_][2] + bf_lo(xw.y))) * sc, o3 = (bf_hi(ni[NI_].y) + w * (acc[AI_][3] + bf_hi(xw.y))) * sc; \
                    u32x2 ow; ow.x = cvtpk(o0, o1); ow.y = cvtpk(o2, o3); if (!dry) *(u32x2*)(HO + (size_t)(r0 + t) * MLI + h * 512 + sl * 64 + 32 * dh + 16 * ((AI_) >> 2) + 4 * g) = ow; } while (0)
                if (e2 == 0) { SC3_FIN(0, 0, 0); SC3_FIN(1, 1, 1); SC3_FIN(0, 4, 2); SC3_FIN(1, 5, 3); }
                else         { SC3_FIN(2, 2, 0); SC3_FIN(3, 3, 1); SC3_FIN(2, 6, 2); SC3_FIN(3, 7, 3); }
#undef SC3_FIN
            }
        }
        asm volatile("s_waitcnt vmcnt(0)" ::: "memory");
#undef SC2_R0
#undef SC2_DMA_Q
#undef SC2_DMA_K
#undef SC2_REGS
#undef SC3_GLD1
#undef SC3_GLD2
#undef SC3_DMA16
    }
}

__device__ __forceinline__ void scanB4_phase(const Ctx& X0, const PArgs& a, bool dry = false, int variant = 0) {
    const Ctx X = fresh_ctx(X0);
    if (X.wave >= 4) __builtin_amdgcn_s_setprio(1);
    unsigned char* ws = a.ws;
    const bf16_t* XM = (const bf16_t*)(ws + WS_XM); const bf16_t* QG = (const bf16_t*)(ws + WS_QG); const bf16_t* KG = (const bf16_t*)(ws + WS_KG); const float* GW = (const float*)(ws + WS_GW); const float* DEN = (const float*)(ws + WS_DEN);
    constexpr int AP = 144, NCH = (CTXL + SEQ) / 64;
    LAS unsigned char* xbL = X.lds;
    LAS unsigned char* vL = X.lds + 131072;
    LAS float* sm = (LAS float*)(vL + 2 * 64 * AP);
    LAS float* wL = sm; LAS float* wgL = sm + 128; LAS float* denL = sm + 256; LAS float* qnL = sm + 384; LAS float* wvL = sm + 1408;
    const int w = X.wave;
    for (int item = X.bid; item < 256; item += X.G) {
        int chain = item >> 3, sl = item & 7;
        if (X.G == 256) { const int k = item >> 3, x = item & 7; chain = (x >> 1) * 8 + (k >> 3) * 2 + (x & 1); sl = k & 7; }
        const int b = chain >> 3, h = (chain >> 1) & 3, dir = chain & 1;
        bf16_t* HO = (bf16_t*)(ws + (dir ? WS_HB : WS_HF));
        f32x4 ct[16];
#pragma unroll
        for (int j = 0; j < 16; ++j) ct[j] = (f32x4){0.f, 0.f, 0.f, 0.f};
        f32x4 nacc[4];
#pragma unroll
        for (int j = 0; j < 4; ++j) nacc[j] = (f32x4){0.f, 0.f, 0.f, 0.f};
        __syncthreads();
        if (X.tid < 256) wvL[X.tid] = a.in(I_MLWV)[(h * 128 + sl * 16) * 16 + X.tid];
        __syncthreads();
#define SC4_R0(ch_) tb_row0(b, dir ? ((ch_) < 4 ? 3 - (ch_) : 135 - (ch_)) : (ch_))
#define SC4_GLD4(dst_, ptr_) asm volatile("global_load_dwordx4 %0, %1, off" : "=v"(dst_) : "v"(ptr_) : "memory")
#define SC4_GLD4O(dst_, ptr_) asm volatile("global_load_dwordx4 %0, %1, off offset:64" : "=v"(dst_) : "v"(ptr_) : "memory")
#define SC4_GLD2(dst_, ptr_) asm volatile("global_load_dwordx2 %0, %1, off" : "=v"(dst_) : "v"(ptr_) : "memory")
#define SC4_GLD1(dst_, ptr_) asm volatile("global_load_dword %0, %1, off" : "=v"(dst_) : "v"(ptr_) : "memory")
        u32x4 qf[8], kf[8];
        u32x2 pxm[2] = {(u32x2){0u, 0u}, (u32x2){0u, 0u}}; float pg[2] = {0.f, 0.f}; float pw = 0.f, pwg = 0.f, pden = 0.f; u32x2 ni[2];
        const int l0 = launder_i(X.lane); const int ql0 = l0 & 15, g0 = l0 >> 4;
#define SC4_LOADQ(ch_) do { const bf16_t* qp_ = QG + (size_t)(SC4_R0(ch_) + 2 * w) * MLI + h * 512 + 8 * l0; \
            _Pragma("unroll") for (int tt_ = 0; tt_ < 4; ++tt_) _Pragma("unroll") for (int kp_ = 0; kp_ < 2; ++kp_) SC4_GLD4(qf[2 * tt_ + kp_], qp_ + (size_t)(16 * tt_ + kp_) * MLI); } while (0)
#define SC4_LOADK(ch_) do { const bf16_t* kp0_ = KG + (size_t)(SC4_R0(ch_) + 8 * w) * MLI + h * 512 + 8 * l0; \
            _Pragma("unroll") for (int j_ = 0; j_ < 4; ++j_) _Pragma("unroll") for (int ks_ = 0; ks_ < 2; ++ks_) SC4_GLD4(kf[2 * j_ + ks_], kp0_ + (size_t)(2 * j_ + ks_) * MLI); } while (0)
#define SC4_REGS(ch_) do { const int r0_ = SC4_R0(ch_); const int vb_ = X.tid & 15, vr_ = X.tid >> 4; \
            _Pragma("unroll") for (int i_ = 0; i_ < 2; ++i_) SC4_GLD2(pxm[i_], XM + (size_t)(r0_ + 2 * vr_ + i_) * MLI + h * 512 + sl * 64 + 4 * vb_); \
            _Pragma("unroll") for (int i_ = 0; i_ < 2; ++i_) SC4_GLD1(pg[i_], GW + (((size_t)(r0_ + 2 * vr_ + i_) * 2 + dir) * 4 + h) * 2 + 1); \
            if (w == 0) { const int row_ = r0_ + X.tid; const float* gw_ = GW + (((size_t)row_ * 2 + dir) * 4 + h) * 2; SC4_GLD1(pw, gw_); SC4_GLD1(pwg, gw_ + 1); SC4_GLD1(pden, DEN + ((size_t)row_ * 2 + dir) * 4 + h); } } while (0)
#define SC4_LOADNI(ch_) do { _Pragma("unroll") for (int k_ = 0; k_ < 2; ++k_) SC4_GLD2(ni[k_], HO + (size_t)(SC4_R0(ch_) + 16 * (2 * (w & 1) + k_) + ql0) * MLI + h * 512 + sl * 64 + 16 * (w >> 1) + 4 * g0); } while (0)
#define SC4_STAGE(bf_) do { const int t1 = launder_i(X.tid); const int vb = t1 & 15, vr = t1 >> 4; float vv[2][4]; f32x4 wv4[4]; \
            _Pragma("unroll") for (int i = 0; i < 4; ++i) wv4[i] = *(const LAS f32x4*)(wvL + vb * 16 + 4 * i); \
            _Pragma("unroll") for (int i = 0; i < 2; ++i) { const u32x2 xw_ = pxm[i]; const float x0 = bf_lo(xw_.x), x1 = bf_hi(xw_.x), x2 = bf_lo(xw_.y), x3 = bf_hi(xw_.y); \
                _Pragma("unroll") for (int dd = 0; dd < 4; ++dd) vv[i][dd] = (x0 * wv4[0][dd] + x1 * wv4[1][dd] + x2 * wv4[2][dd] + x3 * wv4[3][dd]) * pg[i]; } \
            _Pragma("unroll") for (int dd = 0; dd < 4; ++dd) *(LAS unsigned*)(vL + (bf_) * 64 * AP + (4 * vb + dd) * AP + (2 * vr) * 2) = cvtpk(vv[0][dd], vv[1][dd]); \
            if (t1 < 64) { wL[(bf_) * 64 + t1] = pw; wgL[(bf_) * 64 + t1] = pwg; denL[(bf_) * 64 + t1] = pden; } } while (0)
        SC4_REGS(0); SC4_LOADQ(0); SC4_LOADK(0); SC4_LOADNI(0);
        asm volatile("s_waitcnt vmcnt(0)" : "+v"(pxm[0]), "+v"(pxm[1]), "+v"(pg[0]), "+v"(pg[1]), "+v"(pw), "+v"(pwg), "+v"(pden) :: "memory");
        SC4_STAGE(0);
        for (int ch = 0; ch < NCH; ++ch) {
            const int buf = ch & 1, r0 = SC4_R0(ch), chn = ch + 1 < NCH ? ch + 1 : ch;
            SC4_REGS(chn);
            const int l2 = l0, ql = ql0, g = g0;
            if (dry) asm volatile("s_waitcnt vmcnt(14)" : "+v"(qf[0]), "+v"(qf[1]), "+v"(qf[2]), "+v"(qf[3]), "+v"(qf[4]), "+v"(qf[5]), "+v"(qf[6]), "+v"(qf[7]) :: "memory");
            else     asm volatile("s_waitcnt vmcnt(16)" : "+v"(qf[0]), "+v"(qf[1]), "+v"(qf[2]), "+v"(qf[3]), "+v"(qf[4]), "+v"(qf[5]), "+v"(qf[6]), "+v"(qf[7]) :: "memory");
            LAS unsigned char* xw0 = xbL + buf * 65536 + (w * 2) * 512 + l2 * 8;
if (variant != 1)
#pragma unroll
            for (int th = 0; th < 2; ++th) {
                f32x4 qacc[2];
#pragma unroll
                for (int i = 0; i < 2; ++i) qacc[i] = (f32x4){0.f, 0.f, 0.f, 0.f};
#pragma unroll
                for (int dp = 0; dp < 2; ++dp) {
                    f32x4 acc[4];
#pragma unroll
                    for (int i = 0; i < 4; ++i) acc[i] = (f32x4){0.f, 0.f, 0.f, 0.f};
#pragma unroll
                    for (int kp = 0; kp < 2; ++kp) {
#pragma unroll
                        for (int dd = 0; dd < 2; ++dd) { const int dblk = 2 * dp + dd;
                            const f32x4 ca = ct[(2 * kp) * 4 + dblk], cb = ct[(2 * kp + 1) * 4 + dblk];
                            u32x4 cw; cw.x = cvtpk(ca[0], ca[1]); cw.y = cvtpk(ca[2], ca[3]); cw.z = cvtpk(cb[0], cb[1]); cw.w = cvtpk(cb[2], cb[3]);
                            const bf16x8 cf = __builtin_bit_cast(bf16x8, cw);
#pragma unroll
                            for (int i = 0; i < 2; ++i) acc[2 * dd + i] = __builtin_amdgcn_mfma_f32_16x16x32_bf16(cf, __builtin_bit_cast(bf16x8, qf[2 * (2 * th + i) + kp]), acc[2 * dd + i], 0, 0, 0); }
                        if (dp == 0) {
                            u32x4 nw; nw.x = cvtpk(nacc[2 * kp][0], nacc[2 * kp][1]); nw.y = cvtpk(nacc[2 * kp][2], nacc[2 * kp][3]); nw.z = cvtpk(nacc[2 * kp + 1][0], nacc[2 * kp + 1][1]); nw.w = cvtpk(nacc[2 * kp + 1][2], nacc[2 * kp + 1][3]);
                            const bf16x8 nf = __builtin_bit_cast(bf16x8, nw);
#pragma unroll
                            for (int i = 0; i < 2; ++i) qacc[i] = __builtin_amdgcn_mfma_f32_16x16x32_bf16(__builtin_bit_cast(bf16x8, qf[2 * (2 * th + i) + kp]), nf, qacc[i], 0, 0, 0); } }
#pragma unroll
                    for (int dd = 0; dd < 2; ++dd)
#pragma unroll
                        for (int i = 0; i < 2; ++i) { u32x2 o; o.x = cvtpk(acc[2 * dd + i][0], acc[2 * dd + i][1]); o.y = cvtpk(acc[2 * dd + i][2], acc[2 * dd + i][3]); *(LAS u32x2*)(xw0 + ((2 * dp + dd) * 2 + th) * 8192 + i * 512) = o; }
                    __builtin_amdgcn_sched_barrier(0);
                }
                if (ql == 0) {
#pragma unroll
                    for (int i = 0; i < 2; ++i)
#pragma unroll
                        for (int r = 0; r < 4; ++r) qnL[buf * 512 + (16 * (2 * th + i) + 4 * g + r) * 8 + w] = qacc[i][r]; }
            }
            if (variant != 5) SC4_LOADQ(chn);
            SC2_BAR();
            if (dry) asm volatile("s_waitcnt vmcnt(14)" : "+v"(kf[0]), "+v"(kf[1]), "+v"(kf[2]), "+v"(kf[3]), "+v"(kf[4]), "+v"(kf[5]), "+v"(kf[6]), "+v"(kf[7]) :: "memory");
            else     asm volatile("s_waitcnt vmcnt(16)" : "+v"(kf[0]), "+v"(kf[1]), "+v"(kf[2]), "+v"(kf[3]), "+v"(kf[4]), "+v"(kf[5]), "+v"(kf[6]), "+v"(kf[7]) :: "memory");
            const float decay = wL[buf * 64 + (dir ? 0 : 63)];
            if (variant != 2) {
#pragma unroll
            for (int j = 0; j < 16; ++j) ct[j] = ct[j] * decay;
#pragma unroll
            for (int j = 0; j < 4; ++j) nacc[j] = nacc[j] * decay;
#pragma unroll
            for (int ks = 0; ks < 2; ++ks) {
                bf16x8 vf[4];
#pragma unroll
                for (int dblk = 0; dblk < 4; ++dblk) vf[dblk] = *(const LAS bf16x8*)(vL + buf * 64 * AP + (16 * dblk + ql) * AP + 64 * ks + 16 * g);
                const f32x4 w0 = *(const LAS f32x4*)(wgL + buf * 64 + 32 * ks + 8 * g), w1 = *(const LAS f32x4*)(wgL + buf * 64 + 32 * ks + 8 * g + 4);
                u32x4 gwv; gwv.x = cvtpk(w0[0], w0[1]); gwv.y = cvtpk(w0[2], w0[3]); gwv.z = cvtpk(w1[0], w1[1]); gwv.w = cvtpk(w1[2], w1[3]);
                if (ql != 0) gwv = (u32x4){0u, 0u, 0u, 0u};
                const bf16x8 gwf = __builtin_bit_cast(bf16x8, gwv);
#pragma unroll
                for (int j = 0; j < 4; ++j) { const bf16x8 kfr = __builtin_bit_cast(bf16x8, kf[2 * j + ks]);
#pragma unroll
                    for (int dblk = 0; dblk < 4; ++dblk) ct[4 * j + dblk] = __builtin_amdgcn_mfma_f32_16x16x32_bf16(kfr, vf[dblk], ct[4 * j + dblk], 0, 0, 0);
                    nacc[j] = __builtin_amdgcn_mfma_f32_16x16x32_bf16(kfr, gwf, nacc[j], 0, 0, 0); } } }
            if (variant != 5) SC4_LOADK(chn);
            asm volatile("s_waitcnt vmcnt(20)" : "+v"(ni[0]), "+v"(ni[1]) :: "memory");
            if (variant != 3) { const LAS unsigned char* xr1 = xbL + buf * 65536 + w * 8192 + (g >> 1) * 1024 + (32 * (g & 1) + ql) * 8;
              bf16x8 selA;
              { const int lq = launder_i(l0); const unsigned one_lo = 0x3F80u, one_hi = 0x3F800000u; const int jd = (lq & 15) - 8 * ((lq >> 4) & 1); u32x4 sw;
          sw.x = jd == 0 ? one_lo : (jd == 1 ? one_hi : 0u); sw.y = jd == 2 ? one_lo : (jd == 3 ? one_hi : 0u); sw.z = jd == 4 ? one_lo : (jd == 5 ? one_hi : 0u); sw.w = jd == 6 ? one_lo : (jd == 7 ? one_hi : 0u);
          selA = __builtin_bit_cast(bf16x8, sw); }
#pragma unroll
              for (int k = 0; k < 2; ++k) { f32x4 sum = (f32x4){0.f, 0.f, 0.f, 0.f};
#pragma unroll
                  for (int m = 0; m < 4; ++m) { const LAS unsigned char* xp = xr1 + (2 * (2 * m) + k) * 512;
                      const u32x2 lo = *(const LAS u32x2*)(xp), hi = *(const LAS u32x2*)(xp + 128);
                      sum = __builtin_amdgcn_mfma_f32_16x16x32_bf16(selA, __builtin_bit_cast(bf16x8, (u32x4){lo.x, lo.y, hi.x, hi.y}), sum, 0, 0, 0); }
                  const int t = 16 * (2 * (w & 1) + k) + ql; const float wt = wL[buf * 64 + t];
                  const f32x4 qa = *(const LAS f32x4*)(qnL + buf * 512 + t * 8), qb = *(const LAS f32x4*)(qnL + buf * 512 + t * 8 + 4);
                  const float den = denL[buf * 64 + t] + wt * (((qa[0] + qa[1]) + (qa[2] + qa[3])) + ((qb[0] + qb[1]) + (qb[2] + qb[3])));
                  const float sc = 1.0f / (fabsf(den) > 1.0f ? fabsf(den) : 1.0f);
                  const float o0 = (bf_lo(ni[k].x) + wt * sum[0]) * sc, o1 = (bf_hi(ni[k].x) + wt * sum[1]) * sc, o2 = (bf_lo(ni[k].y) + wt * sum[2]) * sc, o3 = (bf_hi(ni[k].y) + wt * sum[3]) * sc;
                  u32x2 ow; ow.x = cvtpk(o0, o1); ow.y = cvtpk(o2, o3); if (!dry) *(u32x2*)(HO + (size_t)(r0 + t) * MLI + h * 512 + sl * 64 + 16 * (w >> 1) + 4 * g) = ow; } }
            if (dry) asm volatile("s_waitcnt vmcnt(16)" : "+v"(pxm[0]), "+v"(pxm[1]), "+v"(pg[0]), "+v"(pg[1]), "+v"(pw), "+v"(pwg), "+v"(pden) :: "memory");
            else     asm volatile("s_waitcnt vmcnt(18)" : "+v"(pxm[0]), "+v"(pxm[1]), "+v"(pg[0]), "+v"(pg[1]), "+v"(pw), "+v"(pwg), "+v"(pden) :: "memory");
            if (variant != 4) SC4_STAGE(buf ^ 1);
            SC4_LOADNI(chn);
        }
        asm volatile("s_waitcnt vmcnt(0)" : "+v"(qf[0]), "+v"(qf[1]), "+v"(qf[2]), "+v"(qf[3]), "+v"(qf[4]), "+v"(qf[5]), "+v"(qf[6]), "+v"(qf[7]), "+v"(kf[0]), "+v"(kf[1]), "+v"(kf[2]), "+v"(kf[3]), "+v"(kf[4]), "+v"(kf[5]), "+v"(kf[6]), "+v"(kf[7]), "+v"(ni[0]), "+v"(ni[1]) :: "memory");
#undef SC4_R0
#undef SC4_GLD4
#undef SC4_GLD4O
#undef SC4_GLD2
#undef SC4_GLD1
#undef SC4_LOADQ
#undef SC4_LOADK
#undef SC4_REGS
#undef SC4_LOADNI
#undef SC4_STAGE
    }
    __builtin_amdgcn_s_setprio(0);
}

#pragma clang diagnostic pop
__device__ __forceinline__ void outprep2_phase(const Ctx& X0, const PArgs& a) {
    const Ctx X = fresh_ctx(X0);
    unsigned char* ws = a.ws;
    const bf16_t* __restrict__ HF = (const bf16_t*)(ws + WS_HF); const bf16_t* __restrict__ HB = (const bf16_t*)(ws + WS_HB); const bf16_t* __restrict__ XM = (const bf16_t*)(ws + WS_XM); const bf16_t* __restrict__ Z = (const bf16_t*)(ws + WS_Z2);
    bf16_t* __restrict__ OA = (bf16_t*)(ws + WS_OA2); const float* __restrict__ gn = a.in(I_MLGN); const float* __restrict__ sk = a.in(I_MLSKIP);
    LAS float* cwl = (LAS float*)X.lds;
    { const float* cw = a.in(I_MLCONVW); const float* cb = a.in(I_MLCONVB);
      for (int i = X.tid; i < 4 * MLI; i += 512) cwl[i] = cw[i];
      for (int i = X.tid; i < MLI; i += 512) cwl[4 * MLI + i] = cb[i]; }
    __syncthreads();
    for (int row = X.bid * 8 + X.wave; row < MT; row += X.G * 8) {
        int base, t, len; seq_of_row(row, base, t, len); const bool v0 = t >= 2, v1 = t >= 1, v3 = t + 1 < len;
        const bf16_t* Zr = (X.G >= 64 && row >= NLAT) ? (const bf16_t*)(ws + WS_ZC) - (size_t)NLAT * MLI : Z;
#pragma unroll
        for (int hh = 0; hh < 4; ++hh) { const int c = hh * 512 + 8 * X.lane; const size_t o = (size_t)row * MLI + c;
            const u32x4 wf = __builtin_nontemporal_load((const u32x4*)(HF + o)), wb = __builtin_nontemporal_load((const u32x4*)(HB + o)), wz = __builtin_nontemporal_load((const u32x4*)(Zr + o)); const u32x4 z4 = (u32x4){0u, 0u, 0u, 0u};
            u32x4 w[4]; w[0] = v0 ? *(const u32x4*)(XM + o - 2 * MLI) : z4; w[1] = v1 ? *(const u32x4*)(XM + o - MLI) : z4; w[2] = *(const u32x4*)(XM + o); w[3] = v3 ? *(const u32x4*)(XM + o + MLI) : z4;
            float xcv[8];
            { const f32x4 ba = *(const LAS f32x4*)(cwl + 4 * MLI + c), bb = *(const LAS f32x4*)(cwl + 4 * MLI + c + 4);
              xcv[0] = ba[0]; xcv[1] = ba[1]; xcv[2] = ba[2]; xcv[3] = ba[3]; xcv[4] = bb[0]; xcv[5] = bb[1]; xcv[6] = bb[2]; xcv[7] = bb[3]; }
#pragma unroll
            for (int tap = 0; tap < 4; ++tap) { const f32x4 ca = *(const LAS f32x4*)(cwl + tap * MLI + c), cc = *(const LAS f32x4*)(cwl + tap * MLI + c + 4);
                xcv[0] += bf_lo(w[tap].x) * ca[0]; xcv[1] += bf_hi(w[tap].x) * ca[1]; xcv[2] += bf_lo(w[tap].y) * ca[2]; xcv[3] += bf_hi(w[tap].y) * ca[3];
                xcv[4] += bf_lo(w[tap].z) * cc[0]; xcv[5] += bf_hi(w[tap].z) * cc[1]; xcv[6] += bf_lo(w[tap].w) * cc[2]; xcv[7] += bf_hi(w[tap].w) * cc[3]; }
#pragma unroll
            for (int i = 0; i < 8; ++i) xcv[i] = bf2f(f2bf(silu_f(xcv[i])));
            float hs[8] = {bf_lo(wf.x) + bf_lo(wb.x), bf_hi(wf.x) + bf_hi(wb.x), bf_lo(wf.y) + bf_lo(wb.y), bf_hi(wf.y) + bf_hi(wb.y), bf_lo(wf.z) + bf_lo(wb.z), bf_hi(wf.z) + bf_hi(wb.z), bf_lo(wf.w) + bf_lo(wb.w), bf_hi(wf.w) + bf_hi(wb.w)};
            const float zv[8] = {bf_lo(wz.x), bf_hi(wz.x), bf_lo(wz.y), bf_hi(wz.y), bf_lo(wz.z), bf_hi(wz.z), bf_lo(wz.w), bf_hi(wz.w)};
            float s = 0.f;
#pragma unroll
            for (int i = 0; i < 8; ++i) s += hs[i];
            const float mu = wave_sum(s) * (1.0f / 512.0f); float q = 0.f;
#pragma unroll
            for (int i = 0; i < 8; ++i) { hs[i] -= mu; q += hs[i] * hs[i]; }
            const float rstd = 1.0f / sqrtf(wave_sum(q) * (1.0f / 512.0f) + NORM_EPS);
            float ov[8];
#pragma unroll
            for (int i = 0; i < 8; ++i) ov[i] = (hs[i] * rstd * gn[c + i] + sk[c + i] * xcv[i]) * silu_f(zv[i]);
            u32x4 wo; wo.x = cvtpk(ov[0], ov[1]); wo.y = cvtpk(ov[2], ov[3]); wo.z = cvtpk(ov[4], ov[5]); wo.w = cvtpk(ov[6], ov[7]);
            *(u32x4*)(OA + o) = wo; }
    }
}

template <int CBLO, int CBHI, bool LOCAL>
__device__ __forceinline__ void attn_tile2(const LAS unsigned char* kt0, const LAS unsigned char* vt0, const LAS float* blr0, const bf16x8 (&qf)[2], float& m, float& lsum, f32x4 (&o)[4], int ql, int g, int qc, int c0) {
    constexpr int PITCH = 272, TILEB = 64 * PITCH;
    f32x4 s[2][4];
#pragma unroll
    for (int ts = 0; ts < 2; ++ts)
#pragma unroll
        for (int cb = CBLO; cb <= CBHI; ++cb) { s[ts][cb] = (f32x4){0.f, 0.f, 0.f, 0.f};
#pragma unroll
            for (int ss = 0; ss < 2; ++ss) { const bf16x8 kf = *(const LAS bf16x8*)(kt0 + ts * TILEB + (16 * cb + ql) * PITCH + ss * 64 + g * 16);
                s[ts][cb] = __builtin_amdgcn_mfma_f32_16x16x32_bf16(kf, qf[ss], s[ts][cb], 0, 0, 0); } }
    float mx = -1.0e30f;
#pragma unroll
    for (int ts = 0; ts < 2; ++ts)
#pragma unroll
        for (int cb = CBLO; cb <= CBHI; ++cb)
#pragma unroll
            for (int rg = 0; rg < 4; ++rg) { float v = s[ts][cb][rg] * 0.18033688011112042f;
                if (LOCAL) { const int kc = 16 * cb + 4 * g + rg; int dc = kc - qc; dc = dc < -15 ? -15 : (dc > 15 ? 15 : dc);
                    v += blr0[ts * 32 + dc + 15]; v = (kc >= c0 && kc < c0 + 16) ? v : -1.0e30f; }
                s[ts][cb][rg] = v; mx = fmaxf(mx, v); }
    mx = fmaxf(mx, __shfl_xor(mx, 16)); mx = fmaxf(mx, __shfl_xor(mx, 32));
    const float mn = fmaxf(m, mx), alpha = __builtin_amdgcn_exp2f(m - mn); m = mn;
    float ps = 0.f;
#pragma unroll
    for (int ts = 0; ts < 2; ++ts)
#pragma unroll
        for (int cb = CBLO; cb <= CBHI; ++cb)
#pragma unroll
            for (int rg = 0; rg < 4; ++rg) { const float p = __builtin_amdgcn_exp2f(s[ts][cb][rg] - mn); s[ts][cb][rg] = p; ps += p; }
    lsum = lsum * alpha + ps;
#pragma unroll
    for (int db = 0; db < 4; ++db) o[db] = o[db] * alpha;
#pragma unroll
    for (int ts = 0; ts < 2; ++ts)
#pragma unroll
        for (int pr = 0; pr < 2; ++pr) {
            if (2 * pr + 1 < CBLO || 2 * pr > CBHI) continue;
            const f32x4 z = (f32x4){0.f, 0.f, 0.f, 0.f};
            const f32x4 s0 = (2 * pr >= CBLO && 2 * pr <= CBHI) ? s[ts][2 * pr] : z, s1 = (2 * pr + 1 >= CBLO && 2 * pr + 1 <= CBHI) ? s[ts][2 * pr + 1] : z;
            u32x4 pw; pw.x = cvtpk(s0[0], s0[1]); pw.y = cvtpk(s0[2], s0[3]); pw.z = cvtpk(s1[0], s1[1]); pw.w = cvtpk(s1[2], s1[3]);
            const bf16x8 pf = __builtin_bit_cast(bf16x8, pw);
#pragma unroll
            for (int db = 0; db < 4; ++db) {
                const LAS unsigned char* vp = vt0 + ts * TILEB + (32 * pr + 4 * g + (ql >> 2)) * PITCH + (16 * db + 4 * (ql & 3)) * 2;
                const s16x4 t0 = lds_tr16(vp), t1 = lds_tr16(vp + 16 * PITCH);
                const bf16x8 vf = (bf16x8){t0[0], t0[1], t0[2], t0[3], t1[0], t1[1], t1[2], t1[3]};
                o[db] = __builtin_amdgcn_mfma_f32_16x16x32_bf16(vf, pf, o[db], 0, 0, 0); } }
}
template <int B0, int B1>
__device__ __forceinline__ void attn_tile2p(const LAS unsigned char* kt0, const LAS unsigned char* vt0, const LAS float* blr0, const bf16x8 (&qf)[2], float& m, float& lsum, f32x4 (&o)[4], int ql, int g, int qc, int c0) {
    constexpr int PITCH = 272, TILEB = 64 * PITCH;
    f32x4 s[2][2];
#pragma unroll
    for (int ts = 0; ts < 2; ++ts)
#pragma unroll
        for (int i = 0; i < 2; ++i) { const int cb = i ? B1 : B0; s[ts][i] = (f32x4){0.f, 0.f, 0.f, 0.f};
#pragma unroll
            for (int ss = 0; ss < 2; ++ss) { const bf16x8 kf = *(const LAS bf16x8*)(kt0 + ts * TILEB + (16 * cb + ql) * PITCH + ss * 64 + g * 16);
                s[ts][i] = __builtin_amdgcn_mfma_f32_16x16x32_bf16(kf, qf[ss], s[ts][i], 0, 0, 0); } }
    float mx = -1.0e30f;
#pragma unroll
    for (int ts = 0; ts < 2; ++ts)
#pragma unroll
        for (int i = 0; i < 2; ++i)
#pragma unroll
            for (int rg = 0; rg < 4; ++rg) { float v = s[ts][i][rg] * 0.18033688011112042f;
                const int kc = 16 * (i ? B1 : B0) + 4 * g + rg; int dc = kc - qc; dc = dc < -15 ? -15 : (dc > 15 ? 15 : dc);
                v += blr0[ts * 32 + dc + 15]; v = (kc >= c0 && kc < c0 + 16) ? v : -1.0e30f;
                s[ts][i][rg] = v; mx = fmaxf(mx, v); }
    mx = fmaxf(mx, __shfl_xor(mx, 16)); mx = fmaxf(mx, __shfl_xor(mx, 32));
    const float mn = fmaxf(m, mx), alpha = __builtin_amdgcn_exp2f(m - mn); m = mn;
    float ps = 0.f;
#pragma unroll
    for (int ts = 0; ts < 2; ++ts)
#pragma unroll
        for (int i = 0; i < 2; ++i)
#pragma unroll
            for (int rg = 0; rg < 4; ++rg) { const float p = __builtin_amdgcn_exp2f(s[ts][i][rg] - mn); s[ts][i][rg] = p; ps += p; }
    lsum = lsum * alpha + ps;
#pragma unroll
    for (int db = 0; db < 4; ++db) o[db] = o[db] * alpha;
#pragma unroll
    for (int ts = 0; ts < 2; ++ts) {
        const f32x4 s0 = s[ts][0], s1 = s[ts][1];
        u32x4 pw; pw.x = cvtpk(s0[0], s0[1]); pw.y = cvtpk(s0[2], s0[3]); pw.z = cvtpk(s1[0], s1[1]); pw.w = cvtpk(s1[2], s1[3]);
        const bf16x8 pf = __builtin_bit_cast(bf16x8, pw);
#pragma unroll
        for (int db = 0; db < 4; ++db) {
            const LAS unsigned char* vp = vt0 + ts * TILEB + (4 * g + (ql >> 2)) * PITCH + (16 * db + 4 * (ql & 3)) * 2;
            const s16x4 t0 = lds_tr16(vp + 16 * B0 * PITCH), t1 = lds_tr16(vp + 16 * B1 * PITCH);
            const bf16x8 vf = (bf16x8){t0[0], t0[1], t0[2], t0[3], t1[0], t1[1], t1[2], t1[3]};
            o[db] = __builtin_amdgcn_mfma_f32_16x16x32_bf16(vf, pf, o[db], 0, 0, 0); } }
}
__device__ __forceinline__ void attn2_phase(const Ctx& X0, const PArgs& a, int j_na, bool with_ctx) {
    const Ctx X = fresh_ctx(X0);
    unsigned char* ws = a.ws;
    const bf16_t* Q = (const bf16_t*)(ws + WS_Q); const bf16_t* K = (const bf16_t*)(ws + WS_K); const bf16_t* V = (const bf16_t*)(ws + WS_V); bf16_t* O = (bf16_t*)(ws + WS_O);
    const float* rpb = a.in(I_NARPB) + (size_t)j_na * NAH * 15 * 31;
    constexpr int PITCH = 272, TILEB = 64 * PITCH;
    LAS unsigned char* Kb = X.lds; LAS unsigned char* Vb = X.lds + 4 * TILEB; LAS float* bl = (LAS float*)(X.lds + 8 * TILEB);
    const int hsel = X.wave >> 2, jb = X.wave & 3, ql = X.lane & 15, g = X.lane >> 4;
    const int nlat = NB * GROWS * 8, nunits = nlat + (with_ctx ? NB * 8 * 4 : 0);
    const int skey = X.tid >> 3, sch = (X.tid & 7) * 16;
    const int qc = jb == 0 ? (ql < 8 ? ql : 48 + ql) : 16 * jb - 8 + ql, c0 = qc - 8 < 0 ? 0 : (qc - 8 > 48 ? 48 : qc - 8);
    const int nper = (X.G % 8 == 0 && nlat % 8 == 0) ? nlat / 8 : 0, wpx = X.G / 8;
    for (int k = 0; ; ++k) {
        int u;
        if (nper) { const int iu = (X.bid >> 3) + wpx * k; u = iu < nper ? (X.bid & 7) * nper + iu : nlat + (iu - nper) * 8 + (X.bid & 7); }
        else u = X.bid + X.G * k;
        if (u >= nunits) break;
        const bool lat = u < nlat; int b, h0, r = 0, r0 = 0, qrow0, nst;
        if (lat) { b = u / (GROWS * 8); const int rem = u % (GROWS * 8); h0 = (rem >> 7) * 2; r = rem & 127; r0 = r - 4; r0 = r0 < 0 ? 0 : (r0 > GROWS - 8 ? GROWS - 8 : r0); qrow0 = b * SEQ + r * GRIDW; nst = 6; }
        else { const int v = u - nlat; b = v >> 5; h0 = ((v >> 2) & 7) * 2; qrow0 = NLAT + b * CTXL + (v & 3) * 64; nst = 2; }
        const int h = h0 + hsel;
        bf16x8 qf[2];
        { const bf16_t* qp = Q + (size_t)(qrow0 + qc) * D + h * 64 + 8 * g; qf[0] = *(const bf16x8*)qp; qf[1] = *(const bf16x8*)(qp + 32); }
        __syncthreads();
        if (lat) { const int idx = X.tid; const int hh = idx >> 8, i = (idx >> 5) & 7, dc = idx & 31; bl[idx] = dc < 31 ? rpb[((h0 + hh) * 15 + (r0 + i - r + 7)) * 31 + dc] * 1.4426950408889634f : 0.f; }
        float m = -1.0e30f, lsum = 0.f; f32x4 o[4];
#pragma unroll
        for (int i = 0; i < 4; ++i) o[i] = (f32x4){0.f, 0.f, 0.f, 0.f};
        u32x4 kr[2][2], vr[2][2];
#define AT_KROW(tl_) ((lat && (tl_) < 8) ? b * SEQ + (r0 + (tl_)) * GRIDW : NLAT + b * CTXL + (lat ? (tl_) - 8 : (tl_)) * 64)
#define AT_LOAD(st_) do { _Pragma("unroll") for (int ts_ = 0; ts_ < 2; ++ts_) { const size_t go_ = (size_t)(AT_KROW(2 * (st_) + ts_) + skey) * D + h0 * 64 + sch; \
            kr[ts_][0] = *(const u32x4*)(K + go_); kr[ts_][1] = *(const u32x4*)(K + go_ + 8); vr[ts_][0] = *(const u32x4*)(V + go_); vr[ts_][1] = *(const u32x4*)(V + go_ + 8); } } while (0)
        AT_LOAD(0);
        for (int st = 0; st < nst; ++st) {
            const int buf = st & 1;
#pragma unroll
            for (int ts = 0; ts < 2; ++ts) { LAS unsigned char* kd = Kb + (buf * 2 + ts) * TILEB + skey * PITCH + sch * 2; LAS unsigned char* vd = Vb + (buf * 2 + ts) * TILEB + skey * PITCH + sch * 2;
                *(LAS u32x4*)kd = kr[ts][0]; *(LAS u32x4*)(kd + 16) = kr[ts][1]; *(LAS u32x4*)vd = vr[ts][0]; *(LAS u32x4*)(vd + 16) = vr[ts][1]; }
            __syncthreads();
            if (st + 1 < nst) AT_LOAD(st + 1);
            const bool local = lat && st < 4;
            const LAS unsigned char* kt0 = Kb + (buf * 2) * TILEB + hsel * 128; const LAS unsigned char* vt0 = Vb + (buf * 2) * TILEB + hsel * 128; const LAS float* blr0 = bl + hsel * 256 + (2 * st) * 32;
            if (!local) attn_tile2<0, 3, false>(kt0, vt0, blr0, qf, m, lsum, o, ql, g, qc, c0);
            else if (jb == 0) attn_tile2p<0, 3>(kt0, vt0, blr0, qf, m, lsum, o, ql, g, qc, c0);
            else if (jb == 1) attn_tile2p<0, 1>(kt0, vt0, blr0, qf, m, lsum, o, ql, g, qc, c0);
            else if (jb == 2) attn_tile2p<1, 2>(kt0, vt0, blr0, qf, m, lsum, o, ql, g, qc, c0);
            else attn_tile2p<2, 3>(kt0, vt0, blr0, qf, m, lsum, o, ql, g, qc, c0);
        }
#undef AT_KROW
#undef AT_LOAD
        lsum += __shfl_xor(lsum, 16); lsum += __shfl_xor(lsum, 32);
        const float inv = 1.0f / lsum;
        bf16_t* op = O + (size_t)(qrow0 + qc) * D + h * 64 + 4 * g;
#pragma unroll
        for (int db = 0; db < 4; ++db) { u32x2 w; w.x = cvtpk(o[db][0] * inv, o[db][1] * inv); w.y = cvtpk(o[db][2] * inv, o[db][3] * inv); *(u32x2*)(op + 16 * db) = w; }
    }
}
struct MoeOrder {
    const LAS int* tab;
    int chunk, G, c, nN, kind;
    const bf16_t* A; const bf16_t* W; const int* LIST;
    __device__ __forceinline__ bool next(int i, pg8::Unit& u) const {
#define RFL(x) __builtin_amdgcn_readfirstlane(x)
        const int nM = RFL(tab[8]); if (nM <= 0) return false;
        int pm, pn; if (!pg8::tile_order(i, G, c, nM, nN, pm, pn)) return false;
        const int gt = pm; int e = 0;
        for (int j = 1; j < 8; ++j) e += (gt >= RFL(tab[j])) ? 1 : 0;
        const int tse = RFL(tab[e]), cne = RFL(tab[16 + e]);
#undef RFL
        const int slot0 = (gt - tse) * 256; int nr = cne - slot0; nr = nr > 256 ? 256 : nr;
        if (kind == 1) { u.a = (const char*)A + (size_t)gt * 256 * D; u.rows = nullptr; u.nrows = nr; u.b = (const char*)W + ((size_t)e * 2 * FFE + (size_t)pn * 256) * D; u.orow = gt * 256; u.ocol = pn * 128; }
        else { u.a = (const char*)A + (size_t)gt * 256 * FFE; u.rows = nullptr; u.nrows = 256; u.b = (const char*)W + ((size_t)e * D + (size_t)pn * 256) * FFE; u.orow = gt * 256; u.ocol = pn * 256; }
        u.aux = 0; return true;
    }
};
__device__ __forceinline__ void moe_table(const Ctx& X, const unsigned* cntw, LAS int* tab) {
    __syncthreads();
    if (X.tid == 0) { int acc = 0; for (int e = 0; e < 8; ++e) { const int c = (int)__hip_atomic_load(cntw + 64 * e, RLX_AGENT); tab[16 + e] = c; tab[e] = acc; acc += (c + 255) >> 8; } tab[8] = acc; }
    __syncthreads();
}

__device__ __forceinline__ void moe_gather_phase(const Ctx& X0, const PArgs& a, const unsigned* cntw, LAS int* tab) {
    const Ctx X = fresh_ctx(X0);
    moe_table(X, cntw, tab);
    const bf16_t* __restrict__ A = (const bf16_t*)(a.ws + WS_A); unsigned char* __restrict__ AG = (unsigned char*)(a.ws + WS_AG); const int* __restrict__ LIST = (const int*)(a.ws + WS_LIST);
    const int ntile = tab[8]; const int step = X.G * 8, nrow = ntile * 256;
#define GA_SRC(cr_) ({ int src_ = -1; if ((cr_) < nrow) { const int gt_ = (cr_) >> 8; int e_ = 0; for (int j_ = 1; j_ < 8; ++j_) e_ += (gt_ >= tab[j_]) ? 1 : 0; const int slot_ = (cr_) - tab[e_] * 256; \
        if (slot_ < tab[16 + e_]) src_ = LIST[(size_t)e_ * MT + slot_]; } src_; })
#define GA_DATA(src_, d0_, d1_) do { d0_ = (u32x4){0u, 0u, 0u, 0u}; d1_ = d0_; if ((src_) >= 0) { const u32x4* sp_ = (const u32x4*)(A + (size_t)(src_) * D) + 2 * X.lane; d0_ = sp_[0]; d1_ = sp_[1]; } } while (0)
    const int cr0 = X.bid * 8 + X.wave;
    int srcA = GA_SRC(cr0), srcB = GA_SRC(cr0 + step);
    u32x4 nd0, nd1; GA_DATA(srcA, nd0, nd1);
    for (int cr = cr0; cr < nrow; cr += step) {
        const u32x4 v0 = nd0, v1 = nd1;
        srcA = srcB; srcB = GA_SRC(cr + 2 * step);
        GA_DATA(srcA, nd0, nd1);
        u32x4 o;
#define F8C(x_) __builtin_fminf(__builtin_fmaxf((x_), -448.f), 448.f)
        { int p = __builtin_amdgcn_cvt_pk_fp8_f32(F8C(bf_lo(v0.x)), F8C(bf_hi(v0.x)), 0, false); p = __builtin_amdgcn_cvt_pk_fp8_f32(F8C(bf_lo(v0.y)), F8C(bf_hi(v0.y)), p, true); o.x = (unsigned)p;
          p = __builtin_amdgcn_cvt_pk_fp8_f32(F8C(bf_lo(v0.z)), F8C(bf_hi(v0.z)), 0, false); p = __builtin_amdgcn_cvt_pk_fp8_f32(F8C(bf_lo(v0.w)), F8C(bf_hi(v0.w)), p, true); o.y = (unsigned)p;
          p = __builtin_amdgcn_cvt_pk_fp8_f32(F8C(bf_lo(v1.x)), F8C(bf_hi(v1.x)), 0, false); p = __builtin_amdgcn_cvt_pk_fp8_f32(F8C(bf_lo(v1.y)), F8C(bf_hi(v1.y)), p, true); o.z = (unsigned)p;
          p = __builtin_amdgcn_cvt_pk_fp8_f32(F8C(bf_lo(v1.z)), F8C(bf_hi(v1.z)), 0, false); p = __builtin_amdgcn_cvt_pk_fp8_f32(F8C(bf_lo(v1.w)), F8C(bf_hi(v1.w)), p, true); o.w = (unsigned)p; }

#undef F8C
        *((u32x4*)(AG + (size_t)cr * D) + X.lane) = o;
    }
#undef GA_SRC
#undef GA_DATA
}

#ifdef PROBE_PRO
#define RP_PRO 1
#else
#define RP_PRO 0
#endif
#ifdef PROBE_NORM
#define RP_NORM 1
#else
#define RP_NORM 0
#endif
#ifdef PROBE_GEMM_A
#define RP_GA 1
#else
#define RP_GA 0
#endif
#ifdef PROBE_GEMM_B
#define RP_GB 1
#else
#define RP_GB 0
#endif
#ifdef PROBE_MOE
#define RP_MOE 1
#else
#define RP_MOE 0
#endif
#ifdef PROBE_ATTN
#define RP_ATTN 1
#else
#define RP_ATTN 0
#endif
#ifdef PROBE_ML
#define RP_ML 1
#else
#define RP_ML 0
#endif
#ifdef PROBE_FEAT
#define RP_FEAT 1
#else
#define RP_FEAT RP_ML
#endif
#ifdef PROBE_SCANA
#define RP_SCANA 1
#else
#define RP_SCANA RP_ML
#endif
#ifdef PROBE_SCANB
#define RP_SCANB 1
#else
#define RP_SCANB RP_ML
#endif
#ifdef PROBE_OUTPREP
#define RP_OUTPREP 1
#else
#define RP_OUTPREP RP_ML
#endif
constexpr int NSEG = 40;
__global__ void __launch_bounds__(512, 2) trunk_fwd(Args args) {
    extern __shared__ __attribute__((aligned(16))) unsigned char lds_raw[];
    Ctx X; X.lds = (LAS unsigned char*)lds_raw; X.tid = threadIdx.x; X.lane = X.tid & 63; X.wave = __builtin_amdgcn_readfirstlane(X.tid >> 6); X.G = gridDim.x; X.bid = blockIdx.x;
    unsigned char* ws = args.ws; unsigned* ctl = (unsigned*)(ws + WS_CTL);
    volatile LAS unsigned* MISC = (volatile LAS unsigned*)(X.lds + MISC_OFF);
    if (X.tid < 64) MISC[X.tid] = 0u;
    __syncthreads();
    LAS unsigned long long* ATAB = (LAS unsigned long long*)(X.lds + MISC_OFF - 640);
    { unsigned long long v = 0ull;
#pragma unroll
      for (int i = 0; i < 33; ++i) v = (X.tid == i) ? (unsigned long long)args.in[i] : v;
      if (X.tid < 33) ATAB[X.tid] = v; }
    __syncthreads();
    PArgs PA; PA.tab = ATAB; PA.out = args.out; PA.ws = args.ws;
    const int lo = args.lo, hi = args.hi;
    XcdBarrier bar; bar.bar = ctl + CW_BAR; bar.x = 0; bar.st = MISC + 8;
    if (hi - lo > 1) bar = xcd_barrier_post(ctl + CW_BAR, MISC + 8);
    int seg = 0;
#define SEG_BEGIN if (seg >= lo && seg < hi) {
#define SEG_END } if (seg >= lo && seg + 1 < hi) xcd_barrier(bar); ++seg;
    const float* MOD = (const float*)(ws + WS_MOD);
    bf16_t* Abuf = (bf16_t*)(ws + WS_A); bf16_t* H = (bf16_t*)(ws + WS_H);
    LAS int* MTAB = (LAS int*)(X.lds + MISC_OFF - 256);

    SEG_BEGIN
#ifndef NO_PRO
 for (int rp = 0; rp <= RP_PRO; ++rp) prologue_phase(X, PA);
#endif
 SEG_END

#define NORM_SPLIT(Lq, whichq, routeq, rsetq, dryq) do { \
        if (X.bid >= 16) norm_phase(X, PA, Lq, whichq, 0, NLAT, X.G - 16, X.bid - 16, false, 0, 0, routeq, rsetq, false, dryq); } while (0)
    SEG_BEGIN
#ifndef NO_NORM
        if (RP_NORM) norm_phase(X, PA, 0, 0, 0, MT, X.G, X.bid, false, 0, 0, false, 0, false, true);
        norm_phase(X, PA, 0, 0, 0, MT, X.G, X.bid, false, 0, 0, false, 0, false);
#endif
    SEG_END
    for (int L = 0; L < DEPTH; ++L) {
        const int kind = L % 3, jk = L / 3, moe = L & 1, ek = L >> 1; const bool last = (L == DEPTH - 1);
        if (L > 0 && ((L - 1) & 1)) {
            SEG_BEGIN
#ifndef NO_NORM
                if (RP_NORM) norm_phase(X, PA, L, 0, 0, MT, X.G, X.bid, true, L - 1, (L - 1) >> 1, false, 0, false, true);
                norm_phase(X, PA, L, 0, 0, MT, X.G, X.bid, true, L - 1, (L - 1) >> 1, false, 0, false);
#endif
            SEG_END
        }
        if (kind != 1) {
            SEG_BEGIN
                pg8::PlainOrder S; pg8::EpiBf16 E;
                const int cs1 = (X.G >= 64 && L == 0) ? 24 : 0; const int g1g = X.G - cs1, g1c = X.bid - cs1;
                if (kind == 0) { S = pg8::PlainOrder{Abuf, (const bf16_t*)(ws + WS_WQKV) + (size_t)jk * 3 * D * D, D, D, MT / 256, 12, g1g, g1c, 0, 256, 0};
                                 E = pg8::EpiBf16{(bf16_t*)(ws + WS_Q), D, PA.in(I_NABQKV) + jk * 3 * D, D, (size_t)MT * D}; }
                else           { S = pg8::PlainOrder{Abuf, (const bf16_t*)(ws + WS_WUP), D, D, MT / 256, 8, g1g, g1c, 0, 256, 0};
                                 E = pg8::EpiBf16{(bf16_t*)(ws + WS_XM), MLI, nullptr, 0, 0}; }
#ifndef NO_G1
                if (X.bid < cs1) conv_weights(X, PA, L >> 1, cs1, X.bid, 0, 85);
                else {
                    const int npass = (kind == 2 && X.G >= 64 && X.bid >= 32 && X.bid < 64) ? 2 : 1;
                    for (int pass = 0; pass < npass; ++pass) {
                        if (pass == 1) { S = pg8::PlainOrder{Abuf, (const bf16_t*)(ws + WS_WUP) + (size_t)MLI * D, D, D, NCTX / 256, 8, 32, X.bid - 32, 0, 256, NLAT / 256};
                                         E = pg8::EpiBf16{(bf16_t*)(ws + WS_ZC) - (size_t)NLAT * MLI, MLI, nullptr, 0, 0}; }
                        pg8::gemm_phase<pg8::EpiBf16, pg8::PlainOrder, false>(X.lds, X.wave, D, D, D, S, E); }
                }
#endif
            SEG_END
        }
        if (kind == 0) { SEG_BEGIN
#ifndef NO_ATTN
            for (int rp = 0; rp <= RP_ATTN; ++rp) attn4_phase(X, PA, jk, !last);
#endif
        SEG_END }
        if (kind == 2) {
            SEG_BEGIN
#ifndef NO_FEAT
#ifdef PROBE_FEATLD
                feat2_phase(X, PA, true);
#endif
                for (int rp = 0; rp <= RP_FEAT; ++rp) feat2_phase(X, PA);
#endif
            SEG_END
            SEG_BEGIN
#ifndef NO_SCANA
                scanA2_phase(X, PA);
#endif
            SEG_END
            SEG_BEGIN
#ifndef NO_SCANB
#ifdef PROBE_SCANB1
                scanB2_phase(X, PA, true, 1);
#endif
#ifdef PROBE_SCANB2
                scanB2_phase(X, PA, true, 2);
#endif
#ifdef PROBE_SCANB3
                scanB2_phase(X, PA, true, 3);
#endif
#ifdef PROBE_SCANB4
                scanB2_phase(X, PA, true, 4);
#endif
#ifdef PROBE_SB4V
                scanB4_phase(X, PA, true, PROBE_SB4V);
#endif
                if (RP_SCANB) scanB4_phase(X, PA, true);
                scanB4_phase(X, PA);
#endif
            SEG_END
            SEG_BEGIN
                pg8::PlainOrder S{Abuf, (const bf16_t*)(ws + WS_WUP) + (size_t)MLI * D, D, D, (X.G >= 64 ? NLAT : MT) / 256, 8, X.G, X.bid, 0, 256, 0};
                pg8::EpiBf16 E{(bf16_t*)(ws + WS_Z2), MLI, nullptr, 0, 0};
                for (int rp = 0; rp <= RP_GA; ++rp) pg8::gemm_phase<pg8::EpiBf16, pg8::PlainOrder, false>(X.lds, X.wave, D, D, D, S, E);
            SEG_END
            SEG_BEGIN
#ifndef NO_OUTPREP
                for (int rp = 0; rp <= RP_OUTPREP; ++rp) outprep2_phase(X, PA);
#endif
            SEG_END
        }
        if (kind == 1) { SEG_BEGIN
#ifndef NO_POOLPREP
            for (int rp = 0; rp <= RP_ML; ++rp) poolprep2_phase(X, PA, MT);
#endif
        SEG_END }
        {
            pg8::PlainOrder S; int lda, ldb, K;
            if (kind == 0)      { S = pg8::PlainOrder{(const bf16_t*)(ws + WS_O), (const bf16_t*)(ws + WS_WOUT) + (size_t)jk * D * D, D, D, NLAT / 256, 4, X.G, X.bid, 0, 256, 0}; lda = D; ldb = D; K = D; }
            else if (kind == 1) { S = pg8::PlainOrder{(const bf16_t*)(ws + WS_PL), (const bf16_t*)(ws + WS_WPOOL), D, 256, NLAT / 256, 4, X.G, X.bid, 256, 256, 0}; lda = D; ldb = 256; K = 256; }
            else                { S = pg8::PlainOrder{(const bf16_t*)(ws + WS_OA2), (const bf16_t*)(ws + WS_WDOWN), MLI, MLI, NLAT / 256, 4, X.G, X.bid, 0, 256, 0}; lda = MLI; ldb = MLI; K = MLI; }
            pg8::EpiRes E{H, MOD + (size_t)(L * 5 * NMODV + 6) * D, MOD + (size_t)(L * 5 * NMODV + 7) * D, NMODV * D, 0, L == 0 ? PA.in(I_X) : nullptr, L == 0 ? PA.in(I_CTX) : nullptr};
            SEG_BEGIN
#ifndef NO_G2
                if (RP_GB) { pg8::EpiRes Ed = E; Ed.dry = 1; pg8::gemm_phase<pg8::EpiRes, pg8::PlainOrder, false>(X.lds, X.wave, lda, ldb, K, S, Ed); }
                pg8::gemm_phase<pg8::EpiRes, pg8::PlainOrder, false>(X.lds, X.wave, lda, ldb, K, S, E);
#endif
            SEG_END
            if (last) {
                SEG_BEGIN
#ifndef NO_NORM2
                    if (RP_NORM) norm_phase(X, PA, L, 1, 0, NLAT, X.G, X.bid, false, 0, 0, moe != 0, ek, false, true);
                    norm_phase(X, PA, L, 1, 0, NLAT, X.G, X.bid, false, 0, 0, moe != 0, ek, false);
#endif
                SEG_END
            } else {
                SEG_BEGIN
                    if (X.bid < 16 && X.G > 16) { pg8::PlainOrder Sc = S; Sc.nM = NCTX / 256; Sc.pm0 = NLAT / 256; Sc.G = 16; Sc.c = X.bid;
                        pg8::gemm_phase<pg8::EpiRes, pg8::PlainOrder, false>(X.lds, X.wave, lda, ldb, K, Sc, E); }
                    else if (X.G > 16) { if (RP_NORM) NORM_SPLIT(L, 1, moe != 0, ek, true); NORM_SPLIT(L, 1, moe != 0, ek, false); }
                SEG_END
                SEG_BEGIN
                    if (X.G > 16) { if (RP_NORM) norm_phase(X, PA, L, 1, NLAT, MT, X.G, X.bid, false, 0, 0, moe != 0, ek, false, true);
                                    norm_phase(X, PA, L, 1, NLAT, MT, X.G, X.bid, false, 0, 0, moe != 0, ek, false); }
                SEG_END
            }
        }
        const int nr2 = last ? NLAT : MT;
        if (!moe) {
            SEG_BEGIN
                const bool csplit = X.G >= CONV_SPLIT * 2; const int csn = L == 0 ? 32 : CONV_SPLIT; const int gg = csplit ? X.G - csn : X.G, gc = csplit ? X.bid - csn : X.bid;
                pg8::PlainOrder S{Abuf, (const bf16_t*)(ws + WS_WF13) + (size_t)ek * 2 * FFD * D, D, D, nr2 / 256, 22, gg, gc, 0, 128, 0};
                pg8::EpiSwigluF8 E{(unsigned char*)(ws + WS_T), FFD, 1.0f, F8_ST, 0};
#ifndef NO_G3
                if (csplit && X.bid < csn) conv_weights(X, PA, L >> 1, csn, X.bid, L == 0 ? 85 : 0, 256);
                else for (int rp = 0; rp <= RP_GA; ++rp) pg8::gemm_phase<pg8::EpiSwigluF8, pg8::PlainOrder, false>(X.lds, X.wave, D, D, D, S, E);
#endif
            SEG_END
            pg8::PlainOrder S{(const bf16_t*)(ws + WS_T), (const bf16_t*)(ws + WS_WF2 + (size_t)ek * D * FFD), FFD / 2, FFD / 2, NLAT / 256, 4, X.G, X.bid, 0, 256, 0};
            pg8::EpiRes E{H, MOD + (size_t)(L * 5 * NMODV + 5) * D, nullptr, NMODV * D, 0, nullptr, nullptr, 1.0f / (F8_ST * F8_SWD)};
            SEG_BEGIN
#ifndef NO_G4
                if (RP_GB) { pg8::EpiRes Ed = E; Ed.dry = 1; pg8::gemm_phase<pg8::EpiRes, pg8::PlainOrder, false, true>(X.lds, X.wave, FFD / 2, FFD / 2, FFD / 2, S, Ed); }
                pg8::gemm_phase<pg8::EpiRes, pg8::PlainOrder, false, true>(X.lds, X.wave, FFD / 2, FFD / 2, FFD / 2, S, E);
#endif
            SEG_END
            SEG_BEGIN
                if (X.bid < 16 && X.G > 16) { pg8::PlainOrder Sc = S; Sc.nM = NCTX / 256; Sc.pm0 = NLAT / 256; Sc.G = 16; Sc.c = X.bid;
                    pg8::gemm_phase<pg8::EpiRes, pg8::PlainOrder, false, true>(X.lds, X.wave, FFD / 2, FFD / 2, FFD / 2, Sc, E); }
                else if (X.G > 16) { if (RP_NORM) NORM_SPLIT(L + 1, 0, false, 0, true); NORM_SPLIT(L + 1, 0, false, 0, false); }
            SEG_END
            SEG_BEGIN
                if (X.G > 16) { if (RP_NORM) norm_phase(X, PA, L + 1, 0, NLAT, MT, X.G, X.bid, false, 0, 0, false, 0, false, true);
                                norm_phase(X, PA, L + 1, 0, NLAT, MT, X.G, X.bid, false, 0, 0, false, 0, false); }
                if (L + 1 == 3 && X.G < CONV_SPLIT * 2) conv_weights(X, PA, 1);
            SEG_END
        } else {
            SEG_BEGIN
#ifndef NO_GATHER
                for (int rp = 0; rp <= RP_MOE; ++rp) moe_gather_phase(X, PA, ctl + CW_CNT + 64 * 8 * ek, MTAB);
#endif
            SEG_END
            {
                SEG_BEGIN
                    MoeOrder S; moe_table(X, ctl + CW_CNT + 64 * 8 * ek, MTAB); S.tab = MTAB; S.chunk = 0; S.G = X.G; S.c = X.bid; S.nN = 28; S.kind = 1;
                    S.A = (const bf16_t*)(ws + WS_AG); S.W = (const bf16_t*)(ws + WS_WM13); S.LIST = nullptr;
                    pg8::EpiSwigluF8 E{(unsigned char*)(ws + WS_MT), FFE, 1.0f / F8_SW1, F8_ST, 0};
#ifndef NO_G5
#ifdef PROBE_MOE1DRY
                    { pg8::EpiSwigluF8 Ed = E; Ed.dry = 1; pg8::gemm_phase<pg8::EpiSwigluF8, MoeOrder, false, true>(X.lds, X.wave, D / 2, D / 2, D / 2, S, Ed); }
#endif
#ifdef PROBE_MOE1
                    pg8::gemm_phase<pg8::EpiSwigluF8, MoeOrder, false, true>(X.lds, X.wave, D / 2, D / 2, D / 2, S, E);
#endif
                    for (int rp = 0; rp <= RP_MOE; ++rp) pg8::gemm_phase<pg8::EpiSwigluF8, MoeOrder, false, true>(X.lds, X.wave, D / 2, D / 2, D / 2, S, E);
#endif
                SEG_END
                SEG_BEGIN
                    MoeOrder S; moe_table(X, ctl + CW_CNT + 64 * 8 * ek, MTAB); S.tab = MTAB; S.chunk = 0; S.G = X.G; S.c = X.bid; S.nN = 4; S.kind = 2;
                    S.A = (const bf16_t*)(ws + WS_MT); S.W = (const bf16_t*)(ws + WS_WM2); S.LIST = nullptr;
                    pg8::EpiBf16S E{(bf16_t*)(ws + WS_MY), D, 1.0f / (F8_ST * F8_SW2)};
#ifndef NO_G6
                    for (int rp = 0; rp <= RP_MOE; ++rp) pg8::gemm_phase<pg8::EpiBf16S, MoeOrder, false, true>(X.lds, X.wave, FFE / 2, FFE / 2, FFE / 2, S, E);
#endif
                SEG_END
            }
        }
    }
    SEG_BEGIN
#ifndef NO_FINAL
        if (RP_NORM) norm_phase(X, PA, 0, 0, 0, NLAT, X.G, X.bid, true, 3, 1, false, 0, true, true);
        norm_phase(X, PA, 0, 0, 0, NLAT, X.G, X.bid, true, 3, 1, false, 0, true);
#endif
    SEG_END
#undef NORM_SPLIT
#undef SEG_BEGIN
#undef SEG_END
}

#ifndef ONE_LAUNCH
#define ONE_LAUNCH 1
#endif
extern "C" void kernel_launch(void* const* d_in, const int* in_sizes, int n_in, void* d_out, int out_size, void* d_ws, size_t ws_size, hipStream_t stream) {
    static int grid = 0;
    if (grid == 0) {
        if (n_in != 33 || out_size != NLAT * D || ws_size < WS_END) { fprintf(stderr, "kernel_launch: unexpected problem: n_in %d out %d ws %zu (need %zu)\n", n_in, out_size, ws_size, (size_t)WS_END); grid = -1; return; }
        int dev = 0, cus = 0, per_cu = 0;
        if (hipGetDevice(&dev) != hipSuccess || hipDeviceGetAttribute(&cus, hipDeviceAttributeMultiprocessorCount, dev) != hipSuccess) { grid = -1; return; }
        if (hipFuncSetAttribute((const void*)trunk_fwd, hipFuncAttributeMaxDynamicSharedMemorySize, LDS_BYTES) != hipSuccess) { fprintf(stderr, "kernel_launch: hipFuncSetAttribute failed\n"); grid = -1; return; }
        if (hipOccupancyMaxActiveBlocksPerMultiprocessor(&per_cu, (const void*)trunk_fwd, 512, LDS_BYTES) != hipSuccess || per_cu < 1) fprintf(stderr, "kernel_launch: occupancy query says %d\n", per_cu);
        (void)hipGetLastError();
        grid = cus;
    }
    if (grid < 0) return;
    if (hipMemsetAsync((char*)d_ws + WS_CTL, 0, CTL_ZERO_BYTES, stream) != hipSuccess) return;
    Args a{};
    for (int i = 0; i < 33; ++i) a.in[i] = (const float*)d_in[i];
    a.out = (float*)d_out; a.ws = (unsigned char*)d_ws; a.pad0 = 0; a.pad1 = 0;
#if ONE_LAUNCH
    a.lo = 0; a.hi = NSEG;
    hipLaunchKernelGGL(trunk_fwd, dim3(grid), dim3(512), LDS_BYTES, stream, a);
#else
    for (int s = 0; s < NSEG; ++s) { a.lo = s; a.hi = s + 1; hipLaunchKernelGGL(trunk_fwd, dim3(grid), dim3(512), LDS_BYTES, stream, a); }
#endif
}
```
